# Optimizing an MI355X kernel written in HIP

```python
import jax
import jax.numpy as jnp
from jax import lax
import numpy as np

D_MODEL = 2048
BATCH = 2
SEQ = 8192
DEPTH = 2

GRID_W = 64
CTX_LEN = 256
HEAD_DIM = 128
ROPE_THETA = 10000.0
EPS = 1e-6
NEG = -1e30
N_BRANCH = 4
BRANCH_W = 512
QBLOCK = 128

ATT_HEADS = 4
ATT_KV_HEADS = 2
MLA_HEADS = 4
MLA_Q_LORA = 384
MLA_KV_LORA = 256
MLA_NOPE = 128
MLA_ROPE = 64
MLA_V = 128
WIN_HEADS = 4
WIN_KV_HEADS = 2
WINDOW = 128
NA_HEADS = 4
NA_WIN_H = 8
NA_WIN_W = 16
N_EXPERTS = 16
N_GROUPS = 4
TOPK_GROUPS = 1
TOP_K = 2
D_EXPERT = 512

SPLITS = (ATT_HEADS * HEAD_DIM, ATT_KV_HEADS * HEAD_DIM, ATT_KV_HEADS * HEAD_DIM,
          MLA_Q_LORA, MLA_KV_LORA, MLA_ROPE,
          WIN_HEADS * HEAD_DIM, WIN_KV_HEADS * HEAD_DIM, WIN_KV_HEADS * HEAD_DIM,
          NA_HEADS * HEAD_DIM, NA_HEADS * HEAD_DIM, NA_HEADS * HEAD_DIM)
D_IN = sum(SPLITS)

kernel_name = 'hybrid_gated_mixers_grouped_moe_dit_block'


def rms_norm(x, g):
    xf = x.astype(jnp.float32)
    xf = xf * lax.rsqrt(jnp.mean(xf * xf, axis=-1, keepdims=True) + EPS)
    return (xf * g.astype(jnp.float32)).astype(x.dtype)


def modulate(h, shift, scale):
    return h * (1 + scale) + shift


def heads(t, n_heads):
    return t.reshape(t.shape[:-1] + (n_heads, t.shape[-1] // n_heads))


def rope_1d(x, pos):
    d2 = x.shape[-1] // 2
    freqs = ROPE_THETA ** (-jnp.arange(d2, dtype=jnp.float32) / d2)
    ang = pos.astype(jnp.float32)[:, None] * freqs[None, :]
    cos = jnp.cos(ang)[None, :, None, :].astype(x.dtype)
    sin = jnp.sin(ang)[None, :, None, :].astype(x.dtype)
    x1, x2 = x[..., :d2], x[..., d2:]
    return jnp.concatenate([x1 * cos - x2 * sin, x1 * sin + x2 * cos], axis=-1)


def axial_rope(x, rows, cols):
    h = x.shape[-1] // 2
    return jnp.concatenate([rope_1d(x[..., :h], rows), rope_1d(x[..., h:], cols)], axis=-1)


def mixer_heads(proj, pos, mla_qa_norm, mla_w_uq, mla_kva_norm, mla_w_ukv,
                qn_att, kn_att, qn_mla, kn_mla, qn_win, kn_win, qn_na, kn_na):
    points, acc = [], 0
    for s in SPLITS[:-1]:
        acc += s
        points.append(acc)
    (a_q, a_k, a_v, m_cq, m_ckv, m_kr, w_q, w_k, w_v, n_q, n_k, n_v) = jnp.split(proj, points, axis=-1)
    if pos is None:
        rope = lambda t: t
    else:
        rope = lambda t: axial_rope(t, pos[0], pos[1])
    att = (rope(rms_norm(heads(a_q, ATT_HEADS), qn_att)),
           rope(rms_norm(heads(a_k, ATT_KV_HEADS), kn_att)),
           heads(a_v, ATT_KV_HEADS))
    q = heads(rms_norm(m_cq, mla_qa_norm) @ mla_w_uq, MLA_HEADS)
    kv = heads(rms_norm(m_ckv, mla_kva_norm) @ mla_w_ukv, MLA_HEADS)
    k_nope, v_m = kv[..., :MLA_NOPE], kv[..., MLA_NOPE:]
    k_rope = jnp.broadcast_to(m_kr[..., None, :], k_nope.shape[:-1] + (MLA_ROPE,))
    q = rms_norm(q, qn_mla)
    k = rms_norm(jnp.concatenate([k_nope, k_rope], axis=-1), kn_mla)
    q = jnp.concatenate([q[..., :MLA_NOPE], rope(q[..., MLA_NOPE:])], axis=-1)
    k = jnp.concatenate([k[..., :MLA_NOPE], rope(k[..., MLA_NOPE:])], axis=-1)
    mla = (q, k, v_m)
    win = (rope(rms_norm(heads(w_q, WIN_HEADS), qn_win)),
           rope(rms_norm(heads(w_k, WIN_KV_HEADS), kn_win)),
           heads(w_v, WIN_KV_HEADS))
    na = (rms_norm(heads(n_q, NA_HEADS), qn_na),
          rms_norm(heads(n_k, NA_HEADS), kn_na),
          heads(n_v, NA_HEADS))
    return att, mla, win, na


def dense_gqa(q, k, v, sink=None):
    b, lq, hq, d = q.shape
    hkv = k.shape[2]
    g = hq // hkv
    qg = q.reshape(b, lq, hkv, g, d)
    s = jnp.einsum('bqkgd,bskd->bkgqs', qg, k).astype(jnp.float32) * (d ** -0.5)
    if sink is None:
        p = jax.nn.softmax(s, axis=-1)
    else:
        s_sink = jnp.broadcast_to(sink.astype(jnp.float32).reshape(1, hkv, g, 1, 1), s.shape[:-1] + (1,))
        p = jax.nn.softmax(jnp.concatenate([s, s_sink], axis=-1), axis=-1)[..., :-1]
    o = jnp.einsum('bkgqs,bskd->bqkgd', p.astype(v.dtype), v)
    return o.reshape(b, lq, hq * v.shape[-1])


def blocked_dense_gqa(q, k_all, v_all):
    b, n, hq, d = q.shape
    qb = q.reshape(b, n // QBLOCK, QBLOCK, hq, d).swapaxes(0, 1)
    o = lax.map(lambda qi: dense_gqa(qi, k_all, v_all), qb)
    return o.swapaxes(0, 1).reshape(b, n, -1)


def windowed_gqa(q, k, v, k_ctx, v_ctx, sink):
    b, n, hq, d = q.shape
    hkv = k.shape[2]
    g = hq // hkv
    wb = WINDOW
    nb = n // wb
    n_ctx = k_ctx.shape[1]
    scale = d ** -0.5

    def band(t):
        tp = jnp.pad(t, ((0, 0), (wb, wb), (0, 0), (0, 0))).reshape(b, nb + 2, wb, hkv, t.shape[-1])
        return jnp.concatenate([tp[:, :-2], tp[:, 1:-1], tp[:, 2:]], axis=2)

    k_band, v_band = band(k), band(v)
    qb = q.reshape(b, nb, wb, hkv, g, d)
    s_loc = jnp.einsum('bnqkgd,bnskd->bnkgqs', qb, k_band).astype(jnp.float32) * scale
    blk = jnp.arange(nb)[:, None, None] * wb
    q_pos = blk + jnp.arange(wb)[None, :, None]
    k_pos = blk - wb + jnp.arange(3 * wb)[None, None, :]
    valid = (jnp.abs(q_pos - k_pos) <= WINDOW) & (k_pos >= 0) & (k_pos < n)
    s_loc = jnp.where(valid[None, :, None, None], s_loc, NEG)
    s_ctx = jnp.einsum('bnqkgd,bskd->bnkgqs', qb, k_ctx).astype(jnp.float32) * scale
    s_sink = jnp.broadcast_to(sink.astype(jnp.float32).reshape(1, 1, hkv, g, 1, 1), s_loc.shape[:-1] + (1,))
    p = jax.nn.softmax(jnp.concatenate([s_loc, s_ctx, s_sink], axis=-1), axis=-1).astype(v.dtype)
    p_loc, p_ctx = p[..., :3 * wb], p[..., 3 * wb:3 * wb + n_ctx]
    o = (jnp.einsum('bnkgqs,bnskd->bnqkgd', p_loc, v_band)
         + jnp.einsum('bnkgqs,bskd->bnqkgd', p_ctx, v_ctx))
    return o.reshape(b, n, hq * v.shape[-1])


def neighbourhood_attn(q, k, v, k_ctx, v_ctx, rpb):
    b, n, h, d = q.shape
    n_rows = n // GRID_W
    kh = min(NA_WIN_H, n_rows)
    kw = NA_WIN_W
    qg = q.reshape(b, n_rows, GRID_W, h, d)
    kg = k.reshape(b, n_rows, GRID_W, h, d)
    vg = v.reshape(b, n_rows, GRID_W, h, v.shape[-1])
    cols = jnp.arange(GRID_W)
    col_idx = jnp.clip(cols - kw // 2, 0, GRID_W - kw)[:, None] + jnp.arange(kw)[None, :]
    dx = col_idx - cols[:, None] + (NA_WIN_W - 1)
    scale = d ** -0.5

    def row(r):
        rs = jnp.clip(r - kh // 2, 0, n_rows - kh)
        k_nb = lax.dynamic_slice_in_dim(kg, rs, kh, axis=1)[:, :, col_idx]
        v_nb = lax.dynamic_slice_in_dim(vg, rs, kh, axis=1)[:, :, col_idx]
        q_r = lax.dynamic_index_in_dim(qg, r, axis=1, keepdims=False)
        dy = rs + jnp.arange(kh) - r + (NA_WIN_H - 1)
        bias = rpb[:, dy][:, :, dx].transpose(0, 2, 1, 3)
        s_nb = jnp.einsum('bwhd,bywkhd->bhwyk', q_r, k_nb).astype(jnp.float32) * scale
        s_nb = s_nb + bias[None].astype(jnp.float32)
        s_ctx = jnp.einsum('bwhd,bshd->bhws', q_r, k_ctx).astype(jnp.float32) * scale
        s = jnp.concatenate([s_nb.reshape(b, h, GRID_W, kh * kw), s_ctx], axis=-1)
        p = jax.nn.softmax(s, axis=-1).astype(v.dtype)
        p_nb = p[..., :kh * kw].reshape(b, h, GRID_W, kh, kw)
        p_ctx = p[..., kh * kw:]
        return (jnp.einsum('bhwyk,bywkhd->bwhd', p_nb, v_nb)
                + jnp.einsum('bhws,bshd->bwhd', p_ctx, v_ctx))

    o = lax.map(row, jnp.arange(n_rows))
    return o.swapaxes(0, 1).reshape(b, n, h * v.shape[-1])


def merge_branches(h, outs, w_branch, w_gate, b_gate, w_out):
    acc = None
    for i, o in enumerate(outs):
        y = jax.nn.sigmoid(h @ w_gate[i] + b_gate[i]) * (o @ w_branch[i])
        acc = y if acc is None else acc + y
    return acc @ w_out


def token_mixer(h, hc, need_ctx, w_in, head_params, win_sink, na_rpb, merge_params):
    n = h.shape[1]
    t = jnp.arange(n)
    pos = (t // GRID_W, t % GRID_W)
    att, mla, win, na = mixer_heads(h @ w_in, pos, *head_params)
    att_c, mla_c, win_c, na_c = mixer_heads(hc @ w_in, None, *head_params)
    cat = lambda a, bb: jnp.concatenate([a, bb], axis=1)
    outs = (blocked_dense_gqa(att[0], cat(att_c[1], att[1]), cat(att_c[2], att[2])),
            blocked_dense_gqa(mla[0], cat(mla_c[1], mla[1]), cat(mla_c[2], mla[2])),
            windowed_gqa(win[0], win[1], win[2], win_c[1], win_c[2], win_sink),
            neighbourhood_attn(na[0], na[1], na[2], na_c[1], na_c[2], na_rpb))
    y = merge_branches(h, outs, *merge_params)
    if not need_ctx:
        return y, None
    outs_c = (dense_gqa(*att_c), dense_gqa(*mla_c), dense_gqa(*win_c, sink=win_sink), dense_gqa(*na_c))
    yc = merge_branches(hc, outs_c, *merge_params)
    return y, yc


def moe(h, w_router, b_router, w1, w3, w2):
    shape = h.shape
    t = h.reshape(-1, shape[-1])
    scores = jax.nn.sigmoid((t @ w_router).astype(jnp.float32))
    biased = scores + b_router.astype(jnp.float32)
    grp = biased.reshape(-1, N_GROUPS, N_EXPERTS // N_GROUPS)
    grp_score = lax.top_k(grp, 2)[0].sum(axis=-1)
    _, g_idx = lax.top_k(grp_score, TOPK_GROUPS)
    g_mask = jax.nn.one_hot(g_idx, N_GROUPS, dtype=jnp.float32).sum(axis=-2)
    e_mask = jnp.repeat(g_mask, N_EXPERTS // N_GROUPS, axis=-1)
    _, e_idx = lax.top_k(jnp.where(e_mask > 0, biased, NEG), TOP_K)
    w = jnp.take_along_axis(scores, e_idx, axis=-1)
    w = w / jnp.sum(w, axis=-1, keepdims=True)
    combine = jnp.sum(jax.nn.one_hot(e_idx, N_EXPERTS, dtype=jnp.float32) * w[..., None], axis=-2).astype(t.dtype)
    out = jnp.zeros_like(t)
    for e in range(N_EXPERTS):
        hid = jax.nn.silu(t @ w1[e]) * (t @ w3[e])
        out = out + combine[:, e:e + 1] * (hid @ w2[e])
    return out.reshape(shape)


def setup_inputs(seed: int = 0) -> dict:
    key = jax.random.key(seed)
    keys = jax.random.split(key, 32)

    def nrm(i, shape, scale):
        return jax.random.normal(keys[i], shape, jnp.float32) * scale

    def gain(i, shape):
        return 1.0 + nrm(i, shape, 0.02)

    L, D = DEPTH, D_MODEL
    return {
        'x': nrm(0, (BATCH, SEQ, D), 1.0),
        'c': nrm(1, (BATCH, D), 1.0),
        'ctx': nrm(2, (BATCH, CTX_LEN, D), 1.0),
        'c_ctx': nrm(3, (D,), 1.0),
        'w_mod': nrm(4, (L, D, 6 * D), 0.5 * D ** -0.5),
        'b_mod': nrm(5, (L, 6 * D), 0.02),
        'norm_mix': gain(6, (L, D)),
        'norm_ffn': gain(7, (L, D)),
        'w_in': nrm(8, (L, D, D_IN), D ** -0.5),
        'mla_qa_norm': gain(9, (L, MLA_Q_LORA)),
        'mla_w_uq': nrm(10, (L, MLA_Q_LORA, MLA_HEADS * (MLA_NOPE + MLA_ROPE)), MLA_Q_LORA ** -0.5),
        'mla_kva_norm': gain(11, (L, MLA_KV_LORA)),
        'mla_w_ukv': nrm(12, (L, MLA_KV_LORA, MLA_HEADS * (MLA_NOPE + MLA_V)), MLA_KV_LORA ** -0.5),
        'qn_att': gain(13, (L, HEAD_DIM)),
        'kn_att': gain(14, (L, HEAD_DIM)),
        'qn_mla': gain(15, (L, MLA_NOPE + MLA_ROPE)),
        'kn_mla': gain(16, (L, MLA_NOPE + MLA_ROPE)),
        'qn_win': gain(17, (L, HEAD_DIM)),
        'kn_win': gain(18, (L, HEAD_DIM)),
        'qn_na': gain(19, (L, HEAD_DIM)),
        'kn_na': gain(20, (L, HEAD_DIM)),
        'win_sink': nrm(21, (L, WIN_HEADS), 1.0),
        'na_rpb': nrm(22, (L, NA_HEADS, 2 * NA_WIN_H - 1, 2 * NA_WIN_W - 1), 0.5),
        'w_branch': nrm(23, (L, N_BRANCH, BRANCH_W, D), BRANCH_W ** -0.5),
        'w_gate': nrm(24, (L, N_BRANCH, D, D), D ** -0.5),
        'b_gate': nrm(25, (L, N_BRANCH, D), 0.02),
        'w_out': nrm(26, (L, D, D), D ** -0.5),
        'w_router': nrm(27, (D, N_EXPERTS), D ** -0.5),
        'b_router': nrm(28, (N_EXPERTS,), 0.01),
        'moe_w1': nrm(29, (L, N_EXPERTS, D, D_EXPERT), D ** -0.5),
        'moe_w3': nrm(30, (L, N_EXPERTS, D, D_EXPERT), D ** -0.5),
        'moe_w2': nrm(31, (L, N_EXPERTS, D_EXPERT, D), D_EXPERT ** -0.5),
    }


def reference(x, c, ctx, c_ctx, w_mod, b_mod, norm_mix, norm_ffn, w_in,
              mla_qa_norm, mla_w_uq, mla_kva_norm, mla_w_ukv,
              qn_att, kn_att, qn_mla, kn_mla, qn_win, kn_win, qn_na, kn_na,
              win_sink, na_rpb, w_branch, w_gate, b_gate, w_out,
              w_router, b_router, moe_w1, moe_w3, moe_w2):
    c_s = jax.nn.silu(c)
    cc_s = jax.nn.silu(c_ctx)
    xc = ctx
    for l in range(DEPTH):
        need_ctx = l < DEPTH - 1
        mod = c_s @ w_mod[l] + b_mod[l]
        mod_c = cc_s @ w_mod[l] + b_mod[l]
        sh1, sc1, g1, sh2, sc2, g2 = jnp.split(mod[:, None, :], 6, axis=-1)
        sh1c, sc1c, g1c, sh2c, sc2c, g2c = jnp.split(mod_c, 6, axis=-1)
        head_params = (mla_qa_norm[l], mla_w_uq[l], mla_kva_norm[l], mla_w_ukv[l],
                       qn_att[l], kn_att[l], qn_mla[l], kn_mla[l],
                       qn_win[l], kn_win[l], qn_na[l], kn_na[l])
        merge_params = (w_branch[l], w_gate[l], b_gate[l], w_out[l])
        h = modulate(rms_norm(x, norm_mix[l]), sh1, sc1)
        hc = modulate(rms_norm(xc, norm_mix[l]), sh1c, sc1c)
        y, yc = token_mixer(h, hc, need_ctx, w_in[l], head_params, win_sink[l], na_rpb[l], merge_params)
        x = x + g1 * y
        h2 = modulate(rms_norm(x, norm_ffn[l]), sh2, sc2)
        x = x + g2 * moe(h2, w_router, b_router, moe_w1[l], moe_w3[l], moe_w2[l])
        if need_ctx:
            xc = xc + g1c * yc
            hc2 = modulate(rms_norm(xc, norm_ffn[l]), sh2c, sc2c)
            xc = xc + g2c * moe(hc2, w_router, b_router, moe_w1[l], moe_w3[l], moe_w2[l])
    return x
```

```cpp
#include <hip/hip_runtime.h>
#include <cstdio>
#include <cstdint>

#ifndef FAST_MASK
#define FAST_MASK 127
#endif
#ifndef REP_PRO
#define REP_PRO 1
#endif
#ifndef REP_ATT
#define REP_ATT 1
#endif
#ifndef REP_GEMM
#define REP_GEMM 1
#endif
#ifndef REP_MOE
#define REP_MOE 1
#endif
#ifndef PREFIX_K
#define PREFIX_K 0
#endif
#ifndef FA_SEL
#define FA_SEL 31
#endif
#ifndef MK_N_LAUNCHES
#define MK_N_LAUNCHES 1
#endif

constexpr int DM = 2048, NB = 2, SEQ = 8192, NCTX = 256, TL = NB * SEQ, TC = NB * NCTX, TT = TL + TC, DEPTH = 2;
constexpr int DIN = 4288, PP = 4352;
constexpr int C_AQ = 0, C_AK = 512, C_AV = 768, C_MCQ = 1024, C_MCKV = 1408, C_MKR = 1664, C_WQ = 1728, C_WK = 2240, C_WV = 2496, C_NQ = 2752, C_NK = 3264, C_NV = 3776;
constexpr int NEXP = 16, DEXP = 512;
constexpr float EPS = 1e-6f;
constexpr float BV_SCALE = 64.0f;
constexpr float ACC_SCALE = 64.0f;
constexpr float OUT_SCALE = 32.0f;
constexpr float GATE_WSCALE = 32.0f;
constexpr int NWAVES = 8, NTHREADS = 512;

constexpr size_t MiB = 1u << 20;
constexpr size_t WS_CTL = 0, CTL_ZERO_BYTES = 1 * MiB;
constexpr size_t WS_MOD = 1 * MiB;
constexpr size_t WS_ROPE = 1 * MiB + 512 * 1024;
constexpr size_t WS_XC = 2 * MiB;
constexpr size_t WS_ELIST = 7 * MiB;
constexpr size_t WS_ELW = 9 * MiB;
constexpr size_t WS_H = 16 * MiB;
constexpr size_t WS_PROJ = 82 * MiB;
constexpr size_t WS_MQ = 223 * MiB;
constexpr size_t WS_MKV = 248 * MiB;
constexpr size_t WS_MK = 281 * MiB;
constexpr int MCP = 640, MQP = 1792;
constexpr size_t WS_HID = 306 * MiB;
constexpr size_t WS_BV = 82 * MiB;
constexpr size_t WS_OUTS = 346 * MiB;
constexpr size_t WS_ACC = 412 * MiB;
constexpr size_t WS_W = 478 * MiB;
constexpr size_t WL_STRIDE = 163 * MiB;
constexpr size_t WO_IN = 0, WO_UQ = 17 * MiB, WO_UKV = 18 * MiB, WO_G = 19 * MiB, WO_B = 51 * MiB, WO_O = 59 * MiB, WO_13 = 67 * MiB, WO_2 = 131 * MiB;
constexpr size_t WS_H8 = 804 * MiB;
constexpr size_t WS_Q8 = 838 * MiB;
constexpr size_t WS_K8 = 876 * MiB;
constexpr size_t WS_V8T = 905 * MiB;
constexpr size_t WS_END = 930 * MiB;
constexpr int Q8P = 2304, K8P = 1792, VTP = 8448;
constexpr int Q8_A = 0, Q8_W = 512, Q8_N = 1024, Q8_M = 1536, K8_A = 0, K8_W = 256, K8_N = 512, K8_M = 1024;
static_assert(WS_BV + (size_t)TT * 8192 * 2 <= WS_OUTS && WS_HID + (size_t)148 * 256 * 512 * 2 <= WS_OUTS && WS_W + 2 * WL_STRIDE <= WS_END, "d_ws map");
constexpr int CW_ECNT = 64;
constexpr int CW_BAR = 4096;

typedef unsigned short bf16_t;
#define LAS __attribute__((address_space(3)))
#define GAS __attribute__((address_space(1)))
typedef float f32x4 __attribute__((ext_vector_type(4)));
typedef unsigned u32x4 __attribute__((ext_vector_type(4)));
typedef unsigned u32x2 __attribute__((ext_vector_type(2)));
typedef float f32x2v __attribute__((ext_vector_type(2)));

__device__ __forceinline__ float bf2f(unsigned v) { return __uint_as_float(v << 16); }
__device__ __forceinline__ unsigned f2bf(float f) { unsigned u = __float_as_uint(f); return (u + 0x7fffu + ((u >> 16) & 1u)) >> 16; }
__device__ __forceinline__ unsigned pk2(float lo, float hi) { return f2bf(lo) | (f2bf(hi) << 16); }
__device__ __forceinline__ float lo16(unsigned w) { return __uint_as_float(w << 16); }
__device__ __forceinline__ float hi16(unsigned w) { return __uint_as_float(w & 0xffff0000u); }
__device__ __forceinline__ int cvt8s(float a, float b, int old, bool hi) {
    a = __builtin_amdgcn_fmed3f(a, -448.f, 448.f); b = __builtin_amdgcn_fmed3f(b, -448.f, 448.f);
    return hi ? __builtin_amdgcn_cvt_pk_fp8_f32(a, b, old, true) : __builtin_amdgcn_cvt_pk_fp8_f32(a, b, old, false);
}
__device__ __forceinline__ float wave_sum(float v) {
#pragma unroll
    for (int o = 1; o < 64; o <<= 1) v += __shfl_xor(v, o);
    return v;
}
__device__ __forceinline__ float sigmoidf_(float x) { return 1.0f / (1.0f + __expf(-x)); }
__device__ __forceinline__ float siluf_(float x) { return x / (1.0f + __expf(-x)); }

#define XB_TMO      128
#define XB_XCNT(j)  (256  + 64 * (j))
#define XB_XSUB(j)  (1280 + 64 * (j))
#define XB_XGEN(j)  (2304 + 64 * (j))
#define XB_TOP      3328
#define XB_TOPGEN   3392
#define XCD_BAR_WORDS 3456
#define XB_SPIN_CAP (1u << 22)

__device__ __forceinline__ unsigned xb_ld(unsigned* p)              { return __hip_atomic_load(p, __ATOMIC_RELAXED, __HIP_MEMORY_SCOPE_AGENT); }
__device__ __forceinline__ unsigned xb_add(unsigned* p, unsigned v) { return __hip_atomic_fetch_add(p, v, __ATOMIC_RELAXED, __HIP_MEMORY_SCOPE_AGENT); }
__device__ __forceinline__ unsigned xb_xcc_id() { return (unsigned)__builtin_amdgcn_s_getreg((3 << 11) | 20) & 0xFu; }
#define XB_SPIN(cond, bar) do { unsigned _sp = 0; while (cond) { __builtin_amdgcn_s_sleep(1); \
    if ((++_sp & 255u) == 0u) { if (xb_ld(&(bar)[XB_TMO])) break; if (_sp > XB_SPIN_CAP) { atomicAdd(&(bar)[XB_TMO], 1u); break; } } } } while (0)

struct XcdBarrier { unsigned* bar; unsigned x; volatile LAS unsigned* st; };

__device__ __forceinline__ XcdBarrier xcd_barrier_post(unsigned* bar, volatile LAS unsigned* st, int tid) {
    XcdBarrier b; b.bar = bar; b.x = xb_xcc_id(); b.st = st;
    if (tid == 0) (void)xb_add(&bar[XB_XCNT(b.x)], 1u);
    return b;
}
__device__ __forceinline__ void xcd_barrier_complete(unsigned* bar, unsigned x, unsigned& nloc, unsigned& nx) {
    const unsigned G = gridDim.x * gridDim.y * gridDim.z;
    unsigned sum, cnt, mine, sp = 0u;
    for (;;) {
        sum = 0u; cnt = 0u; mine = 0u;
#pragma unroll
        for (unsigned j = 0; j < 16; ++j) { const unsigned c = xb_ld(&bar[XB_XCNT(j)]); sum += c; cnt += (c > 0u) ? 1u : 0u; mine = (j == x) ? c : mine; }
        if (sum == G) break;
        __builtin_amdgcn_s_sleep(1);
        if ((++sp & 255u) == 0u) { if (xb_ld(&bar[XB_TMO])) break; if (sp > XB_SPIN_CAP) { atomicAdd(&bar[XB_TMO], 1u); break; } }
    }
    nloc = mine > 0u ? mine : 1u; nx = cnt > 0u ? cnt : 1u;
}
__device__ __forceinline__ void xcd_barrier(const XcdBarrier& b, int tid) {
    asm volatile("s_waitcnt vmcnt(0)" ::: "memory");
    __syncthreads();
    if (tid == 0) {
        unsigned* bar = b.bar;
        __builtin_amdgcn_s_waitcnt(0);
        unsigned nloc = b.st[0], nx = b.st[1];
        if (nloc == 0u) { xcd_barrier_complete(bar, b.x, nloc, nx); b.st[0] = nloc; b.st[1] = nx; }
        const unsigned old = xb_add(&bar[XB_XSUB(b.x)], 1u);
        const unsigned gen = old / nloc;
        if (old + 1u == (gen + 1u) * nloc) {
            __builtin_amdgcn_fence(__ATOMIC_RELEASE, "agent");
            asm volatile("s_waitcnt vmcnt(0)" ::: "memory");
            const unsigned og = xb_add(&bar[XB_TOP], 1u);
            const unsigned tg = og / nx;
            if (og + 1u == (tg + 1u) * nx) xb_add(&bar[XB_TOPGEN], 1u);
            else XB_SPIN(xb_ld(&bar[XB_TOPGEN]) == tg, bar);
            __builtin_amdgcn_fence(__ATOMIC_ACQUIRE, "agent");
            xb_add(&bar[XB_XGEN(b.x)], 1u);
            asm volatile("s_waitcnt vmcnt(0)" ::: "memory");
        } else {
            XB_SPIN(xb_ld(&bar[XB_XGEN(b.x)]) == gen, bar);
            __builtin_amdgcn_fence(__ATOMIC_ACQUIRE, "agent");
            asm volatile("s_waitcnt vmcnt(0)" ::: "memory");
        }
    }
    __syncthreads();
}

struct Args { const float* in[32]; float* out; unsigned char* ws; int ph_lo, ph_hi; };

struct Frame {
    LAS unsigned char* lds;
    float* out; unsigned char* ws;
    int tid, lane, wave, G, bid;
    __device__ __forceinline__ const float* in(int k) const {
        const __attribute__((address_space(4))) char* ka = (const __attribute__((address_space(4))) char*)__builtin_amdgcn_kernarg_segment_ptr();
        int z = 0; asm volatile("" : "+v"(z)); z = __builtin_amdgcn_readfirstlane(z);
        return *(const float* const __attribute__((address_space(4)))*)(ka + k * 8 + z);
    }
};
__device__ __forceinline__ float* xs_row(const Frame& F, int r) { return r < TL ? F.out + (size_t)r * DM : (float*)(F.ws + WS_XC) + (size_t)(r - TL) * DM; }
__device__ __forceinline__ const float* xin_row(const Frame& F, int l, int r) {
    if (l == 0) return r < TL ? F.in(0) + (size_t)r * DM : F.in(2) + (size_t)(r - TL) * DM;
    return xs_row(F, r);
}
__device__ __forceinline__ const float* mod_vec(const Frame& F, int l, int r, int which) {
    const int s = r < TL ? (r / SEQ) : 2;
    return (const float*)(F.ws + WS_MOD) + (size_t)(l * 3 + s) * 6 * DM + which * DM;
}

__device__ __forceinline__ void launder(Frame& F) {
    asm volatile("" : "+s"(F.wave), "+s"(F.bid), "+s"(F.G));
    int z = 0; asm volatile("" : "+v"(z));
    F.lane = (int)__builtin_amdgcn_mbcnt_hi(~0u, __builtin_amdgcn_mbcnt_lo(~0u, (unsigned)z)); F.tid = F.wave * 64 + F.lane;
}

__device__ __forceinline__ void ph_mod(Frame& F) {
    LAS float* sv = (LAS float*)F.lds;
    LAS float* red = sv + 3 * DM;
    for (int i = F.tid; i < 3 * DM; i += NTHREADS) { const int s = i / DM, k = i % DM; const float v = s < 2 ? F.in(1)[s * DM + k] : F.in(3)[k]; sv[i] = siluf_(v); }
    __syncthreads();
    for (int item = F.bid; item < DEPTH * 96; item += F.G) {
        const int l = item / 96, ch = item % 96, col = ch * 128 + F.lane * 2;
        const float* W = F.in(4) + (size_t)l * DM * 6 * DM + col;
        float a[3][2] = {{0.f, 0.f}, {0.f, 0.f}, {0.f, 0.f}};
        const int k0 = F.wave * 256;
#pragma unroll 8
        for (int k = 0; k < 256; ++k) {
            const float2 w = *(const float2*)(W + (size_t)(k0 + k) * 6 * DM);
#pragma unroll
            for (int s = 0; s < 3; ++s) { const float x = sv[s * DM + k0 + k]; a[s][0] += x * w.x; a[s][1] += x * w.y; }
        }
#pragma unroll
        for (int s = 0; s < 3; ++s) { red[(F.wave * 3 + s) * 128 + F.lane * 2] = a[s][0]; red[(F.wave * 3 + s) * 128 + F.lane * 2 + 1] = a[s][1]; }
        __syncthreads();
        if (F.tid < 384) {
            const int s = F.tid / 128, c = F.tid % 128; float t = 0.f;
#pragma unroll
            for (int w = 0; w < 8; ++w) t += red[(w * 3 + s) * 128 + c];
            const int j = ch * 128 + c;
            ((float*)(F.ws + WS_MOD))[(size_t)(l * 3 + s) * 6 * DM + j] = t + F.in(5)[(size_t)l * 6 * DM + j];
        }
        __syncthreads();
    }
}

__device__ __forceinline__ void ph_prep1(Frame& F, int l) {
    const int gw = F.bid * NWAVES + F.wave, NGW = F.G * NWAVES;
    const int nrows = (l == DEPTH) ? TL : TT;
    const bf16_t* Y = (const bf16_t*)(F.ws + WS_PROJ);
    bf16_t* H = (bf16_t*)(F.ws + WS_H);
    const float* gn_mix = F.in(6) + (size_t)(l < DEPTH ? l : 0) * DM;
    for (int r = gw; r < nrows; r += NGW) {
        f32x4 v[8];
        const float* xr = xin_row(F, l == 0 ? 0 : 1, r);
#pragma unroll
        for (int j = 0; j < 8; ++j) v[j] = *(const f32x4*)(xr + j * 256 + F.lane * 4);
        if (l > 0) {
            const bool has_moe = (l == 1) || (r < TL);
            if (has_moe) {
                const float* g2 = mod_vec(F, l - 1, r, 5);
                const bf16_t* y0 = Y + (size_t)r * DM, *y1 = Y + (size_t)TT * DM + (size_t)r * DM;
#pragma unroll
                for (int j = 0; j < 8; ++j) {
                    const int c = j * 256 + F.lane * 4;
                    const u32x2 a = *(const u32x2*)(y0 + c), b = *(const u32x2*)(y1 + c); const f32x4 g = *(const f32x4*)(g2 + c);
                    v[j].x += g.x * (lo16(a.x) + lo16(b.x)); v[j].y += g.y * (hi16(a.x) + hi16(b.x));
                    v[j].z += g.z * (lo16(a.y) + lo16(b.y)); v[j].w += g.w * (hi16(a.y) + hi16(b.y));
                }
                float* xo = xs_row(F, r);
#pragma unroll
                for (int j = 0; j < 8; ++j) *(f32x4*)(xo + j * 256 + F.lane * 4) = v[j];
            }
        }
        if (l == DEPTH) continue;
        float ss = 0.f;
#pragma unroll
        for (int j = 0; j < 8; ++j) ss += v[j].x * v[j].x + v[j].y * v[j].y + v[j].z * v[j].z + v[j].w * v[j].w;
        const float rstd = rsqrtf(wave_sum(ss) * (1.0f / DM) + EPS);
        const float* gn = gn_mix; const float* sh = mod_vec(F, l, r, 0); const float* sc = mod_vec(F, l, r, 1);
#pragma unroll
        for (int j = 0; j < 8; ++j) {
            const int c = j * 256 + F.lane * 4;
            const f32x4 g = *(const f32x4*)(gn + c), s1 = *(const f32x4*)(sc + c), s0 = *(const f32x4*)(sh + c);
            const f32x4 h = (v[j] * rstd * g) * (s1 + 1.0f) + s0;
            if (!(FAST_MASK & 1)) { u32x2 w; w.x = pk2(h.x, h.y); w.y = pk2(h.z, h.w); *(u32x2*)(H + (size_t)r * DM + c) = w; }
            int w8 = 0; w8 = cvt8s(h.x, h.y, w8, false); w8 = cvt8s(h.z, h.w, w8, true);
            *(int*)(F.ws + WS_H8 + (size_t)r * DM + c) = w8;
        }
    }
}

__device__ __forceinline__ void ngemm_tile(float (&acc)[4][4], const bf16_t* A, int lda, const float* B, int ldb, int K, int row0, int col0, LAS float* lds, int tid) {
    LAS float* As = lds;
    LAS float* Bs = lds + 16 * 132;
    const int ty = tid >> 4, tx = tid & 15;
    const int ar = tid >> 2, ak = (tid & 3) * 4;
    const int bk = (tid & 255) >> 4, bc = (tid & 15) * 4;
    for (int k0 = 0; k0 < K; k0 += 16) {
        const u32x2 av = *(const u32x2*)(A + (size_t)(row0 + ar) * lda + k0 + ak);
        f32x4 bv = (f32x4){0.f, 0.f, 0.f, 0.f};
        if (tid < 256) bv = *(const f32x4*)(B + (size_t)(k0 + bk) * ldb + col0 + bc);
        __syncthreads();
        As[(ak + 0) * 132 + ar] = lo16(av.x); As[(ak + 1) * 132 + ar] = hi16(av.x); As[(ak + 2) * 132 + ar] = lo16(av.y); As[(ak + 3) * 132 + ar] = hi16(av.y);
        if (tid < 256) *(LAS f32x4*)(Bs + bk * 64 + bc) = bv;
        __syncthreads();
#pragma unroll
        for (int kk = 0; kk < 16; ++kk) {
            const f32x4 a = *(const LAS f32x4*)(As + kk * 132 + ty * 4);
            const f32x4 b = *(const LAS f32x4*)(Bs + kk * 64 + tx * 4);
#pragma unroll
            for (int i = 0; i < 4; ++i)
#pragma unroll
                for (int j = 0; j < 4; ++j) acc[i][j] += a[i] * b[j];
        }
    }
    __syncthreads();
}
#define ZERO44(a) do { _Pragma("unroll") for (int i_ = 0; i_ < 4; ++i_) _Pragma("unroll") for (int j_ = 0; j_ < 4; ++j_) a[i_][j_] = 0.f; } while (0)

__device__ __forceinline__ void ph_ngemm_bf16(Frame& F, const bf16_t* A, int lda, const float* B, int ldb, int K, int M, int N, bf16_t* C, int ldc) {
    const int nn = N / 64, ntiles = (M / 128) * nn;
    const int ty = F.tid >> 4, tx = F.tid & 15;
    for (int t = F.bid; t < ntiles; t += F.G) {
        const int row0 = (t / nn) * 128, col0 = (t % nn) * 64;
        float acc[4][4]; ZERO44(acc);
        ngemm_tile(acc, A, lda, B, ldb, K, row0, col0, (LAS float*)F.lds, F.tid);
#pragma unroll
        for (int i = 0; i < 4; ++i) { u32x2 w; w.x = pk2(acc[i][0], acc[i][1]); w.y = pk2(acc[i][2], acc[i][3]);
            *(u32x2*)(C + (size_t)(row0 + ty * 4 + i) * ldc + col0 + tx * 4) = w; }
    }
}

__device__ __forceinline__ float rope_freq(int i, int n) { return exp2f(-(float)i * (13.287712379549449f / (float)n)); }
__device__ __forceinline__ void head128(bf16_t* p, const float* g, bool rope, int prow, int pcol, int lane) {
    float e0 = bf2f(p[lane]), e1 = bf2f(p[lane + 64]);
    const float rstd = rsqrtf(wave_sum(e0 * e0 + e1 * e1) * (1.0f / 128.0f) + EPS);
    e0 = e0 * rstd * g[lane]; e1 = e1 * rstd * g[lane + 64];
    if (rope) {
        const float fr = rope_freq(lane & 31, 32);
        float s0, c0, s1, c1; sincosf((float)prow * fr, &s0, &c0); sincosf((float)pcol * fr, &s1, &c1);
        const float p0 = __shfl_xor(e0, 32), p1 = __shfl_xor(e1, 32);
        if (lane < 32) { e0 = e0 * c0 - p0 * s0; e1 = e1 * c1 - p1 * s1; }
        else { e0 = p0 * s0 + e0 * c0; e1 = p1 * s1 + e1 * c1; }
    }
    p[lane] = (bf16_t)f2bf(e0); p[lane + 64] = (bf16_t)f2bf(e1);
}
__device__ __forceinline__ void ph_prep2(Frame& F, int l) {
    const int gw = F.bid * NWAVES + F.wave, NGW = F.G * NWAVES, lane = F.lane;
    bf16_t* PROJ = (bf16_t*)(F.ws + WS_PROJ);
    for (int r = gw; r < TT; r += NGW) {
        bf16_t* p = PROJ + (size_t)r * PP;
        const bool lat = r < TL; const int t = r % SEQ, prow = t / 64, pcol = t % 64;
        for (int h = 0; h < 4; ++h) head128(p + C_AQ + h * 128, F.in(13) + l * 128, lat, prow, pcol, lane);
        for (int h = 0; h < 2; ++h) head128(p + C_AK + h * 128, F.in(14) + l * 128, lat, prow, pcol, lane);
        for (int h = 0; h < 4; ++h) head128(p + C_WQ + h * 128, F.in(17) + l * 128, lat, prow, pcol, lane);
        for (int h = 0; h < 2; ++h) head128(p + C_WK + h * 128, F.in(18) + l * 128, lat, prow, pcol, lane);
        for (int h = 0; h < 4; ++h) head128(p + C_NQ + h * 128, F.in(19) + l * 128, false, 0, 0, lane);
        for (int h = 0; h < 4; ++h) head128(p + C_NK + h * 128, F.in(20) + l * 128, false, 0, 0, lane);
        {
            float e[6]; float ss = 0.f;
#pragma unroll
            for (int j = 0; j < 6; ++j) { e[j] = bf2f(p[C_MCQ + j * 64 + lane]); ss += e[j] * e[j]; }
            const float rstd = rsqrtf(wave_sum(ss) * (1.0f / 384.0f) + EPS);
#pragma unroll
            for (int j = 0; j < 6; ++j) p[C_MCQ + j * 64 + lane] = (bf16_t)f2bf(e[j] * rstd * F.in(9)[l * 384 + j * 64 + lane]);
        }
        {
            float e[4]; float ss = 0.f;
#pragma unroll
            for (int j = 0; j < 4; ++j) { e[j] = bf2f(p[C_MCKV + j * 64 + lane]); ss += e[j] * e[j]; }
            const float rstd = rsqrtf(wave_sum(ss) * (1.0f / 256.0f) + EPS);
#pragma unroll
            for (int j = 0; j < 4; ++j) p[C_MCKV + j * 64 + lane] = (bf16_t)f2bf(e[j] * rstd * F.in(11)[l * 256 + j * 64 + lane]);
        }
    }
}

__device__ __forceinline__ void mla_head(float e0, float e1, float e2, const float* g, bool rope, int prow, int pcol, int lane, bf16_t* dst) {
    const float rstd = rsqrtf(wave_sum(e0 * e0 + e1 * e1 + e2 * e2) * (1.0f / 192.0f) + EPS);
    e0 = e0 * rstd * g[lane]; e1 = e1 * rstd * g[64 + lane]; e2 = e2 * rstd * g[128 + lane];
    if (rope) {
        const float fr = rope_freq(lane & 15, 16); const int pos = (lane < 32) ? prow : pcol;
        float s, c; sincosf((float)pos * fr, &s, &c);
        const float pr = __shfl_xor(e2, 16);
        e2 = ((lane & 31) < 16) ? (e2 * c - pr * s) : (pr * s + e2 * c);
    }
    dst[lane] = (bf16_t)f2bf(e0); dst[64 + lane] = (bf16_t)f2bf(e1); dst[128 + lane] = (bf16_t)f2bf(e2);
}
__device__ __forceinline__ void ph_prep3(Frame& F, int l) {
    const int gw = F.bid * NWAVES + F.wave, NGW = F.G * NWAVES, lane = F.lane;
    const bf16_t* PROJ = (const bf16_t*)(F.ws + WS_PROJ); bf16_t* MQ = (bf16_t*)(F.ws + WS_MQ); const bf16_t* MKV = (const bf16_t*)(F.ws + WS_MKV); bf16_t* MK = (bf16_t*)(F.ws + WS_MK);
    for (int r = gw; r < TT; r += NGW) {
        const bool lat = r < TL; const int t = r % SEQ, prow = t / 64, pcol = t % 64;
        const float kr = bf2f(PROJ[(size_t)r * PP + C_MKR + lane]);
        for (int h = 0; h < 4; ++h) {
            bf16_t* q = MQ + (size_t)r * 768 + h * 192;
            mla_head(bf2f(q[lane]), bf2f(q[64 + lane]), bf2f(q[128 + lane]), F.in(15) + l * 192, lat, prow, pcol, lane, q);
            const bf16_t* kv = MKV + (size_t)r * 1024 + h * 256;
            mla_head(bf2f(kv[lane]), bf2f(kv[64 + lane]), kr, F.in(16) + l * 192, lat, prow, pcol, lane, MK + (size_t)r * 768 + h * 192);
        }
    }
}

constexpr int RT_ROW128 = 0, RT_COL128 = 128 * 32, RT_ROW64 = RT_COL128 + 64 * 32, RT_COL64 = RT_ROW64 + 128 * 16, RT_N = RT_COL64 + 64 * 16;
__device__ __forceinline__ void rope_tables_build(Frame& F) {
    f32x2v* tab = (f32x2v*)(F.ws + WS_ROPE);
    for (int i = F.bid * NTHREADS + F.tid; i < RT_N; i += F.G * NTHREADS) {
        int pos, fi, n;
        if (i < RT_COL128) { pos = i >> 5; fi = i & 31; n = 32; } else if (i < RT_ROW64) { pos = (i - RT_COL128) >> 5; fi = i & 31; n = 32; }
        else if (i < RT_COL64) { pos = (i - RT_ROW64) >> 4; fi = i & 15; n = 16; } else { pos = (i - RT_COL64) >> 4; fi = i & 15; n = 16; }
        float sn, cs; sincosf((float)pos * rope_freq(fi, n), &sn, &cs); tab[i] = (f32x2v){cs, sn};
    }
}
__device__ __forceinline__ void rope_tables(Frame& F, LAS f32x2v* tab) {
    const u32x4* src = (const u32x4*)(F.ws + WS_ROPE);
    for (int i = F.tid; i < RT_N / 2; i += NTHREADS) ((LAS u32x4*)tab)[i] = src[i];
    __syncthreads();
}
__device__ __forceinline__ void unpack8(const u32x4 w, float (&e)[8]) { e[0] = lo16(w.x); e[1] = hi16(w.x); e[2] = lo16(w.y); e[3] = hi16(w.y); e[4] = lo16(w.z); e[5] = hi16(w.z); e[6] = lo16(w.w); e[7] = hi16(w.w); }
__device__ __forceinline__ u32x4 pack8(const float (&e)[8]) { u32x4 w; w.x = pk2(e[0], e[1]); w.y = pk2(e[2], e[3]); w.z = pk2(e[4], e[5]); w.w = pk2(e[6], e[7]); return w; }
__device__ __forceinline__ u32x2 pack8_fp8(const float (&e)[8]) { int a = 0, b = 0;
    a = cvt8s(e[0], e[1], a, false); a = cvt8s(e[2], e[3], a, true);
    b = cvt8s(e[4], e[5], b, false); b = cvt8s(e[6], e[7], b, true);
    u32x2 o; o.x = (unsigned)a; o.y = (unsigned)b; return o; }
__device__ __forceinline__ void vtrans_item(const bf16_t* src, int pitch, int b, int tb, unsigned char* dst  , LAS unsigned char* scr, int lane) {
    const int krow = tb < 4 ? TL + b * NCTX + tb * 64 + lane : b * SEQ + (tb - 4) * 64 + lane;
    const bf16_t* p = src + (size_t)krow * pitch;
    u32x4 w[8];
#pragma unroll
    for (int i = 0; i < 8; ++i) w[i] = *(const u32x4*)(p + i * 8);
    const int pos = 32 * ((lane >> 2) & 1) + (lane & 3) + 4 * ((lane >> 3) & 3) + 16 * (lane >> 5);
#pragma unroll
    for (int i = 0; i < 8; ++i) { float e[8]; unpack8(w[i], e); const u32x2 q = pack8_fp8(e);
#pragma unroll
        for (int j = 0; j < 4; ++j) { scr[(i * 8 + j) * 80 + pos] = (unsigned char)(q.x >> (8 * j)); scr[(i * 8 + 4 + j) * 80 + pos] = (unsigned char)(q.y >> (8 * j)); } }
    asm volatile("s_waitcnt lgkmcnt(0)" ::: "memory");
    unsigned char* o = dst + (size_t)lane * VTP + tb * 64;
#pragma unroll
    for (int c = 0; c < 4; ++c) *(u32x4*)(o + c * 16) = *(const LAS u32x4*)(scr + lane * 80 + c * 16);
    asm volatile("s_waitcnt lgkmcnt(0)" ::: "memory");
}
__device__ __forceinline__ float ssq8(const float (&e)[8]) { float s = 0.f;
#pragma unroll
    for (int i = 0; i < 8; ++i) s += e[i] * e[i]; return s; }
__device__ __forceinline__ float group16_sum(float v) { v += __shfl_xor(v, 1); v += __shfl_xor(v, 2); v += __shfl_xor(v, 4); v += __shfl_xor(v, 8); return v; }
__device__ __forceinline__ u32x2 head128_w(const u32x4 w, const float* g, bool rope, int prow, int pcol, int j, const LAS f32x2v* tab) {
    float e[8]; unpack8(w, e);
    const float rstd = rsqrtf(group16_sum(ssq8(e)) * (1.0f / 128.0f) + EPS);
    const f32x4 g0 = *(const f32x4*)(g + 8 * j), g1 = *(const f32x4*)(g + 8 * j + 4);
    e[0] *= rstd * g0.x; e[1] *= rstd * g0.y; e[2] *= rstd * g0.z; e[3] *= rstd * g0.w; e[4] *= rstd * g1.x; e[5] *= rstd * g1.y; e[6] *= rstd * g1.z; e[7] *= rstd * g1.w;
    if (rope) {
        const int d = 8 * j, fi = d & 31; const bool first = (d & 32) == 0;
        const LAS f32x2v* t = tab + ((d < 64) ? RT_ROW128 + prow * 32 : RT_COL128 + pcol * 32) + fi;
#pragma unroll
        for (int i = 0; i < 8; ++i) { const float p = __shfl_xor(e[i], 4); const f32x2v cs = t[i]; e[i] = first ? e[i] * cs.x - p * cs.y : p * cs.y + e[i] * cs.x; }
    }
    return pack8_fp8(e);
}
__device__ __forceinline__ void ph_prep2_fast(Frame& F, int l) {
    LAS f32x2v* tab = (LAS f32x2v*)F.lds;
    rope_tables(F, tab);
    const int gw = F.bid * NWAVES + F.wave, NGW = F.G * NWAVES, lane = F.lane, j = lane & 15, hd = lane >> 4;
    bf16_t* PROJ = (bf16_t*)(F.ws + WS_PROJ);
    const float* qn_att = F.in(13) + l * 128; const float* kn_att = F.in(14) + l * 128; const float* qn_win = F.in(17) + l * 128; const float* kn_win = F.in(18) + l * 128;
    const float* qn_na = F.in(19) + l * 128; const float* kn_na = F.in(20) + l * 128; const float* qa_n = F.in(9) + l * 384; const float* kva_n = F.in(11) + l * 256;
    for (int r = gw; r < TT; r += NGW) {
        bf16_t* p = PROJ + (size_t)r * PP;
        const bool lat = r < TL; const int t = r % SEQ, prow = t / 64, pcol = t % 64;
        bf16_t* a0 = p + C_AQ + lane * 8;
        bf16_t* a1 = p + (hd < 2 ? C_AK : C_WK - 256) + lane * 8;
        bf16_t* a2 = p + C_WQ + lane * 8;
        bf16_t* a3 = p + C_NQ + lane * 8;
        bf16_t* a4 = p + C_NK + lane * 8;
        bf16_t* a5 = p + C_MCQ + (lane < 48 ? lane : 0) * 8;
        bf16_t* a6 = p + C_MCKV + (lane & 31) * 8;
        const u32x4 w0 = *(const u32x4*)a0, w1 = *(const u32x4*)a1, w2 = *(const u32x4*)a2, w3 = *(const u32x4*)a3, w4 = *(const u32x4*)a4, w5 = *(const u32x4*)a5, w6 = *(const u32x4*)a6;
        unsigned char* q8 = F.ws + WS_Q8 + (size_t)r * Q8P; unsigned char* k8 = F.ws + WS_K8 + (size_t)r * K8P;
        *(u32x2*)(q8 + Q8_A + lane * 8) = head128_w(w0, qn_att, lat, prow, pcol, j, tab);
        *(u32x2*)(k8 + (hd < 2 ? K8_A : K8_W - 256) + lane * 8) = head128_w(w1, hd < 2 ? kn_att : kn_win, lat, prow, pcol, j, tab);
        *(u32x2*)(q8 + Q8_W + lane * 8) = head128_w(w2, qn_win, lat, prow, pcol, j, tab);
        *(u32x2*)(q8 + Q8_N + lane * 8) = head128_w(w3, qn_na, false, 0, 0, j, tab);
        *(u32x2*)(k8 + K8_N + lane * 8) = head128_w(w4, kn_na, false, 0, 0, j, tab);
        float e5[8], e6[8]; unpack8(w5, e5); unpack8(w6, e6);
        const float r5 = rsqrtf(wave_sum(lane < 48 ? ssq8(e5) : 0.f) * (1.0f / 384.0f) + EPS);
        const float r6 = rsqrtf(wave_sum(lane < 32 ? ssq8(e6) : 0.f) * (1.0f / 256.0f) + EPS);
        {
            const float* g5 = qa_n + (lane < 48 ? lane : 0) * 8; const float* g6 = kva_n + (lane & 31) * 8;
            const f32x4 ga = *(const f32x4*)g5, gb = *(const f32x4*)(g5 + 4), gc = *(const f32x4*)g6, gd = *(const f32x4*)(g6 + 4);
            e5[0] *= r5 * ga.x; e5[1] *= r5 * ga.y; e5[2] *= r5 * ga.z; e5[3] *= r5 * ga.w; e5[4] *= r5 * gb.x; e5[5] *= r5 * gb.y; e5[6] *= r5 * gb.z; e5[7] *= r5 * gb.w;
            e6[0] *= r6 * gc.x; e6[1] *= r6 * gc.y; e6[2] *= r6 * gc.z; e6[3] *= r6 * gc.w; e6[4] *= r6 * gd.x; e6[5] *= r6 * gd.y; e6[6] *= r6 * gd.z; e6[7] *= r6 * gd.w;
        }
        unsigned char* mc8 = F.ws + WS_MK + (size_t)r * MCP;
        if (lane < 48) *(u32x2*)(mc8 + 256 + lane * 8) = pack8_fp8(e5);
        if (lane < 32) *(u32x2*)(mc8 + lane * 8) = pack8_fp8(e6);
    }
    __syncthreads();
    {
        LAS unsigned char* scr = F.lds + F.wave * 5120;
        for (int it = gw; it < 2 * 132 * 16; it += NGW) {
            const int g = it & 15, tb = (it >> 4) % 132, b = (it >> 4) / 132;
            const int hidx = g >> 1, half = g & 1;
            const int col = (hidx < 2 ? C_AV + hidx * 128 : (hidx < 4 ? C_WV + (hidx - 2) * 128 : C_NV + (hidx - 4) * 128)) + half * 64;
            vtrans_item(PROJ + col, PP, b, tb, F.ws + WS_V8T + ((size_t)(hidx * 2 + b) * 128 + half * 64) * VTP, scr, lane);
        }
        __syncthreads();
    }
}
__device__ __forceinline__ void mla_rope8(float (&e)[8], int rp  , int prow, int pcol, const LAS f32x2v* tab, int delta_lane) {
    const int blk = rp >> 2, pp = rp & 3; const bool first = pp < 2;
    const LAS f32x2v* t = tab + (blk == 0 ? RT_ROW64 + prow * 16 : RT_COL64 + pcol * 16) + 8 * (pp & 1);
#pragma unroll
    for (int i = 0; i < 8; ++i) { const float p = __shfl_xor(e[i], delta_lane); const f32x2v cs = t[i]; e[i] = first ? e[i] * cs.x - p * cs.y : p * cs.y + e[i] * cs.x; }
}
__device__ __forceinline__ void scale8(float (&e)[8], float rstd, const float* g) { const f32x4 a = *(const f32x4*)g, b = *(const f32x4*)(g + 4);
    e[0] *= rstd * a.x; e[1] *= rstd * a.y; e[2] *= rstd * a.z; e[3] *= rstd * a.w; e[4] *= rstd * b.x; e[5] *= rstd * b.y; e[6] *= rstd * b.z; e[7] *= rstd * b.w; }
__device__ __forceinline__ void ph_prep3_fast(Frame& F, int l) {
    LAS f32x2v* tab = (LAS f32x2v*)F.lds;
    rope_tables(F, tab);
    const int gw = F.bid * NWAVES + F.wave, NGW = F.G * NWAVES, lane = F.lane;
    const bf16_t* PROJ = (const bf16_t*)(F.ws + WS_PROJ); const bf16_t* MKV = (const bf16_t*)(F.ws + WS_MQ); const bf16_t* MQ = MKV + 1024;
    const float* qn = F.in(15) + l * 192; const float* kn = F.in(16) + l * 192;
    const int hA = lane / 24, wA = lane % 24, cB = 64 + (lane & 31), hB = cB / 24, wB = cB % 24;
    for (int r = gw; r < TT; r += NGW) {
        const bool lat = r < TL; const int t = r % SEQ, prow = t / 64, pcol = t % 64;
        const bf16_t* q = MQ + (size_t)r * MQP;
        const u32x4 qa = *(const u32x4*)(q + lane * 8), qb = *(const u32x4*)(q + cB * 8);
        const u32x4 kw = *(const u32x4*)(MKV + (size_t)r * MQP + (lane >> 4) * 256 + (lane & 15) * 8);
        const u32x4 rw = *(const u32x4*)(PROJ + (size_t)r * PP + C_MKR + (lane & 7) * 8);
        float ea[8], eb[8], ek[8], er[8]; unpack8(qa, ea); unpack8(qb, eb); unpack8(kw, ek); unpack8(rw, er);
        const float sA = ssq8(ea), sB = (lane < 32) ? ssq8(eb) : 0.f;
        float rq[4];
#pragma unroll
        for (int h = 0; h < 4; ++h) rq[h] = rsqrtf(wave_sum((hA == h ? sA : 0.f) + (hB == h ? sB : 0.f)) * (1.0f / 192.0f) + EPS);
        const float rA = hA == 0 ? rq[0] : (hA == 1 ? rq[1] : rq[2]), rB = hB == 2 ? rq[2] : rq[3];
        scale8(ea, rA, qn + wA * 8); scale8(eb, rB, qn + wB * 8);
        if (lat) {
            float ta[8], tb[8];
#pragma unroll
            for (int i = 0; i < 8; ++i) { ta[i] = ea[i]; tb[i] = eb[i]; }
            mla_rope8(ta, (wA - 16) & 7, prow, pcol, tab, 2); mla_rope8(tb, (wB - 16) & 7, prow, pcol, tab, 2);
#pragma unroll
            for (int i = 0; i < 8; ++i) { if (wA >= 16) ea[i] = ta[i]; if (wB >= 16) eb[i] = tb[i]; }
        }
        unsigned char* q8 = F.ws + WS_Q8 + (size_t)r * Q8P + Q8_M; unsigned char* k8 = F.ws + WS_K8 + (size_t)r * K8P + K8_M;
        *(u32x2*)(q8 + lane * 8) = pack8_fp8(ea);
        if (lane < 32) *(u32x2*)(q8 + cB * 8) = pack8_fp8(eb);
        const float srope = wave_sum(lane < 8 ? ssq8(er) : 0.f);
        const float rk = rsqrtf((group16_sum(ssq8(ek)) + srope) * (1.0f / 192.0f) + EPS);
        scale8(ek, rk, kn + (lane & 15) * 8);
        *(u32x2*)(k8 + (lane >> 4) * 192 + (lane & 15) * 8) = pack8_fp8(ek);
        const float rkh = __shfl(rk, ((lane >> 3) & 3) * 16);
        scale8(er, rkh, kn + 128 + (lane & 7) * 8);
        if (lat) mla_rope8(er, lane & 7, prow, pcol, tab, 2);
        if (lane < 32) *(u32x2*)(k8 + (lane >> 3) * 192 + 128 + (lane & 7) * 8) = pack8_fp8(er);
    }
    __syncthreads();
    {
        LAS unsigned char* scr = F.lds + F.wave * 5120;
        for (int it = gw; it < 2 * 132 * 8; it += NGW) {
            const int g = it & 7, tb = (it >> 3) % 132, b = (it >> 3) / 132, h = g >> 1, half = g & 1;
            vtrans_item(MKV + h * 256 + 128 + half * 64, MQP, b, tb, F.ws + WS_V8T + ((size_t)((8 + h) * 2 + b) * 128 + half * 64) * VTP, scr, lane);
        }
        __syncthreads();
    }
}

#define QSTR 97
template <int DQK> __device__ __forceinline__ float qk_dot(const LAS unsigned* q, const bf16_t* k) {
    float s = 0.f;
#pragma unroll 4
    for (int c = 0; c < DQK / 8; ++c) {
        const u32x4 kv = *(const u32x4*)(k + c * 8);
#pragma unroll
        for (int j = 0; j < 4; ++j) { const unsigned qw = q[c * 4 + j]; s += lo16(qw) * lo16(kv[j]); s += hi16(qw) * hi16(kv[j]); }
    }
    return s;
}
__device__ __forceinline__ void attn_key(float s, const bf16_t* v, float& m, float& l, float (&o)[64]) {
    if (s > m) { const float al = __expf(m - s); l *= al;
#pragma unroll
        for (int d = 0; d < 64; ++d) o[d] *= al;
        m = s; }
    const float p = __expf(s - m); l += p;
    if (v) {
#pragma unroll
        for (int c = 0; c < 8; ++c) { const u32x4 vv = *(const u32x4*)(v + c * 8);
#pragma unroll
            for (int j = 0; j < 4; ++j) { o[c * 8 + 2 * j] += p * lo16(vv[j]); o[c * 8 + 2 * j + 1] += p * hi16(vv[j]); } }
    }
}
template <int DQK> __device__ __forceinline__ void nattn_item(Frame& F, int l, int mx, int h, int r0, bool is_ctx) {
    const int lane = F.lane;
    const bf16_t* PROJ = (const bf16_t*)(F.ws + WS_PROJ);
    const bf16_t *Q, *Kb, *Vb; int ldq, ldk, ldv;
    if (mx == 0) { Q = PROJ + C_AQ + h * 128; Kb = PROJ + C_AK + (h >> 1) * 128; Vb = PROJ + C_AV + (h >> 1) * 128; ldq = ldk = ldv = PP; }
    else if (mx == 1) { Q = (const bf16_t*)(F.ws + WS_MQ) + h * 192; Kb = (const bf16_t*)(F.ws + WS_MK) + h * 192; Vb = (const bf16_t*)(F.ws + WS_MKV) + h * 256 + 128; ldq = 768; ldk = 768; ldv = 1024; }
    else if (mx == 2) { Q = PROJ + C_WQ + h * 128; Kb = PROJ + C_WK + (h >> 1) * 128; Vb = PROJ + C_WV + (h >> 1) * 128; ldq = ldk = ldv = PP; }
    else { Q = PROJ + C_NQ + h * 128; Kb = PROJ + C_NK + h * 128; Vb = PROJ + C_NV + h * 128; ldq = ldk = ldv = PP; }
    const float scale = (DQK == 128) ? 0.08838834764831845f : 0.07216878364870323f;
    const int r = r0 + (lane & 31), half = lane >> 5;
    Vb += half * 64;
    LAS unsigned* qs = (LAS unsigned*)F.lds + (F.wave * 64 + lane) * QSTR;
    {
        const bf16_t* qp = Q + (size_t)r * ldq;
#pragma unroll
        for (int c = 0; c < DQK / 8; ++c) { const u32x4 v = *(const u32x4*)(qp + c * 8); qs[c * 4 + 0] = v.x; qs[c * 4 + 1] = v.y; qs[c * 4 + 2] = v.z; qs[c * 4 + 3] = v.w; }
    }
    float m = -1e30f, lsum = 0.f; float o[64];
#pragma unroll
    for (int d = 0; d < 64; ++d) o[d] = 0.f;
    const int b = is_ctx ? (r0 - TL) / NCTX : r0 / SEQ;
    for (int j = 0; j < NCTX; ++j) { const size_t kr = (size_t)(TL + b * NCTX + j);
        const float s = qk_dot<DQK>(qs, Kb + kr * ldk) * scale; attn_key(s, Vb + kr * ldv, m, lsum, o); }
    if (!is_ctx) {
        const int t = r - b * SEQ;
        if (mx <= 1) {
            for (int j = 0; j < SEQ; ++j) { const size_t kr = (size_t)(b * SEQ + j);
                const float s = qk_dot<DQK>(qs, Kb + kr * ldk) * scale; attn_key(s, Vb + kr * ldv, m, lsum, o); }
        } else if (mx == 2) {
            const int t0 = r0 - b * SEQ;
            for (int j = t0 - 128; j <= t0 + 31 + 128; ++j) {
                const int d = t - j;
                if (j >= 0 && j < SEQ && d <= 128 && d >= -128) { const size_t kr = (size_t)(b * SEQ + j);
                    const float s = qk_dot<DQK>(qs, Kb + kr * ldk) * scale; attn_key(s, Vb + kr * ldv, m, lsum, o); }
            }
        } else {
            const int rr = t / 64, cc = t % 64;
            const int rs = min(max(rr - 4, 0), 128 - 8), cs = min(max(cc - 8, 0), 64 - 16);
            const float* rpb = F.in(22) + (size_t)(l * 4 + h) * 15 * 31;
            for (int y = 0; y < 8; ++y)
                for (int kx = 0; kx < 16; ++kx) {
                    const size_t kr = (size_t)(b * SEQ + (rs + y) * 64 + cs + kx);
                    const int dy = rs + y - rr + 7, dx = cs + kx - cc + 15;
                    const float s = qk_dot<DQK>(qs, Kb + kr * ldk) * scale + rpb[dy * 31 + dx]; attn_key(s, Vb + kr * ldv, m, lsum, o); }
        }
    }
    if (mx == 2) attn_key(F.in(21)[l * 4 + h], nullptr, m, lsum, o);
    const float inv = 1.0f / lsum;
    bf16_t* op = (bf16_t*)(F.ws + WS_OUTS) + (size_t)r * DM + mx * 512 + h * 128 + half * 64;
#pragma unroll
    for (int c = 0; c < 8; ++c) { u32x4 w;
#pragma unroll
        for (int j = 0; j < 4; ++j) w[j] = pk2(o[c * 8 + 2 * j] * inv, o[c * 8 + 2 * j + 1] * inv);
        *(u32x4*)(op + c * 8) = w; }
}
__device__ __forceinline__ void ph_nattn(Frame& F, int l) {
    if (F.wave >= 4) return;
    const int slot = F.bid * 4 + F.wave, nslots = F.G * 4;
    const int total = 8192 + (l == 0 ? 256 : 0);
    for (int it = slot; it < total; it += nslots) {
        if (it < 8192) {
            const int grp = it >> 11, rem = it & 2047, h = rem >> 9, qi = rem & 511;
            const int mx = grp == 0 ? 1 : (grp == 1 ? 0 : grp);
            if (mx == 1) nattn_item<192>(F, l, 1, h, qi * 32, false); else nattn_item<128>(F, l, mx, h, qi * 32, false);
        } else {
            const int i2 = it - 8192, mx = i2 >> 6, h = (i2 >> 4) & 3, qi = i2 & 15;
            if (mx == 1) nattn_item<192>(F, l, 1, h, TL + qi * 32, true); else nattn_item<128>(F, l, mx, h, TL + qi * 32, true);
        }
    }
}

__device__ __forceinline__ void ph_nmerge(Frame& F, int l) {
    const int M = (l == 0) ? TT : TL, nn = DM / 64, ntiles = (M / 128) * nn;
    const int ty = F.tid >> 4, tx = F.tid & 15;
    const bf16_t* H = (const bf16_t*)(F.ws + WS_H); const bf16_t* OUTS = (const bf16_t*)(F.ws + WS_OUTS); bf16_t* ACC = (bf16_t*)(F.ws + WS_ACC);
    for (int t = F.bid; t < ntiles; t += F.G) {
        const int row0 = (t / nn) * 128, col0 = (t % nn) * 64;
        float tot[4][4]; ZERO44(tot);
        for (int i = 0; i < 4; ++i) {
            float ag[4][4], ab[4][4]; ZERO44(ag); ZERO44(ab);
            ngemm_tile(ag, H, DM, F.in(24) + (size_t)(l * 4 + i) * DM * DM, DM, DM, row0, col0, (LAS float*)F.lds, F.tid);
            ngemm_tile(ab, OUTS + i * 512, DM, F.in(23) + (size_t)(l * 4 + i) * 512 * DM, DM, 512, row0, col0, (LAS float*)F.lds, F.tid);
            const f32x4 bg = *(const f32x4*)(F.in(25) + (size_t)(l * 4 + i) * DM + col0 + tx * 4);
#pragma unroll
            for (int a = 0; a < 4; ++a)
#pragma unroll
                for (int b = 0; b < 4; ++b) tot[a][b] += sigmoidf_(ag[a][b] + bg[b]) * ab[a][b];
        }
#pragma unroll
        for (int a = 0; a < 4; ++a) { u32x2 w; w.x = pk2(tot[a][0], tot[a][1]); w.y = pk2(tot[a][2], tot[a][3]);
            *(u32x2*)(ACC + (size_t)(row0 + ty * 4 + a) * DM + col0 + tx * 4) = w; }
    }
}
__device__ __forceinline__ void ph_nout(Frame& F, int l) {
    const int M = (l == 0) ? TT : TL, nn = DM / 64, ntiles = (M / 128) * nn;
    const int ty = F.tid >> 4, tx = F.tid & 15;
    const bf16_t* ACC = (const bf16_t*)(F.ws + WS_ACC);
    for (int t = F.bid; t < ntiles; t += F.G) {
        const int row0 = (t / nn) * 128, col0 = (t % nn) * 64;
        float acc[4][4]; ZERO44(acc);
        ngemm_tile(acc, ACC, DM, F.in(26) + (size_t)l * DM * DM, DM, DM, row0, col0, (LAS float*)F.lds, F.tid);
#pragma unroll
        for (int a = 0; a < 4; ++a) { const int r = row0 + ty * 4 + a, c = col0 + tx * 4;
            const f32x4 xi = *(const f32x4*)(xin_row(F, l, r) + c), g1 = *(const f32x4*)(mod_vec(F, l, r, 2) + c);
            f32x4 o; o.x = xi.x + g1.x * acc[a][0]; o.y = xi.y + g1.y * acc[a][1]; o.z = xi.z + g1.z * acc[a][2]; o.w = xi.w + g1.w * acc[a][3];
            *(f32x4*)(xs_row(F, r) + c) = o; }
    }
}

__device__ __forceinline__ void ph_prep4(Frame& F, int l) {
    const int gw = F.bid * NWAVES + F.wave, NGW = F.G * NWAVES, lane = F.lane;
    const int nrows = (l == 0) ? TT : TL;
    bf16_t* H = (bf16_t*)(F.ws + WS_H);
    unsigned* ecnt = (unsigned*)(F.ws + WS_CTL) + CW_ECNT + l * 16;
    int* elist = (int*)(F.ws + WS_ELIST); float* elw = (float*)(F.ws + WS_ELW);
    LAS float* wrT = (LAS float*)F.lds;
    { const float* wr = F.in(27);
      for (int i = F.tid; i < DM * 4; i += NTHREADS) { const int k = i >> 2, e4 = i & 3; const f32x4 v = *(const f32x4*)(wr + (size_t)k * 16 + e4 * 4);
          wrT[(e4 * 4 + 0) * DM + k] = v.x; wrT[(e4 * 4 + 1) * DM + k] = v.y; wrT[(e4 * 4 + 2) * DM + k] = v.z; wrT[(e4 * 4 + 3) * DM + k] = v.w; }
      __syncthreads(); }
    const float* gn_ffn = F.in(7) + (size_t)l * DM; const float* rbias = F.in(28);
    constexpr int RPW = 12;
    LAS unsigned* lcnt = (LAS unsigned*)(F.lds + 131072 + 1024); LAS unsigned* lbase = lcnt + 16;
    LAS int* rt_e = (LAS int*)(lbase + 16); LAS int* rt_r = rt_e + NWAVES * RPW; LAS float* rt_w1 = (LAS float*)(rt_r + NWAVES * RPW); LAS float* rt_w2 = rt_w1 + NWAVES * RPW;
    if (F.tid < 16) lcnt[F.tid] = 0u;
    __syncthreads();
    int nloc = 0;
    f32x4 vn[8];
    if (gw < nrows) { const float* xr0 = xs_row(F, gw);
#pragma unroll
        for (int j = 0; j < 8; ++j) vn[j] = *(const f32x4*)(xr0 + j * 256 + lane * 4); }
    for (int r = gw; r < nrows; r += NGW) {
        f32x4 v[8];
        float ss = 0.f;
#pragma unroll
        for (int j = 0; j < 8; ++j) { v[j] = vn[j]; ss += v[j].x * v[j].x + v[j].y * v[j].y + v[j].z * v[j].z + v[j].w * v[j].w; }
        if (r + NGW < nrows) { const float* xr1 = xs_row(F, r + NGW);
#pragma unroll
            for (int j = 0; j < 8; ++j) vn[j] = *(const f32x4*)(xr1 + j * 256 + lane * 4); }
        const float rstd = rsqrtf(wave_sum(ss) * (1.0f / DM) + EPS);
        const float* gn = gn_ffn; const float* sh = mod_vec(F, l, r, 3); const float* sc = mod_vec(F, l, r, 4);
        float lg[16];
#pragma unroll
        for (int e = 0; e < 16; ++e) lg[e] = 0.f;
#pragma unroll
        for (int j = 0; j < 8; ++j) {
            const int c = j * 256 + lane * 4;
            const f32x4 g = *(const f32x4*)(gn + c), s1 = *(const f32x4*)(sc + c), s0 = *(const f32x4*)(sh + c);
            const f32x4 h = (v[j] * rstd * g) * (s1 + 1.0f) + s0;
            if (FAST_MASK & 16) { int w8 = 0; w8 = cvt8s(h.x, h.y, w8, false); w8 = cvt8s(h.z, h.w, w8, true);
                *(int*)(F.ws + WS_H8 + (size_t)r * DM + c) = w8; }
            else { u32x2 w; w.x = pk2(h.x, h.y); w.y = pk2(h.z, h.w); *(u32x2*)(H + (size_t)r * DM + c) = w; }
#pragma unroll
            for (int e = 0; e < 16; ++e) { const f32x4 wv = *(const LAS f32x4*)(wrT + e * DM + c); lg[e] += (h.x * wv.x + h.y * wv.y) + (h.z * wv.z + h.w * wv.w); }
        }
        float q8[8], q4[4], q2[2], q1;
        { const bool b5 = (lane & 32) != 0;
#pragma unroll
          for (int i = 0; i < 8; ++i) { const float keep = b5 ? lg[8 + i] : lg[i], send = b5 ? lg[i] : lg[8 + i]; q8[i] = keep + __shfl_xor(send, 32); }
          const bool b4 = (lane & 16) != 0;
#pragma unroll
          for (int i = 0; i < 4; ++i) { const float keep = b4 ? q8[4 + i] : q8[i], send = b4 ? q8[i] : q8[4 + i]; q4[i] = keep + __shfl_xor(send, 16); }
          const bool b3 = (lane & 8) != 0;
#pragma unroll
          for (int i = 0; i < 2; ++i) { const float keep = b3 ? q4[2 + i] : q4[i], send = b3 ? q4[i] : q4[2 + i]; q2[i] = keep + __shfl_xor(send, 8); }
          const bool b2 = (lane & 4) != 0;
          { const float keep = b2 ? q2[1] : q2[0], send = b2 ? q2[0] : q2[1]; q1 = keep + __shfl_xor(send, 4); }
          q1 += __shfl_xor(q1, 2); q1 += __shfl_xor(q1, 1); }
        float sc_[16], bs[16];
#pragma unroll
        for (int e = 0; e < 16; ++e) { const float z = __uint_as_float(__builtin_amdgcn_readlane(__float_as_uint(q1), 4 * e));
            sc_[e] = __builtin_amdgcn_rcpf(1.0f + __expf(-z)); bs[e] = sc_[e] + rbias[e]; }
        int bg = 0; float bgs;
#pragma unroll
        for (int g = 0; g < 4; ++g) {
            const float a0 = bs[g * 4], a1 = bs[g * 4 + 1], a2 = bs[g * 4 + 2], a3 = bs[g * 4 + 3];
            const float lo1 = fminf(a0, a1), hi1 = fmaxf(a0, a1), lo2 = fminf(a2, a3), hi2 = fmaxf(a2, a3);
            const float gs = fmaxf(hi1, hi2) + fmaxf(fminf(hi1, hi2), fmaxf(lo1, lo2));
            if (g == 0) bgs = gs; else { const bool t = gs > bgs; bgs = t ? gs : bgs; bg = t ? g : bg; }
        }
        float x[4], su[4];
#pragma unroll
        for (int q = 0; q < 4; ++q) { x[q] = bg == 0 ? bs[q] : (bg == 1 ? bs[4 + q] : (bg == 2 ? bs[8 + q] : bs[12 + q])); su[q] = bg == 0 ? sc_[q] : (bg == 1 ? sc_[4 + q] : (bg == 2 ? sc_[8 + q] : sc_[12 + q])); }
        int i1 = 0; float v1 = x[0], s1 = su[0];
#pragma unroll
        for (int q = 1; q < 4; ++q) { const bool t = x[q] > v1; v1 = t ? x[q] : v1; s1 = t ? su[q] : s1; i1 = t ? q : i1; }
        int i2 = -1; float v2 = -3.0e38f, s2 = 0.f;
#pragma unroll
        for (int q = 0; q < 4; ++q) { const bool t = (q != i1) && (x[q] > v2); v2 = t ? x[q] : v2; s2 = t ? su[q] : s2; i2 = t ? q : i2; }
        const int e1 = bg * 4 + i1, e2 = bg * 4 + i2;
        if (lane == 0) {
            const float inv = 1.0f / (s1 + s2); const int slot = F.wave * RPW + nloc;
            rt_e[slot] = e1 | (e2 << 8); rt_r[slot] = r; rt_w1[slot] = s1 * inv; rt_w2[slot] = s2 * inv;
            (void)__hip_atomic_fetch_add(&lcnt[e1], 1u, __ATOMIC_RELAXED, __HIP_MEMORY_SCOPE_WORKGROUP); (void)__hip_atomic_fetch_add(&lcnt[e2], 1u, __ATOMIC_RELAXED, __HIP_MEMORY_SCOPE_WORKGROUP);
        }
        ++nloc;
    }
    __syncthreads();
    if (F.tid < 16) { const unsigned n = lcnt[F.tid]; lbase[F.tid] = n ? atomicAdd(ecnt + F.tid, n) : 0u; lcnt[F.tid] = 0u; }
    __syncthreads();
    if (lane == 0) for (int i = 0; i < nloc; ++i) {
        const int slot = F.wave * RPW + i; const int e1 = rt_e[slot] & 255, e2 = rt_e[slot] >> 8, r = rt_r[slot];
        const unsigned p1 = lbase[e1] + __hip_atomic_fetch_add(&lcnt[e1], 1u, __ATOMIC_RELAXED, __HIP_MEMORY_SCOPE_WORKGROUP); elist[(size_t)e1 * TT + p1] = r * 2 + 0; elw[(size_t)e1 * TT + p1] = rt_w1[slot];
        const unsigned p2 = lbase[e2] + __hip_atomic_fetch_add(&lcnt[e2], 1u, __ATOMIC_RELAXED, __HIP_MEMORY_SCOPE_WORKGROUP); elist[(size_t)e2 * TT + p2] = r * 2 + 1; elw[(size_t)e2 * TT + p2] = rt_w2[slot];
    }
    __syncthreads();
}

__device__ __forceinline__ void ph_nmoe(Frame& F, int l) {
    const unsigned* ecnt = (const unsigned*)(F.ws + WS_CTL) + CW_ECNT + l * 16;
    const int* elist = (const int*)(F.ws + WS_ELIST); const float* elw = (const float*)(F.ws + WS_ELW);
    const bf16_t* H = (const bf16_t*)(F.ws + WS_H); bf16_t* Y = (bf16_t*)(F.ws + WS_PROJ);
    LAS float* hx = (LAS float*)F.lds;
    LAS float* hid = hx + 8 * DM;
    LAS int* ent = (LAS int*)(hid + 8 * DEXP);
    LAS float* entw = (LAS float*)(ent + 8);
    int total = 0;
    for (int e = 0; e < 16; ++e) total += ((int)ecnt[e] + 7) >> 3;
    const int tid = F.tid;
    for (int item = F.bid; item < total; item += F.G) {
        int e = 0, cbase = 0, acc = 0, cnt = 0;
        for (int i = 0; i < 16; ++i) { const int n = (int)ecnt[i], c = (n + 7) >> 3; if (item >= acc && item < acc + c) { e = i; cbase = acc; cnt = n; } acc += c; }
        const int p0 = (item - cbase) * 8, nv = min(8, cnt - p0);
        __syncthreads();
        if (tid < 8) { ent[tid] = tid < nv ? elist[(size_t)e * TT + p0 + tid] : -1; entw[tid] = tid < nv ? elw[(size_t)e * TT + p0 + tid] : 0.f; }
        __syncthreads();
        for (int i = tid; i < 8 * DM; i += NTHREADS) { const int t = i / DM, k = i % DM; const int en = ent[t]; hx[i] = en >= 0 ? bf2f(H[(size_t)(en >> 1) * DM + k]) : 0.f; }
        __syncthreads();
        {
            const float* w1 = F.in(29) + (size_t)(l * 16 + e) * DM * DEXP + tid; const float* w3 = F.in(30) + (size_t)(l * 16 + e) * DM * DEXP + tid;
            float a1[8], a3[8];
#pragma unroll
            for (int t = 0; t < 8; ++t) { a1[t] = 0.f; a3[t] = 0.f; }
#pragma unroll 4
            for (int d = 0; d < DM; ++d) { const float x1 = w1[(size_t)d * DEXP], x3 = w3[(size_t)d * DEXP];
#pragma unroll
                for (int t = 0; t < 8; ++t) { const float hv = hx[t * DM + d]; a1[t] += hv * x1; a3[t] += hv * x3; } }
#pragma unroll
            for (int t = 0; t < 8; ++t) hid[t * DEXP + tid] = siluf_(a1[t]) * a3[t];
        }
        __syncthreads();
        {
            const float* w2 = F.in(31) + (size_t)(l * 16 + e) * DEXP * DM + tid * 4;
            f32x4 a[8];
#pragma unroll
            for (int t = 0; t < 8; ++t) a[t] = (f32x4){0.f, 0.f, 0.f, 0.f};
#pragma unroll 4
            for (int j = 0; j < DEXP; ++j) { const f32x4 w = *(const f32x4*)(w2 + (size_t)j * DM);
#pragma unroll
                for (int t = 0; t < 8; ++t) a[t] += w * hid[t * DEXP + j]; }
#pragma unroll
            for (int t = 0; t < 8; ++t) { const int en = ent[t]; if (en >= 0) { const float w = entw[t];
                u32x2 o; o.x = pk2(a[t].x * w, a[t].y * w); o.y = pk2(a[t].z * w, a[t].w * w);
                *(u32x2*)(Y + (size_t)(en & 1) * TT * DM + (size_t)(en >> 1) * DM + tid * 4) = o; } }
        }
    }
    __syncthreads();
}


namespace pg8 {
typedef short bf16x8 __attribute__((ext_vector_type(8)));
typedef int v4i_t __attribute__((ext_vector_type(4)));
typedef int v8i_t __attribute__((ext_vector_type(8)));
constexpr int BM = 256, BK = 64, HALF = 128, HTB = HALF * BK * 2, STAGE_BYTES = 8 * HTB, NXCD = 8, WGM = 8;
__host__ __device__ __forceinline__ int lds_byte(int r, int c) { const int st = (r >> 4) * 2 + (c >> 5), rr = r & 15, cc = c & 31, ob = rr * 64 + cc * 2; return st * 1024 + (ob ^ (((ob >> 9) & 1) << 5)); }
__host__ __device__ __forceinline__ void stage_rc(int b, int& R, int& C) { const int st = b / 1024, sb = b % 1024, swz = sb ^ (((sb >> 9) & 1) << 5); R = (st >> 1) * 16 + swz / 64; C = (st & 1) * 32 + (swz % 64) / 2; }
__host__ __device__ __forceinline__ void stage_rc8(int b, int& R, int& C) { const int st = b / 1024, sb = b % 1024, r = sb / 64, j = ((sb % 64) / 16) ^ ((r >> 3) & 1); R = (st >> 1) * 16 + r; C = (st & 1) * 32 + j * 8; }
__host__ __device__ __forceinline__ int lds_byte8(int r, int fq, int half) { const int rr = r & 15; return ((r >> 4) * 2 + (fq >> 1)) * 1024 + rr * 64 + (((2 * (fq & 1) + half) ^ ((rr >> 3) & 1)) * 16); }
__host__ __device__ __forceinline__ int perm32(int rho) { const int n = rho >> 4, i = rho & 15; return 8 * (i >> 2) + 4 * n + (i & 3); }

struct Unit { int pm, pn; const char* A; const char* B; const int* list; int nrows; int aux; };

__device__ __forceinline__ void xcd_decode(int L, int nM, int nN, int& pm, int& pn) {
    const int nwg = nM * nN; int wgid = L;
    { const int q = nwg / NXCD, r = nwg % NXCD, xcd = wgid % NXCD, off = wgid / NXCD; wgid = (xcd < r ? xcd * (q + 1) : r * (q + 1) + (xcd - r) * q) + off; }
    const int nig = WGM * nN, gid = wgid / nig, fm = gid * WGM, gsz = (nM - fm) < WGM ? (nM - fm) : WGM;
    pm = fm + ((wgid % nig) % gsz); pn = (wgid % nig) / gsz;
}
struct SchedPlain {
    const char* A; const char* B; int lda, ldb, nM, nN, G, c, a_div, a_colbytes;
    __device__ __forceinline__ bool next(int i, Unit& u) const {
        const long L = (long)i * G + c; if (L >= (long)nM * nN) return false;
        int pm, pn; xcd_decode((int)L, nM, nN, pm, pn);
        u.pm = pm; u.pn = pn; u.A = A + (size_t)pm * BM * lda * 2 + (size_t)(pn / a_div) * a_colbytes; u.B = B + (size_t)pn * BM * ldb * 2; u.list = nullptr; u.nrows = BM; u.aux = 0; return true;
    }
};

__device__ __forceinline__ unsigned cvt_pk_bf16(float lo, float hi) { unsigned r; asm volatile("v_cvt_pk_bf16_f32 %0, %1, %2" : "=v"(r) : "v"(lo), "v"(hi)); return r; }

struct EpiBf16 {
    static constexpr bool PERM = true;
    bf16_t* O; int ldc; float scale;
    __device__ __forceinline__ void operator()(const f32x4 (&acc)[2][2][4][2], const Unit& u, int wr, int wc, int fr, int fq) const {
        const int row0 = u.pm * BM + wr * 64 + fr, col0 = u.pn * BM + wc * 32 + 8 * fq;
#pragma unroll
        for (int ai = 0; ai < 2; ++ai)
#pragma unroll
            for (int m = 0; m < 4; ++m) { bf16_t* rowp = O + (size_t)(row0 + ai * HALF + m * 16) * ldc + col0;
#pragma unroll
                for (int bj = 0; bj < 2; ++bj) { const f32x4 v0 = acc[ai][bj][m][0] * scale, v1 = acc[ai][bj][m][1] * scale;
                    u32x4 w; w.x = cvt_pk_bf16(v0[0], v0[1]); w.y = cvt_pk_bf16(v0[2], v0[3]); w.z = cvt_pk_bf16(v1[0], v1[1]); w.w = cvt_pk_bf16(v1[2], v1[3]);
                    *(u32x4*)(rowp + bj * HALF) = w; } }
    }
};
struct EpiFp8 {
    static constexpr bool PERM = true;
    unsigned char* O; int ldc; float scale;
    __device__ __forceinline__ void operator()(const f32x4 (&acc)[2][2][4][2], const Unit& u, int wr, int wc, int fr, int fq) const {
        const int row0 = u.pm * BM + wr * 64 + fr, col0 = u.pn * BM + wc * 32 + 8 * fq;
#pragma unroll
        for (int ai = 0; ai < 2; ++ai)
#pragma unroll
            for (int m = 0; m < 4; ++m) { unsigned char* rowp = O + (size_t)(row0 + ai * HALF + m * 16) * ldc + col0;
#pragma unroll
                for (int bj = 0; bj < 2; ++bj) { const f32x4 v0 = acc[ai][bj][m][0] * scale, v1 = acc[ai][bj][m][1] * scale;
                    int a = 0, b = 0; a = cvt8s(v0[0], v0[1], a, false); a = cvt8s(v0[2], v0[3], a, true); b = cvt8s(v1[0], v1[1], b, false); b = cvt8s(v1[2], v1[3], b, true);
                    u32x2 w; w.x = (unsigned)a; w.y = (unsigned)b; *(u32x2*)(rowp + bj * HALF) = w; } }
    }
};
struct EpiResid {
    static constexpr bool PERM = true;
    const float* xin_lat; const float* xin_ctx; float* xs_lat; float* xs_ctx; const float* modbase; int which; float scale;
    __device__ __forceinline__ void operator()(const f32x4 (&acc)[2][2][4][2], const Unit& u, int wr, int wc, int fr, int fq) const {
        const bool lat = u.pm < TL / BM; const int s = lat ? (u.pm * BM) / SEQ : 2;
        const float* xi = lat ? xin_lat + (size_t)u.pm * BM * DM : xin_ctx + (size_t)(u.pm * BM - TL) * DM;
        float* xo = lat ? xs_lat + (size_t)u.pm * BM * DM : xs_ctx + (size_t)(u.pm * BM - TL) * DM;
        const float* g = modbase + (size_t)s * 6 * DM + which * DM;
        const int col0 = u.pn * BM + wc * 32 + 8 * fq;
        const size_t ro0 = (size_t)(wr * 64 + fr) * DM + col0;
#pragma unroll
        for (int bj = 0; bj < 2; ++bj) { const f32x4 g0 = *(const f32x4*)(g + col0 + bj * HALF) * scale, g1 = *(const f32x4*)(g + col0 + bj * HALF + 4) * scale;
#pragma unroll
            for (int ai = 0; ai < 2; ++ai) {
#pragma unroll
                for (int m = 0; m < 4; ++m) { const size_t ro = ro0 + (size_t)(ai * HALF + m * 16) * DM + bj * HALF;
                    const f32x4 x0 = *(const f32x4*)(xi + ro), x1 = *(const f32x4*)(xi + ro + 4);
                    *(f32x4*)(xo + ro) = x0 + g0 * acc[ai][bj][m][0]; *(f32x4*)(xo + ro + 4) = x1 + g1 * acc[ai][bj][m][1]; }
                asm volatile("" ::: "memory"); } }
    }
};

template <class Epi, class Sched, bool GATHER, bool FP8 = false>
__device__ __forceinline__ void gemm_phase(LAS unsigned char* lds, const int tid_in, const int lda, const int ldb, const int K, const Sched& S, const Epi& E) {
    const int wid = __builtin_amdgcn_readfirstlane(tid_in >> 6), lane = tid_in & 63, wr = wid >> 2, wc = wid & 3, fr = lane & 15, fq = lane >> 4;
    const int nt = K / BK;
#define tid (wid * 64 + lane)
    unsigned ao[2][2], voffA[2], voffB[2];
#pragma unroll
    for (int i = 0; i < 2; ++i) { int R, C; if constexpr (FP8) stage_rc8(tid * 16 + i * 8192, R, C); else stage_rc(tid * 16 + i * 8192, R, C); const int Rb = Epi::PERM ? ((R & ~31) + perm32(R & 31)) : R;
        voffB[i] = (unsigned)(Rb * ldb + C) * 2u; voffA[i] = (unsigned)(R * lda + C) * 2u;
        ao[0][i] = 0u; ao[1][i] = 0u; }
    const size_t kstep = (size_t)(BK * 2);
    const size_t hstepB = (size_t)HALF * ldb * 2, hstepA = (size_t)HALF * lda * 2;
    const unsigned ldsw = (unsigned)wid * 1024u;
    const int aoff = lds_byte(wr * 64 + fr, fq * 8), boff = lds_byte(wc * 32 + fr, fq * 8);
    const int aoff8 = lds_byte8(wr * 64 + fr, fq, 0), boff8 = lds_byte8(wc * 32 + fr, fq, 0), aoff8b = lds_byte8(wr * 64 + fr, fq, 1), boff8b = lds_byte8(wc * 32 + fr, fq, 1);
#define PG8_SA(b, h) (((b) * 2 + (h)) * HTB)
#define PG8_SB(b, h) ((4 + (b) * 2 + (h)) * HTB)
#define PG8_STAGE(bufoff, gbase, voff) do { _Pragma("unroll") for (int _i = 0; _i < 2; ++_i) \
        __builtin_amdgcn_global_load_lds((const unsigned*)((const char*)(gbase) + (voff)[_i]), (LAS unsigned*)(lds + (bufoff) + ldsw + _i * 8192), 16, 0, 0); } while (0)
#define PG8_STAGE_A(bufoff, gbase, h, nx) do { if constexpr (GATHER) { _Pragma("unroll") for (int _i = 0; _i < 2; ++_i) { const unsigned _o = ao[h][_i]; \
        __builtin_amdgcn_global_load_lds((const unsigned*)((const char*)(gbase) + _o), (LAS unsigned*)(lds + (bufoff) + ldsw + _i * 8192), 16, 0, 0); } } \
        else { PG8_STAGE(bufoff, (const char*)(gbase) + ((h) ? hstepA : (size_t)0), voffA); } } while (0)
#define PG8_LDA(dst, b, h) do { if constexpr (FP8) { _Pragma("unroll") for (int m = 0; m < 4; ++m) dst##8[m] = __builtin_shufflevector(*(const LAS v4i_t*)(lds + PG8_SA(b, h) + aoff8 + m * 2048), *(const LAS v4i_t*)(lds + PG8_SA(b, h) + aoff8b + m * 2048), 0, 1, 2, 3, 4, 5, 6, 7); } \
        else { _Pragma("unroll") for (int m = 0; m < 4; ++m) _Pragma("unroll") for (int k = 0; k < 2; ++k) dst[m][k] = *(const LAS bf16x8*)(lds + PG8_SA(b, h) + aoff + m * 2048 + k * 1024); } } while (0)
#define PG8_LDB(dst, b, h) do { if constexpr (FP8) { _Pragma("unroll") for (int n = 0; n < 2; ++n) dst##8[n] = __builtin_shufflevector(*(const LAS v4i_t*)(lds + PG8_SB(b, h) + boff8 + n * 2048), *(const LAS v4i_t*)(lds + PG8_SB(b, h) + boff8b + n * 2048), 0, 1, 2, 3, 4, 5, 6, 7); } \
        else { _Pragma("unroll") for (int n = 0; n < 2; ++n) _Pragma("unroll") for (int k = 0; k < 2; ++k) dst[n][k] = *(const LAS bf16x8*)(lds + PG8_SB(b, h) + boff + n * 2048 + k * 1024); } } while (0)
#define PG8_MMA(ai, bj, At, Bt) do { __builtin_amdgcn_s_setprio(1); if constexpr (FP8) { _Pragma("unroll") for (int m = 0; m < 4; ++m) _Pragma("unroll") for (int n = 0; n < 2; ++n) \
        asm volatile("v_mfma_scale_f32_16x16x128_f8f6f4 %0, %1, %2, %0, %3, %3 op_sel_hi:[0,0,0]" : "+v"(acc[ai][bj][m][n]) : "v"(Bt##8[n]), "v"(At##8[m]), "v"(sc1)); } \
        else { _Pragma("unroll") for (int m = 0; m < 4; ++m) _Pragma("unroll") for (int n = 0; n < 2; ++n) _Pragma("unroll") for (int k = 0; k < 2; ++k) \
        acc[ai][bj][m][n] = __builtin_amdgcn_mfma_f32_16x16x32_bf16(Bt[n][k], At[m][k], acc[ai][bj][m][n], 0, 0, 0); } __builtin_amdgcn_s_setprio(0); } while (0)
#define PG8_WAIT_V(n) asm volatile("s_waitcnt vmcnt(" #n ")" ::: "memory")
#define PG8_WAIT_L(n) asm volatile("s_waitcnt lgkmcnt(" #n ")" ::: "memory")
#define PG8_BAR __builtin_amdgcn_s_barrier()
#define PG8_SCHED __builtin_amdgcn_sched_barrier(0)
#define PG8_GOFF(dst, u) do { if constexpr (GATHER) { _Pragma("unroll") for (int _i = 0; _i < 2; ++_i) { int _R, _C; if constexpr (FP8) stage_rc8(tid * 16 + _i * 8192, _R, _C); else stage_rc(tid * 16 + _i * 8192, _R, _C); \
        _Pragma("unroll") for (int _h = 0; _h < 2; ++_h) { const int _r = _R + _h * HALF; \
        const int _e = (_r < (u).nrows) ? (u).list[_r] : (u).list[0]; dst[_h][_i] = (unsigned)(_e >> 1) * (unsigned)(lda * 2) + (unsigned)(_C * 2); } } } } while (0)
    Unit cur, nxt; int ui = 0;
    if (!S.next(0, cur)) return;
    f32x4 acc[2][2][4][2];
#define PG8_ZERO_ACC() do { float _z = 0.f; asm volatile("" : "+v"(_z)); const f32x4 _zv = (f32x4){_z, _z, _z, _z}; \
    _Pragma("unroll") for (int a = 0; a < 2; ++a) _Pragma("unroll") for (int b = 0; b < 2; ++b) _Pragma("unroll") for (int m = 0; m < 4; ++m) _Pragma("unroll") for (int n = 0; n < 2; ++n) acc[a][b][m][n] = _zv; \
    if constexpr (FP8) asm volatile("s_nop 15" ::: "memory"); } while (0)
    PG8_ZERO_ACC();
    const int sc1 = 0x7f7f7f7f;
    bf16x8 At[4][2], B0[2][2], B1[2][2]; v8i_t At8[4], B08[2], B18[2];
    const char* cA = cur.A; const char* cB = cur.B;
    PG8_GOFF(ao, cur);
    PG8_STAGE(PG8_SB(0, 0), cB, voffB); PG8_STAGE(PG8_SB(0, 1), cB + hstepB, voffB); PG8_STAGE_A(PG8_SA(0, 0), cA, 0, false); PG8_STAGE_A(PG8_SA(0, 1), cA, 1, false);
    if (wr == 1) PG8_BAR;
    PG8_WAIT_V(2); PG8_BAR;
    PG8_STAGE(PG8_SB(1, 0), cB + kstep, voffB); PG8_STAGE_A(PG8_SA(1, 0), cA + kstep, 0, false); PG8_STAGE(PG8_SB(1, 1), cB + hstepB + kstep, voffB);
    PG8_WAIT_V(6); PG8_BAR;
    for (;;) {
        const bool has_next = S.next(ui + 1, nxt);
        const char* nA = has_next ? nxt.A : cA; const char* nB = has_next ? nxt.B : cB;
        for (int t = 0; t < nt; t += 2) {
            const bool last = (t == nt - 2);
            const char* a1 = cA + (size_t)(t + 1) * kstep;
            const char* a2 = last ? nA : cA + (size_t)(t + 2) * kstep; const char* b2 = last ? nB : cB + (size_t)(t + 2) * kstep;
            const char* a3 = a2 + kstep; const char* b3 = b2 + kstep;
            const bool nx = GATHER && last;
            PG8_LDB(B0, 0, 0); PG8_LDB(B1, 0, 1); PG8_SCHED; PG8_LDA(At, 0, 0); PG8_STAGE_A(PG8_SA(1, 1), a1, 1, false);
            if constexpr (GATHER) { if (last && has_next) { PG8_GOFF(ao, nxt); } }
            PG8_WAIT_V(8); PG8_WAIT_L(0); PG8_BAR; PG8_MMA(0, 0, At, B0); PG8_MMA(0, 1, At, B1); PG8_BAR; PG8_SCHED;
            PG8_LDA(At, 0, 1); PG8_STAGE(PG8_SB(0, 0), b2, voffB); PG8_STAGE(PG8_SB(0, 1), b2 + hstepB, voffB); PG8_STAGE_A(PG8_SA(0, 0), a2, 0, nx);
            PG8_WAIT_V(8); PG8_WAIT_L(0); PG8_BAR; PG8_MMA(1, 0, At, B0); PG8_MMA(1, 1, At, B1); PG8_BAR; PG8_SCHED;
            PG8_LDB(B0, 1, 0); PG8_LDB(B1, 1, 1); PG8_SCHED; PG8_LDA(At, 1, 0); PG8_STAGE_A(PG8_SA(0, 1), a2, 1, nx);
            PG8_WAIT_V(8); PG8_WAIT_L(0); PG8_BAR; PG8_MMA(0, 0, At, B0); PG8_MMA(0, 1, At, B1); PG8_BAR; PG8_SCHED;
            PG8_LDA(At, 1, 1); PG8_STAGE(PG8_SB(1, 0), b3, voffB); PG8_STAGE(PG8_SB(1, 1), b3 + hstepB, voffB); PG8_STAGE_A(PG8_SA(1, 0), a3, 0, nx);
            PG8_WAIT_V(8); PG8_WAIT_L(0); PG8_BAR; PG8_MMA(1, 0, At, B0); PG8_MMA(1, 1, At, B1); PG8_BAR; PG8_SCHED;
        }
        if (wr == 0) PG8_BAR;
        if constexpr (FP8) asm volatile("s_nop 15\n\ts_nop 15" ::: "memory");
        { int ln = lane; asm volatile("" : "+v"(ln)); E(acc, cur, wr, wc, ln & 15, ln >> 4); }
        if (!has_next) break;
        PG8_ZERO_ACC();
        cur = nxt; cA = nA; cB = nB; ++ui;
        if (wr == 1) PG8_BAR;
    }
    PG8_WAIT_V(0);
    PG8_BAR;
#undef PG8_SA
#undef PG8_SB
#undef PG8_STAGE
#undef PG8_STAGE_A
#undef PG8_LDA
#undef PG8_LDB
#undef PG8_MMA
#undef PG8_WAIT_V
#undef PG8_WAIT_L
#undef PG8_BAR
#undef PG8_SCHED
#undef PG8_GOFF
#undef PG8_ZERO_ACC
#undef tid
}
}


struct MapPlain { __device__ __forceinline__ int operator()(int n) const { return n; } };
struct MapGate { int i; __device__ __forceinline__ int operator()(int ch) const { return (ch >> 6) * 256 + 128 * (i >> 1) + 32 * ((ch & 63) >> 4) + 16 * (i & 1) + (ch & 15); } };
struct MapW13 { int which; __device__ __forceinline__ int operator()(int j) const { return (j >> 7) * 256 + which * 128 + (j & 127); } };
template <class Map> __device__ __forceinline__ void cvt_item(const float* W, int N, int k0, int n0, bf16_t* WT, int ldk, const Map& map, LAS float* scr, int lane) {
#pragma unroll 8
    for (int i = 0; i < 32; ++i) { const int kk = 2 * i + (lane >> 5); scr[kk * 33 + (lane & 31)] = W[(size_t)(k0 + kk) * N + n0 + (lane & 31)]; }
    asm volatile("s_waitcnt lgkmcnt(0)" ::: "memory");
    const int c = lane & 7;
#pragma unroll
    for (int j = 0; j < 4; ++j) { const int n = (lane >> 3) + 8 * j; const LAS float* sp = scr + (8 * c) * 33 + n;
        u32x4 o; o.x = pk2(sp[0 * 33], sp[1 * 33]); o.y = pk2(sp[2 * 33], sp[3 * 33]); o.z = pk2(sp[4 * 33], sp[5 * 33]); o.w = pk2(sp[6 * 33], sp[7 * 33]);
        *(u32x4*)(WT + (size_t)map(n0 + n) * ldk + k0 + 8 * c) = o; }
    asm volatile("s_waitcnt lgkmcnt(0)" ::: "memory");
}
template <class Map> __device__ __forceinline__ void cvt_item8(const float* W, int N, int k0, int n0, unsigned char* WT, int ldk, const Map& map, float scale, LAS float* scr, int lane) {
#pragma unroll 8
    for (int i = 0; i < 32; ++i) { const int kk = 2 * i + (lane >> 5); scr[kk * 33 + (lane & 31)] = W[(size_t)(k0 + kk) * N + n0 + (lane & 31)]; }
    asm volatile("s_waitcnt lgkmcnt(0)" ::: "memory");
    const int c = lane & 7;
#pragma unroll
    for (int j = 0; j < 4; ++j) { const int n = (lane >> 3) + 8 * j; const LAS float* sp = scr + (8 * c) * 33 + n;
        int a = 0, b = 0;
        a = __builtin_amdgcn_cvt_pk_fp8_f32(sp[0 * 33] * scale, sp[1 * 33] * scale, a, false); a = __builtin_amdgcn_cvt_pk_fp8_f32(sp[2 * 33] * scale, sp[3 * 33] * scale, a, true);
        b = __builtin_amdgcn_cvt_pk_fp8_f32(sp[4 * 33] * scale, sp[5 * 33] * scale, b, false); b = __builtin_amdgcn_cvt_pk_fp8_f32(sp[6 * 33] * scale, sp[7 * 33] * scale, b, true);
        u32x2 o; o.x = (unsigned)a; o.y = (unsigned)b;
        *(u32x2*)(WT + (size_t)map(n0 + n) * ldk + k0 + 8 * c) = o; }
    asm volatile("s_waitcnt lgkmcnt(0)" ::: "memory");
}
template <class Map> __device__ __forceinline__ int cvt_matrix8(Frame& F, const float* W, int K, int N, unsigned char* WT, const Map& map, float scale, int run, int ldk = 0) {
    LAS float* scr = (LAS float*)(F.lds + F.wave * 8448);
    const int gw = F.bid * NWAVES + F.wave, NGW = F.G * NWAVES;
    const int nblk = N / 32, nitems = (K / 64) * nblk;
    int first = (gw - (run % NGW) + NGW) % NGW;
    for (int it = first; it < nitems; it += NGW) cvt_item8(W, N, (it / nblk) * 64, (it % nblk) * 32, WT, ldk ? ldk : K, map, scale, scr, F.lane);
    return run + nitems;
}
template <class Map> __device__ __forceinline__ int cvt_matrix(Frame& F, const float* W, int K, int N, bf16_t* WT, const Map& map, int run) {
    LAS float* scr = (LAS float*)(F.lds + F.wave * 8448);
    const int gw = F.bid * NWAVES + F.wave, NGW = F.G * NWAVES;
    const int nblk = N / 32, nitems = (K / 64) * nblk;
    int first = (gw - (run % NGW) + NGW) % NGW;
    for (int it = first; it < nitems; it += NGW) cvt_item(W, N, (it / nblk) * 64, (it % nblk) * 32, WT, K, map, scr, F.lane);
    return run + nitems;
}
__device__ __forceinline__ void ph_convert(Frame& F) {
    int run = 0;
    for (int l = 0; l < DEPTH; ++l) {
        unsigned char* wl = F.ws + WS_W + (size_t)l * WL_STRIDE;
        run = cvt_matrix8(F, F.in(8) + (size_t)l * DM * DIN, DM, DIN, (unsigned char*)(wl + WO_IN), MapPlain{}, GATE_WSCALE, run);
        {
            u32x4* z = (u32x4*)((unsigned char*)(wl + WO_IN) + (size_t)DIN * DM); const int n16 = (PP - DIN) * DM / 16;
            for (int i = F.bid * NTHREADS + F.tid; i < n16; i += F.G * NTHREADS) z[i] = (u32x4){0u, 0u, 0u, 0u};
        }
        run = cvt_matrix8(F, F.in(12) + (size_t)l * 256 * 1024, 256, 1024, (unsigned char*)(wl + WO_UQ), MapPlain{}, GATE_WSCALE, run, 512);
        run = cvt_matrix8(F, F.in(10) + (size_t)l * 384 * 768, 384, 768, (unsigned char*)(wl + WO_UQ) + 1024 * 512 + 128, MapPlain{}, GATE_WSCALE, run, 512);
        {
            unsigned char* wb = (unsigned char*)(wl + WO_UQ);
            for (int i = F.bid * NTHREADS + F.tid; i < 1024 * 16 + 768 * 8; i += F.G * NTHREADS) {
                u32x4* z = (i < 1024 * 16) ? (u32x4*)(wb + (size_t)(i >> 4) * 512 + 256 + (i & 15) * 16) : (u32x4*)(wb + (size_t)(1024 + ((i - 1024 * 16) >> 3)) * 512 + ((i - 1024 * 16) & 7) * 16);
                *z = (u32x4){0u, 0u, 0u, 0u};
            }
        }
        for (int i = 0; i < 4; ++i) run = cvt_matrix8(F, F.in(24) + (size_t)(l * 4 + i) * DM * DM, DM, DM, (unsigned char*)(wl + WO_G), MapGate{i}, GATE_WSCALE, run);
        for (int i = 0; i < 4; ++i) run = cvt_matrix8(F, F.in(23) + (size_t)(l * 4 + i) * 512 * DM, 512, DM, (unsigned char*)(wl + WO_B) + (size_t)i * DM * 512, MapPlain{}, GATE_WSCALE, run);
        run = cvt_matrix8(F, F.in(26) + (size_t)l * DM * DM, DM, DM, (unsigned char*)(wl + WO_O), MapPlain{}, GATE_WSCALE, run);
        for (int e = 0; e < NEXP; ++e) {
            run = cvt_matrix8(F, F.in(29) + (size_t)(l * NEXP + e) * DM * DEXP, DM, DEXP, (unsigned char*)(wl + WO_13) + (size_t)e * 1024 * DM, MapW13{0}, GATE_WSCALE, run);
            run = cvt_matrix8(F, F.in(30) + (size_t)(l * NEXP + e) * DM * DEXP, DM, DEXP, (unsigned char*)(wl + WO_13) + (size_t)e * 1024 * DM, MapW13{1}, GATE_WSCALE, run);
            run = cvt_matrix8(F, F.in(31) + (size_t)(l * NEXP + e) * DEXP * DM, DEXP, DM, (unsigned char*)(wl + WO_2) + (size_t)e * DM * DEXP, MapPlain{}, GATE_WSCALE, run);
        }
    }
}

namespace pg8 {
__device__ __forceinline__ float fsigmoid(float x) { return __builtin_amdgcn_rcpf(1.0f + __builtin_amdgcn_exp2f(-1.4426950408889634f * x)); }
struct EpiGate {
    static constexpr bool PERM = false;
    const unsigned char* BV; const float* bg; bf16_t* ACC;
    __device__ __forceinline__ void operator()(const f32x4 (&acc)[2][2][4][2], const Unit& u, int wr, int wc, int fr, int fq) const {
        const int ch0 = u.pn * 64 + wc * 16 + fq * 4;
        f32x4 b[4];
#pragma unroll
        for (int i = 0; i < 4; ++i) b[i] = *(const f32x4*)(bg + i * DM + ch0);
#pragma unroll
        for (int ai = 0; ai < 2; ++ai) {
            int v[4][4];
#pragma unroll
            for (int m = 0; m < 4; ++m) { const unsigned char* bv = BV + (size_t)(u.pm * BM + ai * HALF + wr * 64 + m * 16 + fr) * 8192 + ch0;
#pragma unroll
                for (int i = 0; i < 4; ++i) v[m][i] = *(const int*)(bv + i * DM); }
#pragma unroll
            for (int m = 0; m < 4; ++m) { const size_t row = (size_t)(u.pm * BM + ai * HALF + wr * 64 + m * 16 + fr);
                f32x4 tot = (f32x4){0.f, 0.f, 0.f, 0.f};
#pragma unroll
                for (int bj = 0; bj < 2; ++bj)
#pragma unroll
                    for (int n = 0; n < 2; ++n) { const int i = 2 * bj + n; const f32x4 a = acc[ai][bj][m][n] * (1.0f / GATE_WSCALE) + b[i];
                        tot.x += fsigmoid(a.x) * __builtin_amdgcn_cvt_f32_fp8(v[m][i], 0); tot.y += fsigmoid(a.y) * __builtin_amdgcn_cvt_f32_fp8(v[m][i], 1);
                        tot.z += fsigmoid(a.z) * __builtin_amdgcn_cvt_f32_fp8(v[m][i], 2); tot.w += fsigmoid(a.w) * __builtin_amdgcn_cvt_f32_fp8(v[m][i], 3); }
                const float os = ACC_SCALE / BV_SCALE;
                int o8 = 0; o8 = cvt8s(tot.x * os, tot.y * os, o8, false); o8 = cvt8s(tot.z * os, tot.w * os, o8, true);
                *(int*)((unsigned char*)ACC + row * DM + ch0) = o8; }
            asm volatile("" ::: "memory"); }
    }
};
struct SchedMoe {
    const unsigned* ecnt; const int* elist; const char* A; const char* W; int npn, G, c; size_t w_estride, w_pnstride, a_tstride; bool gather;
    __device__ __forceinline__ bool next(int i, Unit& u) const {
        int nt = 0;
        for (int e = 0; e < NEXP; ++e) nt += ((int)ecnt[e] + 255) >> 8;
        const long L = (long)i * G + c; if (L >= (long)nt * npn) return false;
        const int ti = (int)(L / npn), pn = (int)(L % npn);
        int e = 0, tb = 0, cn = 0, run = 0;
        for (int q = 0; q < NEXP; ++q) { const int n = (int)ecnt[q], t = (n + 255) >> 8; if (ti >= run && ti < run + t) { e = q; tb = run; cn = n; } run += t; }
        u.pm = ti; u.pn = pn; u.A = gather ? A : A + (size_t)ti * a_tstride; u.B = W + (size_t)e * w_estride + (size_t)pn * w_pnstride;
        u.list = elist + (size_t)e * TT + (size_t)(ti - tb) * 256; u.nrows = min(256, cn - (ti - tb) * 256); u.aux = e; return true;
    }
};
__device__ __forceinline__ float fsilu(float x) { return x * fsigmoid(x); }
struct EpiSwiGLU {
    static constexpr bool PERM = true;
    unsigned char* HID;
    __device__ __forceinline__ void operator()(const f32x4 (&acc)[2][2][4][2], const Unit& u, int wr, int wc, int fr, int fq) const {
        const int col0 = u.pn * 128 + wc * 32 + 8 * fq; const float is = 1.0f / GATE_WSCALE;
#pragma unroll
        for (int ai = 0; ai < 2; ++ai)
#pragma unroll
            for (int m = 0; m < 4; ++m) { const size_t row = (size_t)(u.pm * BM + ai * HALF + wr * 64 + m * 16 + fr);
                const f32x4 a0 = acc[ai][0][m][0] * is, a1 = acc[ai][0][m][1] * is, c0 = acc[ai][1][m][0] * is, c1 = acc[ai][1][m][1] * is;
                int x = 0, y = 0;
                x = cvt8s(fsilu(a0.x) * c0.x, fsilu(a0.y) * c0.y, x, false); x = cvt8s(fsilu(a0.z) * c0.z, fsilu(a0.w) * c0.w, x, true);
                y = cvt8s(fsilu(a1.x) * c1.x, fsilu(a1.y) * c1.y, y, false); y = cvt8s(fsilu(a1.z) * c1.z, fsilu(a1.w) * c1.w, y, true);
                u32x2 w; w.x = (unsigned)x; w.y = (unsigned)y;
                *(u32x2*)(HID + row * DEXP + col0) = w; }
    }
};
struct EpiMoeDown {
    static constexpr bool PERM = true;
    bf16_t* Y;
    __device__ __forceinline__ void operator()(const f32x4 (&acc)[2][2][4][2], const Unit& u, int wr, int wc, int fr, int fq) const {
        const int col0 = u.pn * BM + wc * 32 + 8 * fq;
        const float* lw = (const float*)((const char*)u.list + (WS_ELW - WS_ELIST));
#pragma unroll
        for (int ai = 0; ai < 2; ++ai)
#pragma unroll
            for (int m = 0; m < 4; ++m) { const int r = ai * HALF + wr * 64 + m * 16 + fr;
                if (r < u.nrows) { const int en = u.list[r]; const float w = lw[r] * (1.0f / GATE_WSCALE);
                    bf16_t* rowp = Y + (size_t)(en & 1) * TT * DM + (size_t)(en >> 1) * DM + col0;
#pragma unroll
                    for (int bj = 0; bj < 2; ++bj) { const f32x4 v0 = acc[ai][bj][m][0] * w, v1 = acc[ai][bj][m][1] * w;
                        u32x4 o; o.x = cvt_pk_bf16(v0[0], v0[1]); o.y = cvt_pk_bf16(v0[2], v0[3]); o.z = cvt_pk_bf16(v1[0], v1[1]); o.w = cvt_pk_bf16(v1[2], v1[3]);
                        *(u32x4*)(rowp + bj * HALF) = o; } }
                asm volatile("" ::: "memory"); }
    }
};
}
__device__ __forceinline__ void ph_fbranch(Frame& F, int l) {
    const int M = (l == 0) ? TT : TL;
    pg8::SchedPlain S{(const char*)(F.ws + WS_OUTS), (const char*)(F.ws + WS_W + (size_t)l * WL_STRIDE + WO_B), DM / 2, 256, M / 256, 32, F.G, F.bid, 8, 512};
    pg8::EpiFp8 E{F.ws + WS_BV, 8192, BV_SCALE / (OUT_SCALE * GATE_WSCALE)};
    pg8::gemm_phase<pg8::EpiFp8, pg8::SchedPlain, false, true>(F.lds, F.tid, DM / 2, 256, 256, S, E);
}
__device__ __forceinline__ void ph_fgate(Frame& F, int l) {
    const int M = (l == 0) ? TT : TL;
    pg8::SchedPlain S{(const char*)(F.ws + WS_H8), (const char*)(F.ws + WS_W + (size_t)l * WL_STRIDE + WO_G), DM / 2, DM / 2, M / 256, 32, F.G, F.bid, 1 << 30, 0};
    pg8::EpiGate E{F.ws + WS_BV, F.in(25) + (size_t)l * 4 * DM, (bf16_t*)(F.ws + WS_ACC)};
    pg8::gemm_phase<pg8::EpiGate, pg8::SchedPlain, false, true>(F.lds, F.tid, DM / 2, DM / 2, DM / 2, S, E);
}
__device__ __forceinline__ void ph_fmoe_up(Frame& F, int l) {
    pg8::SchedMoe S{(const unsigned*)(F.ws + WS_CTL) + CW_ECNT + l * 16, (const int*)(F.ws + WS_ELIST), (const char*)(F.ws + WS_H8), (const char*)(F.ws + WS_W + (size_t)l * WL_STRIDE + WO_13), 4, F.G, F.bid,
                    (size_t)1024 * DM, (size_t)256 * DM, 0, true};
    pg8::EpiSwiGLU E{(unsigned char*)(F.ws + WS_HID)};
    pg8::gemm_phase<pg8::EpiSwiGLU, pg8::SchedMoe, true, true>(F.lds, F.tid, DM / 2, DM / 2, DM / 2, S, E);
}
__device__ __forceinline__ void ph_fmoe_down(Frame& F, int l) {
    pg8::SchedMoe S{(const unsigned*)(F.ws + WS_CTL) + CW_ECNT + l * 16, (const int*)(F.ws + WS_ELIST), (const char*)(F.ws + WS_HID), (const char*)(F.ws + WS_W + (size_t)l * WL_STRIDE + WO_2), 8, F.G, F.bid,
                    (size_t)DM * DEXP, (size_t)256 * DEXP, (size_t)256 * DEXP, false};
    pg8::EpiMoeDown E{(bf16_t*)(F.ws + WS_PROJ)};
    pg8::gemm_phase<pg8::EpiMoeDown, pg8::SchedMoe, false, true>(F.lds, F.tid, DEXP / 2, DEXP / 2, DEXP / 2, S, E);
}

namespace fa {
using bf16x8 = __attribute__((ext_vector_type(8))) short;
using s16x4 = __attribute__((ext_vector_type(4))) short;
using f32x16 = __attribute__((ext_vector_type(16))) float;
constexpr int NW = 8, QBLK = 32, KVBLK = 64;
constexpr float THR = 8.f;
#define FA_SBAR() __builtin_amdgcn_sched_barrier(0)
__device__ __forceinline__ int crow(int r, int hi) { return (r & 3) + 8 * (r >> 2) + 4 * hi; }
__device__ __forceinline__ unsigned cvtpk(float lo, float hi) { unsigned r; asm volatile("v_cvt_pk_bf16_f32 %0, %1, %2" : "=v"(r) : "v"(lo), "v"(hi)); return r; }
template <int DQK> __device__ __forceinline__ int kswz(int row, int colB) { return row * (DQK * 2) + (colB ^ ((row & 7) << 4)); }
__device__ __forceinline__ int v_st(int k, int c) { const int kk = (k & ~0xC) | ((k & 4) << 1) | ((k & 8) >> 1); return ((kk >> 3) * 4 + (c >> 5)) * 512 + ((kk & 7) * 32 + (c & 31)) * 2; }
__device__ __forceinline__ int v_rd_base(int lane) { return ((lane & 3) << 3) | (((lane >> 2) & 3) << 6) | (((lane >> 4) & 1) << 5) | (((lane >> 5) & 1) << 8); }
constexpr int v_rd_off(int d0, int ks, int half) { return d0 * 512 + ks * 4096 + half * 2048; }
template <int OFF> __device__ __forceinline__ s16x4 tr_read(int vb) { s16x4 r; asm volatile("ds_read_b64_tr_b16 %0, %1 offset:%2" : "=&v"(r) : "v"(vb), "i"(OFF) : "memory"); return r; }
template <int D0> __device__ __forceinline__ void pv_one(f32x16& od, int vb, bf16x8 pa0, bf16x8 pa1, bf16x8 pa2, bf16x8 pa3) {
    const s16x4 l0 = tr_read<v_rd_off(D0, 0, 0)>(vb), h0 = tr_read<v_rd_off(D0, 0, 1)>(vb), l1 = tr_read<v_rd_off(D0, 1, 0)>(vb), h1 = tr_read<v_rd_off(D0, 1, 1)>(vb);
    const s16x4 l2 = tr_read<v_rd_off(D0, 2, 0)>(vb), h2 = tr_read<v_rd_off(D0, 2, 1)>(vb), l3 = tr_read<v_rd_off(D0, 3, 0)>(vb), h3 = tr_read<v_rd_off(D0, 3, 1)>(vb);
    asm volatile("s_waitcnt lgkmcnt(0)" ::: "memory"); FA_SBAR();
#define FA_PK(L, H) (bf16x8){L[0], L[1], L[2], L[3], H[0], H[1], H[2], H[3]}
    od = __builtin_amdgcn_mfma_f32_32x32x16_bf16(pa0, FA_PK(l0, h0), od, 0, 0, 0);
    od = __builtin_amdgcn_mfma_f32_32x32x16_bf16(pa1, FA_PK(l1, h1), od, 0, 0, 0);
    od = __builtin_amdgcn_mfma_f32_32x32x16_bf16(pa2, FA_PK(l2, h2), od, 0, 0, 0);
    od = __builtin_amdgcn_mfma_f32_32x32x16_bf16(pa3, FA_PK(l3, h3), od, 0, 0, 0);
#undef FA_PK
}
__device__ __forceinline__ void pv_d0(f32x16* o, int vb, bf16x8 pa0, bf16x8 pa1, bf16x8 pa2, bf16x8 pa3) {
    pv_one<0>(o[0], vb, pa0, pa1, pa2, pa3); pv_one<1>(o[1], vb, pa0, pa1, pa2, pa3); pv_one<2>(o[2], vb, pa0, pa1, pa2, pa3); pv_one<3>(o[3], vb, pa0, pa1, pa2, pa3);
}
__device__ __forceinline__ void partialSM(f32x16& p0, f32x16& p1, float& m_reg, float& mn, float& alpha, const float C, const float thr_raw) {
    float pmax = p0[0];
#pragma unroll
    for (int r = 1; r < 16; ++r) pmax = fmaxf(pmax, p0[r]);
#pragma unroll
    for (int r = 0; r < 16; ++r) pmax = fmaxf(pmax, p1[r]);
    { auto rr = __builtin_amdgcn_permlane32_swap(__float_as_uint(pmax), __float_as_uint(pmax), false, false); pmax = fmaxf(__uint_as_float(rr[0]), __uint_as_float(rr[1])); }
    if (__builtin_expect(__all(pmax - m_reg <= thr_raw), 1)) { mn = m_reg; alpha = 1.f; }
    else { mn = fmaxf(m_reg, pmax); alpha = __builtin_amdgcn_exp2f((m_reg - mn) * C); m_reg = mn; }
    const float mnC = -mn * C;
#pragma unroll
    for (int r = 0; r < 16; ++r) p0[r] = fmaf(p0[r], C, mnC);
#pragma unroll
    for (int r = 0; r < 16; ++r) p1[r] = fmaf(p1[r], C, mnC);
#pragma unroll
    for (int r = 0; r < 16; ++r) p0[r] = __builtin_amdgcn_exp2f(p0[r]);
}
__device__ __forceinline__ void finishSM(f32x16& p0, f32x16& p1, float alpha, float& l_reg, bf16x8& pa0, bf16x8& pa1, bf16x8& pa2, bf16x8& pa3) {
#pragma unroll
    for (int r = 0; r < 16; ++r) p1[r] = __builtin_amdgcn_exp2f(p1[r]);
    float ps = 0;
#pragma unroll
    for (int r = 0; r < 16; ++r) ps += p0[r];
#pragma unroll
    for (int r = 0; r < 16; ++r) ps += p1[r];
    { auto rr = __builtin_amdgcn_permlane32_swap(__float_as_uint(ps), __float_as_uint(ps), false, false); ps = __uint_as_float(rr[0]) + __uint_as_float(rr[1]); }
    l_reg = l_reg * alpha + ps;
#define FA_PK4(P, BASE, OUT) do { unsigned a0 = cvtpk(P[BASE + 0], P[BASE + 1]), a1 = cvtpk(P[BASE + 2], P[BASE + 3]);   \
    unsigned b0 = cvtpk(P[BASE + 4], P[BASE + 5]), b1 = cvtpk(P[BASE + 6], P[BASE + 7]);                              \
    auto r0 = __builtin_amdgcn_permlane32_swap(a0, b0, false, false); auto r1 = __builtin_amdgcn_permlane32_swap(a1, b1, false, false); \
    u32x4 w = {r0[0], r1[0], r0[1], r1[1]}; OUT = *reinterpret_cast<bf16x8*>(&w); } while (0)
    FA_PK4(p0, 0, pa0); FA_PK4(p0, 8, pa1); FA_PK4(p1, 0, pa2); FA_PK4(p1, 8, pa3);
#undef FA_PK4
}
template <int DQK> __device__ __forceinline__ void qkt(f32x16& p0, f32x16& p1, const char* Ks, const bf16x8* qr, const char* qx, int r32, int hi) {
    p0 = f32x16{}; p1 = f32x16{};
#pragma unroll
    for (int d0 = 0; d0 < DQK / 16; ++d0) { const int cb = (d0 * 16 + hi * 8) * 2;
        const bf16x8 b0 = *reinterpret_cast<const bf16x8*>(Ks + kswz<DQK>(r32, cb));
        const bf16x8 b1 = *reinterpret_cast<const bf16x8*>(Ks + kswz<DQK>(32 + r32, cb));
        const bf16x8 q = d0 < 8 ? qr[d0 < 8 ? d0 : 0] : *reinterpret_cast<const bf16x8*>(qx + (d0 - 8) * 1024);
        p0 = __builtin_amdgcn_mfma_f32_32x32x16_bf16(b0, q, p0, 0, 0, 0);
        p1 = __builtin_amdgcn_mfma_f32_32x32x16_bf16(b1, q, p1, 0, 0, 0);
        if (DQK == 192 && (d0 & 3) == 3) FA_SBAR(); }
}
struct Tiles {
    int nctx_t;
    int ctx_row0;
    int lat_row0;
    int NT;
    __device__ __forceinline__ int krow(int t) const { return t < nctx_t ? ctx_row0 + t * KVBLK : lat_row0 + (t - nctx_t) * KVBLK; }
};
constexpr float NEGM = -1e30f;
template <int MODE> __device__ __forceinline__ void mask_tile(f32x16& p0, f32x16& p1, int t, const Tiles& T, int q_a, int q_b, int k_a, int hi, const float* rpbL) {
    if (MODE == 0 || t < T.nctx_t) return;
    const int tl = t - T.nctx_t;
    if (MODE == 1) {
        const int kb = k_a + tl * KVBLK + 4 * hi - q_a;
#pragma unroll
        for (int r = 0; r < 16; ++r) { const int d0 = kb + (r & 3) + 8 * (r >> 2), d1 = d0 + 32;
            if (d0 > 128 || d0 < -128) p0[r] = NEGM; if (d1 > 128 || d1 < -128) p1[r] = NEGM; }
    } else {
        const int kr = k_a + tl;
        const int rs = min(max(q_a - 4, 0), 128 - 8), cs = min(max(q_b - 8, 0), 64 - 16);
        const bool rok = (kr >= rs) && (kr < rs + 8);
        const float* brow = rpbL + (kr - q_a + 7) * 31 + (15 - q_b);
#pragma unroll
        for (int r = 0; r < 16; ++r) { const int c0 = 4 * hi + (r & 3) + 8 * (r >> 2), c1 = c0 + 32;
            const bool ok0 = rok && c0 >= cs && c0 < cs + 16, ok1 = rok && c1 >= cs && c1 < cs + 16;
            p0[r] = ok0 ? p0[r] + brow[c0] : NEGM; p1[r] = ok1 ? p1[r] + brow[c1] : NEGM;
            if ((r & 3) == 3) asm volatile("" ::: "memory"); }
    }
}

template <int DQK, int SDEPTH, int MODE, int LDQ, int LDK, int LDV>
__device__ __forceinline__ void attn_unit(const bf16_t* __restrict__ Qb, const bf16_t* __restrict__ Kb, const bf16_t* __restrict__ Vb,
                                          bf16_t* __restrict__ Ob, const Tiles T, const float scale, const bool has_sink, const float sink,
                                          const int q_a0, const int k_a, const float* rpbL, char* lds, const int tid_in) {
    constexpr int LDO = DM;
    int tid = tid_in; asm volatile("" : "+v"(tid));
    constexpr int SHM_V = KVBLK * 128 * 2, SHM_K = KVBLK * DQK * 2;
    constexpr int KCH = DQK / 8 * KVBLK / 512;
    const int wid = tid >> 6, lane = tid & 63, r32 = lane & 31, hi = lane >> 5;
    char* V_lds = lds; char* K_lds = lds + 2 * SHM_V;
    float* ws = (float*)(lds + 2 * SHM_V + 2 * SHM_K) + wid * 64; float* li_l = ws; float* al_l = ws + 32;
    const float C = scale * 1.4426950408889634f, thr_raw = THR / scale;
    float m_reg = -1e30f, l_reg = 0; f32x16 o[4] = {}; bf16x8 qr[8];
    const bf16_t* Qw = Qb + (size_t)(wid * QBLK + r32) * LDQ + hi * 8;
#pragma unroll
    for (int d0 = 0; d0 < 8; ++d0) qr[d0] = *reinterpret_cast<const bf16x8*>(Qw + d0 * 16);
    char* qx = lds + 2 * SHM_V + 2 * SHM_K + NW * 256 + wid * 4096 + lane * 16;
    if constexpr (DQK == 192) {
#pragma unroll
        for (int d0 = 8; d0 < 12; ++d0) *(bf16x8*)(qx + (d0 - 8) * 1024) = *reinterpret_cast<const bf16x8*>(Qw + d0 * 16);
    }
    const int sr = tid >> 4, sc = (tid & 15) * 8, vst0 = v_st(sr, sc), vst1 = v_st(32 + sr, sc);
    int krw[KCH], kcb[KCH];
#pragma unroll
    for (int i = 0; i < KCH; ++i) { const int id = tid + 512 * i; krw[i] = id / (DQK / 8); kcb[i] = (id % (DQK / 8)) * 16; }
    const int vb0 = (int)(uintptr_t)V_lds + v_rd_base(lane);
    struct { bf16x8 vs0, vs1, ks[KCH]; } sr_[SDEPTH];
    const char* Vp = (const char*)(Vb + (size_t)sr * LDV + sc);
    const char* Kp[KCH];
#pragma unroll
    for (int c_ = 0; c_ < KCH; ++c_) Kp[c_] = (const char*)Kb + (size_t)krw[c_] * LDK * 2 + kcb[c_];
#define FA_SLOAD(i, t) do { const size_t kr_ = (size_t)T.krow(t); sr_[i].vs0 = *reinterpret_cast<const bf16x8*>(Vp + kr_ * (LDV * 2)); sr_[i].vs1 = *reinterpret_cast<const bf16x8*>(Vp + (kr_ + 32) * (LDV * 2)); \
    _Pragma("unroll") for (int c_ = 0; c_ < KCH; ++c_) sr_[i].ks[c_] = *reinterpret_cast<const bf16x8*>(Kp[c_] + kr_ * (LDK * 2)); } while (0)
#define FA_SWRITE(b, i) do { *(bf16x8*)(V_lds + (b) * SHM_V + vst0) = sr_[i].vs0; *(bf16x8*)(V_lds + (b) * SHM_V + vst1) = sr_[i].vs1; \
    _Pragma("unroll") for (int c_ = 0; c_ < KCH; ++c_) *(bf16x8*)(K_lds + (b) * SHM_K + kswz<DQK>(krw[c_], kcb[c_])) = sr_[i].ks[c_]; } while (0)
#define FA_SWAIT() do { if constexpr (SDEPTH == 2) { if constexpr (KCH == 2) asm volatile("s_waitcnt vmcnt(4)" ::: "memory"); else asm volatile("s_waitcnt vmcnt(5)" ::: "memory"); } else asm volatile("s_waitcnt vmcnt(0)" ::: "memory"); } while (0)
#define FA_RESC(a) do { if (__any((a) < 1.f)) { if (hi == 0) al_l[r32] = (a); asm volatile("s_waitcnt lgkmcnt(0)" ::: "memory"); \
    _Pragma("unroll") for (int d = 0; d < 4; ++d) _Pragma("unroll") for (int r = 0; r < 16; ++r) o[d][r] *= al_l[crow(r, hi)]; } } while (0)
    const int q_a = (MODE == 1) ? q_a0 + wid * QBLK + r32 : q_a0 + ((wid * QBLK + r32) >> 6), q_b = (wid * QBLK + r32) & 63;
#define FA_MASK(P0, P1, t) mask_tile<MODE>(P0, P1, t, T, q_a, q_b, k_a, hi, rpbL)
    f32x16 pA0, pA1, pB0, pB1; float mnA, mnB, alA, alB; bf16x8 pa0, pa1, pa2, pa3; const int NT = T.NT;
    constexpr int SE = 0, SO = SDEPTH - 1;
    FA_SLOAD(SE, 0); asm volatile("s_waitcnt vmcnt(0)" ::: "memory"); FA_SWRITE(0, SE); __syncthreads();
    qkt<DQK>(pA0, pA1, K_lds, qr, qx, r32, hi); FA_MASK(pA0, pA1, 0); partialSM(pA0, pA1, m_reg, mnA, alA, C, thr_raw);
    FA_SLOAD(SO, 1); if constexpr (SDEPTH == 2) { if (2 < NT) FA_SLOAD(SE, 2); }
    FA_SWAIT(); FA_SWRITE(1, SO); __syncthreads();
    for (int j = 1; j + 1 < NT; j += 2) {
        FA_SBAR(); qkt<DQK>(pB0, pB1, K_lds + SHM_K, qr, qx, r32, hi); FA_MASK(pB0, pB1, j);
        finishSM(pA0, pA1, alA, l_reg, pa0, pa1, pa2, pa3); FA_SBAR();
        FA_SLOAD(SO, j + SDEPTH); FA_SBAR();
        pv_d0(o, vb0, pa0, pa1, pa2, pa3); partialSM(pB0, pB1, m_reg, mnB, alB, C, thr_raw);
        __syncthreads(); FA_SWAIT(); FA_SWRITE(0, SE);
        FA_RESC(alB); __syncthreads();
        FA_SBAR(); qkt<DQK>(pA0, pA1, K_lds, qr, qx, r32, hi); FA_MASK(pA0, pA1, j + 1);
        finishSM(pB0, pB1, alB, l_reg, pa0, pa1, pa2, pa3); FA_SBAR();
        if (SDEPTH == 1 || j + 3 < NT) FA_SLOAD(SE, j + 1 + SDEPTH); FA_SBAR();
        pv_d0(o, vb0 + SHM_V, pa0, pa1, pa2, pa3); partialSM(pA0, pA1, m_reg, mnA, alA, C, thr_raw);
        __syncthreads(); FA_SWAIT(); FA_SWRITE(1, SO);
        FA_RESC(alA); __syncthreads();
    }
    FA_SBAR(); qkt<DQK>(pB0, pB1, K_lds + SHM_K, qr, qx, r32, hi); FA_MASK(pB0, pB1, NT - 1);
    finishSM(pA0, pA1, alA, l_reg, pa0, pa1, pa2, pa3); FA_SBAR();
    pv_d0(o, vb0, pa0, pa1, pa2, pa3); partialSM(pB0, pB1, m_reg, mnB, alB, C, thr_raw);
    __syncthreads(); FA_RESC(alB);
    finishSM(pB0, pB1, alB, l_reg, pa0, pa1, pa2, pa3); FA_SBAR();
    pv_d0(o, vb0 + SHM_V, pa0, pa1, pa2, pa3);
    if (has_sink) l_reg += __builtin_amdgcn_exp2f(sink * 1.4426950408889634f - m_reg * C);
    if (hi == 0) li_l[r32] = l_reg; asm volatile("s_waitcnt lgkmcnt(0)" ::: "memory");
    float rli[16];
#pragma unroll
    for (int r = 0; r < 16; ++r) rli[r] = __builtin_amdgcn_rcpf(li_l[crow(r, hi)]);
    __syncthreads();
    int tid2 = tid_in; asm volatile("" : "+v"(tid2));
    const int lane2 = tid2 & 63, wid2 = tid2 >> 6;
    bf16_t* stg = (bf16_t*)(lds + wid2 * (32 * 272));
#pragma unroll
    for (int r = 0; r < 16; ++r) { const int orow = crow(r, hi);
#pragma unroll
        for (int d0 = 0; d0 < 4; ++d0) stg[orow * 136 + d0 * 32 + r32] = (bf16_t)f2bf(o[d0][r] * rli[r]); }
    asm volatile("s_waitcnt lgkmcnt(0)" ::: "memory");
    bf16_t* Ow = Ob + (size_t)(wid2 * QBLK) * LDO;
#pragma unroll
    for (int i = 0; i < 8; ++i) { const int row = i * 4 + (lane2 >> 4), ch = lane2 & 15; const u32x4 v = *(const u32x4*)(stg + row * 136 + ch * 8); *(u32x4*)(Ow + (size_t)row * LDO + ch * 8) = v; }
    __syncthreads();
#undef FA_SLOAD
#undef FA_SWRITE
#undef FA_SWAIT
#undef FA_RESC
#undef FA_MASK
}

template <int LDQ, int LDK, int LDV>
__device__ __forceinline__ void attn_unit_sp192(const bf16_t* __restrict__ Qb, const bf16_t* __restrict__ Kb, const bf16_t* __restrict__ Vb, bf16_t* __restrict__ Ob, const Tiles T, const float scale, char* lds, const int tid_in) {
    constexpr int DQK = 192, LDO = DM, SHM_V = KVBLK * 128 * 2, SHM_K = KVBLK * DQK * 2, KCH = 3;
    int tid = tid_in; asm volatile("" : "+v"(tid));
    const int wid = tid >> 6, lane = tid & 63, r32 = lane & 31, hi = lane >> 5;
    char* V_lds = lds; char* K_lds = lds + 2 * SHM_V;
    float* ws = (float*)(lds + 2 * SHM_V + 2 * SHM_K) + wid * 64; float* li_l = ws; float* al_l = ws + 32;
    const float C = scale * 1.4426950408889634f, thr_raw = THR / scale;
    float m_reg = -1e30f, l_reg = 0; f32x16 o[4] = {}; bf16x8 qr[12];
    const bf16_t* Qw = Qb + (size_t)(wid * QBLK + r32) * LDQ + hi * 8;
#pragma unroll
    for (int d0 = 0; d0 < 12; ++d0) qr[d0] = *reinterpret_cast<const bf16x8*>(Qw + d0 * 16);
    const int sr = tid >> 4, sc = (tid & 15) * 8, vst0 = v_st(sr, sc), vst1 = v_st(32 + sr, sc);
    int krw[KCH], kcb[KCH];
#pragma unroll
    for (int i = 0; i < KCH; ++i) { const int id = tid + 512 * i; krw[i] = id / 24; kcb[i] = (id % 24) * 16; }
    const int vb0 = (int)(uintptr_t)V_lds + v_rd_base(lane);
    const char* Vp = (const char*)(Vb + (size_t)sr * LDV + sc);
    const char* Kp[KCH];
#pragma unroll
    for (int c_ = 0; c_ < KCH; ++c_) Kp[c_] = (const char*)Kb + (size_t)krw[c_] * LDK * 2 + kcb[c_];
    bf16x8 vs0, vs1, ks[KCH];
#define FB_SLOAD(t) do { const size_t kr_ = (size_t)T.krow(t); vs0 = *reinterpret_cast<const bf16x8*>(Vp + kr_ * (LDV * 2)); vs1 = *reinterpret_cast<const bf16x8*>(Vp + (kr_ + 32) * (LDV * 2)); \
    _Pragma("unroll") for (int c_ = 0; c_ < KCH; ++c_) ks[c_] = *reinterpret_cast<const bf16x8*>(Kp[c_] + kr_ * (LDK * 2)); } while (0)
#define FB_SWRITE(b) do { *(bf16x8*)(V_lds + (b) * SHM_V + vst0) = vs0; *(bf16x8*)(V_lds + (b) * SHM_V + vst1) = vs1; \
    _Pragma("unroll") for (int c_ = 0; c_ < KCH; ++c_) *(bf16x8*)(K_lds + (b) * SHM_K + kswz<DQK>(krw[c_], kcb[c_])) = ks[c_]; } while (0)
    const int NT = T.NT;
    FB_SLOAD(0); asm volatile("s_waitcnt vmcnt(0)" ::: "memory"); FB_SWRITE(0); __syncthreads();
    for (int j = 0; j < NT; ++j) {
        const int b = j & 1;
        if (j + 1 < NT) FB_SLOAD(j + 1);
        __builtin_amdgcn_sched_barrier(0);
        f32x16 p0 = f32x16{}, p1 = f32x16{};
        { const char* Ks = K_lds + b * SHM_K;
#pragma unroll
          for (int d0 = 0; d0 < 12; ++d0) { const int cb = (d0 * 16 + hi * 8) * 2;
              const bf16x8 b0 = *reinterpret_cast<const bf16x8*>(Ks + kswz<DQK>(r32, cb));
              const bf16x8 b1 = *reinterpret_cast<const bf16x8*>(Ks + kswz<DQK>(32 + r32, cb));
              p0 = __builtin_amdgcn_mfma_f32_32x32x16_bf16(b0, qr[d0], p0, 0, 0, 0);
              p1 = __builtin_amdgcn_mfma_f32_32x32x16_bf16(b1, qr[d0], p1, 0, 0, 0); } }
        float mn, al; bf16x8 pa0, pa1, pa2, pa3;
        partialSM(p0, p1, m_reg, mn, al, C, thr_raw);
        if (__any(al < 1.f)) { if (hi == 0) al_l[r32] = al; asm volatile("s_waitcnt lgkmcnt(0)" ::: "memory");
#pragma unroll
            for (int d = 0; d < 4; ++d)
#pragma unroll
                for (int r = 0; r < 16; ++r) o[d][r] *= al_l[crow(r, hi)]; }
        finishSM(p0, p1, al, l_reg, pa0, pa1, pa2, pa3);
        __builtin_amdgcn_sched_barrier(0);
        pv_d0(o, vb0 + b * SHM_V, pa0, pa1, pa2, pa3);
        if (j + 1 < NT) { asm volatile("s_waitcnt vmcnt(0)" ::: "memory"); FB_SWRITE(b ^ 1); }
        __syncthreads();
    }
    if (hi == 0) li_l[r32] = l_reg; asm volatile("s_waitcnt lgkmcnt(0)" ::: "memory");
    float rli[16];
#pragma unroll
    for (int r = 0; r < 16; ++r) rli[r] = __builtin_amdgcn_rcpf(li_l[crow(r, hi)]);
    __syncthreads();
    int tid2 = tid_in; asm volatile("" : "+v"(tid2));
    const int lane2 = tid2 & 63, wid2 = tid2 >> 6;
    bf16_t* stg = (bf16_t*)(lds + wid2 * (32 * 272));
#pragma unroll
    for (int r = 0; r < 16; ++r) { const int orow = crow(r, hi);
#pragma unroll
        for (int d0 = 0; d0 < 4; ++d0) stg[orow * 136 + d0 * 32 + r32] = (bf16_t)f2bf(o[d0][r] * rli[r]); }
    asm volatile("s_waitcnt lgkmcnt(0)" ::: "memory");
    bf16_t* Ow = Ob + (size_t)(wid2 * QBLK) * LDO;
#pragma unroll
    for (int i = 0; i < 8; ++i) { const int row = i * 4 + (lane2 >> 4), ch = lane2 & 15; const u32x4 v = *(const u32x4*)(stg + row * 136 + ch * 8); *(u32x4*)(Ow + (size_t)row * LDO + ch * 8) = v; }
    __syncthreads();
#undef FB_SLOAD
#undef FB_SWRITE
}
#undef FA_SBAR
}

namespace fa8 {
typedef int v8i_t __attribute__((ext_vector_type(8)));
typedef int v4i_t __attribute__((ext_vector_type(4)));
using fa::f32x16; using fa::crow;
constexpr int VP = 80;
constexpr float THR8 = 3.f, POFF = 4.f;
struct Tiles8 {
    int nctx_t, ctx_row0, lat_row0, NT, vk_lat0;
    __device__ __forceinline__ int krow(int t) const { return t < nctx_t ? ctx_row0 + t * 64 : lat_row0 + (t - nctx_t) * 64; }
    __device__ __forceinline__ int vkey(int t) const { return t < nctx_t ? t * 64 : vk_lat0 + (t - nctx_t) * 64; }
};
#define FA8_SBAR() __builtin_amdgcn_sched_barrier(0)
#define FA8_MFMA(a, b, c) __builtin_amdgcn_mfma_scale_f32_32x32x64_f8f6f4(a, b, c, 0, 0, 0, 0x7f7f7f7f, 0, 0x7f7f7f7f)
#define FA8_LD32(p) __builtin_shufflevector(*(const v4i_t*)(p), *(const v4i_t*)((p) + 16), 0, 1, 2, 3, 4, 5, 6, 7)
#define FA8_MX3(a, b, c) __builtin_fmaxf(__builtin_fmaxf((a), (b)), (c))
__device__ __forceinline__ void partialSM8(f32x16& p0, f32x16& p1, float& m_reg, float& mn, float& alpha, const float C, const float thr_raw) {
    float pa_ = FA8_MX3(p0[0], p0[1], p1[0]), pb_ = FA8_MX3(p0[2], p0[3], p1[1]); pa_ = FA8_MX3(pa_, p1[2], p1[3]);
#pragma unroll
    for (int r = 4; r < 16; r += 4) { pa_ = FA8_MX3(pa_, p0[r], p0[r + 1]); pb_ = FA8_MX3(pb_, p0[r + 2], p0[r + 3]); pa_ = FA8_MX3(pa_, p1[r], p1[r + 1]); pb_ = FA8_MX3(pb_, p1[r + 2], p1[r + 3]); }
    float pmax = __builtin_fmaxf(pa_, pb_);
    { auto rr = __builtin_amdgcn_permlane32_swap(__float_as_uint(pmax), __float_as_uint(pmax), false, false); pmax = fmaxf(__uint_as_float(rr[0]), __uint_as_float(rr[1])); }
    if (__builtin_expect(__all(pmax - m_reg <= thr_raw), 1)) { mn = m_reg; alpha = 1.f; }
    else { mn = fmaxf(m_reg, pmax); alpha = __builtin_amdgcn_exp2f((m_reg - mn) * C); m_reg = mn; }
    const float mnC = POFF - mn * C;
#pragma unroll
    for (int r = 0; r < 16; ++r) p0[r] = fmaf(p0[r], C, mnC);
#pragma unroll
    for (int r = 0; r < 16; ++r) p1[r] = fmaf(p1[r], C, mnC);
#pragma unroll
    for (int r = 0; r < 16; ++r) p0[r] = __builtin_amdgcn_exp2f(p0[r]);
}
__device__ __forceinline__ void finishSM8(f32x16& p0, f32x16& p1, float alpha, float& l_reg, v8i_t& pa) {
#pragma unroll
    for (int r = 0; r < 16; ++r) p1[r] = __builtin_amdgcn_exp2f(p1[r]);
    float ps = 0;
#pragma unroll
    for (int r = 0; r < 16; ++r) ps += p0[r];
#pragma unroll
    for (int r = 0; r < 16; ++r) ps += p1[r];
    { auto rr = __builtin_amdgcn_permlane32_swap(__float_as_uint(ps), __float_as_uint(ps), false, false); ps = __uint_as_float(rr[0]) + __uint_as_float(rr[1]); }
    l_reg = l_reg * alpha + ps;
#pragma unroll
    for (int k = 0; k < 4; ++k) { int w = __float_as_int(p0[4 * k]); w = __builtin_amdgcn_cvt_pk_fp8_f32(p0[4 * k], p0[4 * k + 1], w, false);     w = __builtin_amdgcn_cvt_pk_fp8_f32(p0[4 * k + 2], p0[4 * k + 3], w, true); pa[k] = w; }
#pragma unroll
    for (int k = 0; k < 4; ++k) { int w = __float_as_int(p1[4 * k]); w = __builtin_amdgcn_cvt_pk_fp8_f32(p1[4 * k], p1[4 * k + 1], w, false); w = __builtin_amdgcn_cvt_pk_fp8_f32(p1[4 * k + 2], p1[4 * k + 3], w, true); pa[4 + k] = w; }
}
template <int DQK> __device__ __forceinline__ void qkt8(f32x16& p0, f32x16& p1, const char* Ks, const v8i_t* qf, int r32, int hi) {
    constexpr int KP = DQK + 16;
    p0 = f32x16{}; p1 = f32x16{};
#pragma unroll
    for (int c = 0; c < DQK / 64; ++c) {
        const v8i_t a0 = FA8_LD32(Ks + r32 * KP + c * 64 + hi * 32);
        const v8i_t a1 = FA8_LD32(Ks + (32 + r32) * KP + c * 64 + hi * 32);
        p0 = FA8_MFMA(a0, qf[c], p0);
        p1 = FA8_MFMA(a1, qf[c], p1); }
}
__device__ __forceinline__ void pv8(f32x16* o, const char* Vs, const v8i_t pa, int r32, int hi) {
#pragma unroll
    for (int n = 0; n < 4; ++n) { const v8i_t b = FA8_LD32(Vs + (32 * n + r32) * VP + hi * 32); o[n] = FA8_MFMA(pa, b, o[n]); }
}

template <int DQK, int SDEPTH, int MODE>
__device__ __forceinline__ void attn_unit8(const unsigned char* __restrict__ Qb, const unsigned char* __restrict__ Kb, const unsigned char* __restrict__ Vt, bf16_t* __restrict__ Ob,
                                           const Tiles8 T, const float scale, const bool has_sink, const float sink, const int q_a0, const int k_a, const float* rpbL, char* lds, const int tid_in) {
    constexpr int LDO = DM, KP = DQK + 16, SHM_K = 64 * KP, SHM_V = 128 * VP;
    int tid = tid_in; asm volatile("" : "+v"(tid));
    const int wid = tid >> 6, lane = tid & 63, r32 = lane & 31, hi = lane >> 5;
    char* K_lds = lds; char* V_lds = lds + 3 * SHM_K;
    float* ws = (float*)(lds + 3 * SHM_K + 3 * SHM_V) + wid * 64; float* li_l = ws; float* al_l = ws + 32;
    const float C = scale * 1.4426950408889634f, thr_raw = THR8 / scale;
    float m_reg = -1e30f, l_reg = 0; f32x16 o[4] = {}; v8i_t qf[DQK / 64];
    { const unsigned char* Qw = Qb + (size_t)(wid * 32 + r32) * Q8P + hi * 32;
#pragma unroll
      for (int c = 0; c < DQK / 64; ++c) qf[c] = FA8_LD32(Qw + c * 64); }
    constexpr int PS = (DQK == 128) ? 16 : 8, PPR = DQK / PS, KCH = 64 * PPR / 512;
    typedef unsigned kpiece_t __attribute__((ext_vector_type(PS / 4)));
    const int krow_ = (tid * KCH) / PPR, kpc_ = (tid * KCH) % PPR; const int kdst0 = krow_ * KP + kpc_ * PS; const unsigned char* Kp0 = Kb + (size_t)krow_ * K8P + kpc_ * PS;
    const int vdst = (tid >> 2) * VP + (tid & 3) * 16; const unsigned char* Vp = Vt + (size_t)(tid >> 2) * VTP + (tid & 3) * 16;
    struct { kpiece_t ks[KCH]; u32x4 vs; } sr_[SDEPTH];
#define FA8_SLOAD(i, t) do { const size_t kr_ = (size_t)T.krow(t); const int vk_ = T.vkey(t); sr_[i].vs = *(const u32x4*)(Vp + vk_); \
    _Pragma("unroll") for (int c_ = 0; c_ < KCH; ++c_) sr_[i].ks[c_] = *(const kpiece_t*)(Kp0 + kr_ * K8P + c_ * PS); } while (0)
#define FA8_SWRITE(b, i) do { *(u32x4*)(V_lds + (b) * SHM_V + vdst) = sr_[i].vs; \
    _Pragma("unroll") for (int c_ = 0; c_ < KCH; ++c_) *(kpiece_t*)(K_lds + (b) * SHM_K + kdst0 + c_ * PS) = sr_[i].ks[c_]; } while (0)
#define FA8_SWAIT() do { if constexpr (KCH == 1) asm volatile("s_waitcnt vmcnt(2)" ::: "memory"); else asm volatile("s_waitcnt vmcnt(4)" ::: "memory"); } while (0)
#define FA8_RESC(a) do { if (__any((a) < 1.f)) { if (hi == 0) al_l[r32] = (a); asm volatile("s_waitcnt lgkmcnt(0)" ::: "memory"); \
    _Pragma("unroll") for (int d = 0; d < 4; ++d) _Pragma("unroll") for (int r = 0; r < 16; ++r) o[d][r] *= al_l[crow(r, hi)]; } } while (0)
    const int q_a = (MODE == 1) ? q_a0 + wid * 32 + r32 : q_a0 + ((wid * 32 + r32) >> 6), q_b = (wid * 32 + r32) & 63;
    const fa::Tiles TM{T.nctx_t, 0, 0, T.NT};
#define FA8_MASK(P0, P1, t) fa::mask_tile<MODE>(P0, P1, t, TM, q_a, q_b, k_a, hi, rpbL)
    f32x16 pA0, pA1, pB0, pB1; float mnA, mnB, alA, alB; v8i_t pa; const int NT = T.NT;
    constexpr int SE = 0, SO = SDEPTH - 1;
    static_assert(SDEPTH == 2, "the three-slot ring is written for two-deep register staging");
    FA8_SLOAD(SE, 0); asm volatile("s_waitcnt vmcnt(0)" ::: "memory"); FA8_SWRITE(0, SE); __syncthreads();
    qkt8<DQK>(pA0, pA1, K_lds, qf, r32, hi); FA8_MASK(pA0, pA1, 0); partialSM8(pA0, pA1, m_reg, mnA, alA, C, thr_raw);
    FA8_SLOAD(SO, 1); if (2 < NT) FA8_SLOAD(SE, 2);
    FA8_SWAIT(); FA8_SWRITE(1, SO); __syncthreads();
    int s_m = 0, s_c = 1, s_p = 2;
    for (int j = 1; j + 1 < NT; j += 2) {
        FA8_SBAR(); qkt8<DQK>(pB0, pB1, K_lds + s_c * SHM_K, qf, r32, hi); FA8_MASK(pB0, pB1, j);
        finishSM8(pA0, pA1, alA, l_reg, pa); FA8_SBAR();
        FA8_SLOAD(SO, j + 2); FA8_SBAR();
        pv8(o, V_lds + s_m * SHM_V, pa, r32, hi); partialSM8(pB0, pB1, m_reg, mnB, alB, C, thr_raw);
        FA8_SWAIT(); FA8_SWRITE(s_p, SE);
        FA8_RESC(alB); __syncthreads();
        FA8_SBAR(); qkt8<DQK>(pA0, pA1, K_lds + s_p * SHM_K, qf, r32, hi); FA8_MASK(pA0, pA1, j + 1);
        finishSM8(pB0, pB1, alB, l_reg, pa); FA8_SBAR();
        if (j + 3 < NT) FA8_SLOAD(SE, j + 3); FA8_SBAR();
        pv8(o, V_lds + s_c * SHM_V, pa, r32, hi); partialSM8(pA0, pA1, m_reg, mnA, alA, C, thr_raw);
        FA8_SWAIT(); FA8_SWRITE(s_m, SO);
        FA8_RESC(alA); __syncthreads();
        { const int t0 = s_m; s_m = s_p; s_p = s_c; s_c = t0; }
    }
    FA8_SBAR(); qkt8<DQK>(pB0, pB1, K_lds + s_c * SHM_K, qf, r32, hi); FA8_MASK(pB0, pB1, NT - 1);
    finishSM8(pA0, pA1, alA, l_reg, pa); FA8_SBAR();
    pv8(o, V_lds + s_m * SHM_V, pa, r32, hi); partialSM8(pB0, pB1, m_reg, mnB, alB, C, thr_raw);
    FA8_RESC(alB);
    finishSM8(pB0, pB1, alB, l_reg, pa); FA8_SBAR();
    pv8(o, V_lds + s_c * SHM_V, pa, r32, hi);
    if (has_sink) l_reg += __builtin_amdgcn_exp2f(POFF + sink * 1.4426950408889634f - m_reg * C);
    if (hi == 0) li_l[r32] = l_reg; asm volatile("s_waitcnt lgkmcnt(0)" ::: "memory");
    float rli[16];
#pragma unroll
    for (int r = 0; r < 16; ++r) rli[r] = __builtin_amdgcn_rcpf(li_l[crow(r, hi)]);
    __syncthreads();
    int tid2 = tid_in; asm volatile("" : "+v"(tid2));
    const int lane2 = tid2 & 63, wid2 = tid2 >> 6;
    unsigned char* stg = (unsigned char*)(lds + wid2 * (32 * 144));
#pragma unroll
    for (int r = 0; r < 16; ++r) { const int orow = crow(r, hi); const float sc_ = rli[r] * OUT_SCALE;
#pragma unroll
        for (int d0 = 0; d0 < 4; d0 += 2) { int w = 0; w = cvt8s(o[d0][r] * sc_, o[d0 + 1][r] * sc_, w, false);
            stg[orow * 144 + d0 * 32 + r32] = (unsigned char)w; stg[orow * 144 + (d0 + 1) * 32 + r32] = (unsigned char)(w >> 8); } }
    asm volatile("s_waitcnt lgkmcnt(0)" ::: "memory");
    unsigned char* Ow = (unsigned char*)Ob + (size_t)(wid2 * 32) * LDO;
#pragma unroll
    for (int i = 0; i < 4; ++i) { const int row = i * 8 + (lane2 >> 3), ch = lane2 & 7; const u32x4 v = *(const u32x4*)(stg + row * 144 + ch * 16); *(u32x4*)(Ow + (size_t)row * LDO + ch * 16) = v; }
    __syncthreads();
#undef FA8_SLOAD
#undef FA8_SWRITE
#undef FA8_SWAIT
#undef FA8_RESC
#undef FA8_MASK
}
#undef FA8_SBAR
}

#define XCDU(u) ((((u) & 7) << 5) | (((u) >> 3) & 31))
__device__ __forceinline__ void ph_fattn8(Frame& F, int l) {
    unsigned char* OUTS = F.ws + WS_OUTS;
    const unsigned char* Q8 = F.ws + WS_Q8; const unsigned char* K8 = F.ws + WS_K8; const unsigned char* V8T = F.ws + WS_V8T;
    char* lds = (char*)(unsigned char*)F.lds;
    float* rpbL = (float*)(lds + 120 * 1024);
    {
        const float* rpb = F.in(22) + (size_t)l * 4 * 15 * 31;
        for (int i = F.tid; i < 4 * 15 * 31; i += NTHREADS) rpbL[i] = rpb[i] * 11.313708498984761f;
        __syncthreads();
    }
    const float sc128 = 0.08838834764831845f, sc192 = 0.07216878364870323f;
    const int nctxu = (l == 0) ? 8 : 0;
    if (FA_SEL & 1) for (int u = F.bid; u < 256 + nctxu; u += F.G) {
        launder(F);
        const bool cq = u >= 256; const int v = cq ? u - 256 : XCDU(u), b = cq ? (v >> 2) : (v >> 7), h = cq ? (v & 3) : ((v >> 5) & 3), r0 = cq ? TL + b * NCTX : b * SEQ + (v & 31) * 256;
        fa8::Tiles8 T{4, TL + b * NCTX, b * SEQ, cq ? 4 : 132, 256};
        fa8::attn_unit8<192, 2, 0>(Q8 + (size_t)r0 * Q8P + Q8_M + h * 192, K8 + K8_M + h * 192, V8T + (size_t)((8 + h) * 2 + b) * 128 * VTP, (bf16_t*)(OUTS + (size_t)r0 * DM + 512 + h * 128), T, sc192,
                                   false, 0.f, 0, 0, nullptr, lds, F.tid);
    }
    if (FA_SEL & 2) for (int u = F.bid; u < 256 + 3 * nctxu; u += F.G) {
        launder(F);
        const bool cq = u >= 256; const int v = cq ? u - 256 : XCDU(u);
        const int mx = cq ? ((v >> 3) == 0 ? 0 : (v >> 3) + 1) : 0, b = cq ? ((v >> 2) & 1) : (v >> 7), h = cq ? (v & 3) : ((v >> 5) & 3), r0 = cq ? TL + b * NCTX : b * SEQ + (v & 31) * 256;
        const int qo = mx == 0 ? Q8_A : (mx == 2 ? Q8_W : Q8_N), ko = mx == 0 ? K8_A : (mx == 2 ? K8_W : K8_N), kvh = (mx == 3) ? h : (h >> 1), hidx = (mx == 0 ? 0 : (mx == 2 ? 2 : 4)) + kvh;
        fa8::Tiles8 T{4, TL + b * NCTX, b * SEQ, cq ? 4 : 132, 256};
        fa8::attn_unit8<128, 2, 0>(Q8 + (size_t)r0 * Q8P + qo + h * 128, K8 + ko + kvh * 128, V8T + (size_t)(hidx * 2 + b) * 128 * VTP, (bf16_t*)(OUTS + (size_t)r0 * DM + mx * 512 + h * 128), T, sc128,
                                   mx == 2, F.in(21)[l * 4 + h], 0, 0, nullptr, lds, F.tid);
    }
    if (FA_SEL & 4) for (int u = F.bid; u < 256; u += F.G) {
        launder(F);
        const int uu = XCDU(u), b = uu >> 7, h = (uu >> 5) & 3, qb = uu & 31, r0 = b * SEQ + qb * 256;
        const int q0 = qb * 256, k0 = max(q0 - 128, 0), k1 = min(q0 + 384, SEQ);
        fa8::Tiles8 T{4, TL + b * NCTX, b * SEQ + k0, 4 + (k1 - k0) / 64, 256 + k0};
        fa8::attn_unit8<128, 2, 1>(Q8 + (size_t)r0 * Q8P + Q8_W + h * 128, K8 + K8_W + (h >> 1) * 128, V8T + (size_t)((2 + (h >> 1)) * 2 + b) * 128 * VTP, (bf16_t*)(OUTS + (size_t)r0 * DM + 2 * 512 + h * 128), T, sc128,
                                   true, F.in(21)[l * 4 + h], q0, k0, nullptr, lds, F.tid);
    }
    if (FA_SEL & 8) for (int u = F.bid; u < 256; u += F.G) {
        launder(F);
        const int uu = XCDU(u), b = uu >> 7, h = (uu >> 5) & 3, qb = uu & 31, r0 = b * SEQ + qb * 256;
        const int g0 = qb * 4, ks = min(max(g0 - 4, 0), 120), ke = min(max(g0 + 3 - 4, 0), 120) + 8;
        int nt = ke - ks; nt += (nt & 1);
        const int ks2 = (ks + nt > 128) ? 128 - nt : ks;
        fa8::Tiles8 T{4, TL + b * NCTX, b * SEQ + ks2 * 64, 4 + nt, 256 + ks2 * 64};
        fa8::attn_unit8<128, 2, 2>(Q8 + (size_t)r0 * Q8P + Q8_N + h * 128, K8 + K8_N + h * 128, V8T + (size_t)((4 + h) * 2 + b) * 128 * VTP, (bf16_t*)(OUTS + (size_t)r0 * DM + 3 * 512 + h * 128), T, sc128,
                                   false, 0.f, g0, ks2, rpbL + h * 465, lds, F.tid);
    }
}

__device__ __forceinline__ void ph_fattn(Frame& F, int l) {
    const bf16_t* PROJ = (const bf16_t*)(F.ws + WS_PROJ);
    bf16_t* OUTS = (bf16_t*)(F.ws + WS_OUTS);
    char* lds = (char*)(unsigned char*)F.lds;
    float* rpbL = (float*)(lds + 120 * 1024);
    {
        const float* rpb = F.in(22) + (size_t)l * 4 * 15 * 31;
        for (int i = F.tid; i < 4 * 15 * 31; i += NTHREADS) rpbL[i] = rpb[i] * 11.313708498984761f;
        __syncthreads();
    }
    const float sc128 = 0.08838834764831845f, sc192 = 0.07216878364870323f;
    const int nctxu = (l == 0) ? 8 : 0;
    if (FA_SEL & 1) for (int u = F.bid; u < 256 + nctxu; u += F.G) {
        launder(F);
        const bool cq = u >= 256; const int v = cq ? u - 256 : u, b = cq ? (v >> 2) : (v >> 7), h = cq ? (v & 3) : ((v >> 5) & 3), r0 = cq ? TL + b * NCTX : b * SEQ + (v & 31) * 256;
        fa::Tiles T{4, TL + b * NCTX, b * SEQ, cq ? 4 : 132};
        fa::attn_unit_sp192<768, 768, 1024>((const bf16_t*)(F.ws + WS_MQ) + (size_t)r0 * 768 + h * 192, (const bf16_t*)(F.ws + WS_MK) + h * 192, (const bf16_t*)(F.ws + WS_MKV) + h * 256 + 128,
                                            OUTS + (size_t)r0 * DM + 512 + h * 128, T, sc192, lds, F.tid);
    }
    if (FA_SEL & 2) for (int u = F.bid; u < 256 + 3 * nctxu; u += F.G) {
        launder(F);
        const bool cq = u >= 256; const int v = cq ? u - 256 : u;
        const int mx = cq ? ((v >> 3) == 0 ? 0 : (v >> 3) + 1) : 0, b = cq ? ((v >> 2) & 1) : (v >> 7), h = cq ? (v & 3) : ((v >> 5) & 3), r0 = cq ? TL + b * NCTX : b * SEQ + (v & 31) * 256;
        const int cqo = mx == 0 ? C_AQ : (mx == 2 ? C_WQ : C_NQ), cko = mx == 0 ? C_AK : (mx == 2 ? C_WK : C_NK), cvo = mx == 0 ? C_AV : (mx == 2 ? C_WV : C_NV), kvh = (mx == 3) ? h : (h >> 1);
        fa::Tiles T{4, TL + b * NCTX, b * SEQ, cq ? 4 : 132};
        fa::attn_unit<128, 1, 0, PP, PP, PP>(PROJ + (size_t)r0 * PP + cqo + h * 128, PROJ + cko + kvh * 128, PROJ + cvo + kvh * 128, OUTS + (size_t)r0 * DM + mx * 512 + h * 128, T, sc128,
                                             mx == 2, F.in(21)[l * 4 + h], 0, 0, nullptr, lds, F.tid);
    }
    if (FA_SEL & 4) for (int u = F.bid; u < 256; u += F.G) {
        launder(F);
        const int uu = XCDU(u), b = uu >> 7, h = (uu >> 5) & 3, qb = uu & 31, r0 = b * SEQ + qb * 256;
        const int q0 = qb * 256, k0 = max(q0 - 128, 0), k1 = min(q0 + 384, SEQ);
        fa::Tiles T{4, TL + b * NCTX, b * SEQ + k0, 4 + (k1 - k0) / 64};
        fa::attn_unit<128, 1, 1, PP, PP, PP>(PROJ + (size_t)r0 * PP + C_WQ + h * 128, PROJ + C_WK + (h >> 1) * 128, PROJ + C_WV + (h >> 1) * 128, OUTS + (size_t)r0 * DM + 2 * 512 + h * 128, T, sc128,
                                             true, F.in(21)[l * 4 + h], q0, k0, nullptr, lds, F.tid);
    }
    if (FA_SEL & 8) for (int u = F.bid; u < 256; u += F.G) {
        launder(F);
        const int b = u >> 7, h = (u >> 5) & 3, qb = u & 31, r0 = b * SEQ + qb * 256;
        const int g0 = qb * 4, ks = min(max(g0 - 4, 0), 120), ke = min(max(g0 + 3 - 4, 0), 120) + 8;
        int nt = ke - ks; nt += (nt & 1);
        const int ks2 = (ks + nt > 128) ? 128 - nt : ks;
        fa::Tiles T{4, TL + b * NCTX, b * SEQ + ks2 * 64, 4 + nt};
        fa::attn_unit<128, 1, 2, PP, PP, PP>(PROJ + (size_t)r0 * PP + C_NQ + h * 128, PROJ + C_NK + h * 128, PROJ + C_NV + h * 128, OUTS + (size_t)r0 * DM + 3 * 512 + h * 128, T, sc128,
                                             false, 0.f, g0, ks2, rpbL + h * 465, lds, F.tid);
    }
}

__device__ __forceinline__ void ph_fgemm_bf16(Frame& F, const bf16_t* A, int lda, const bf16_t* Bt, int K, int M, int N, bf16_t* C, int ldc) {
    pg8::SchedPlain S{(const char*)A, (const char*)Bt, lda, K, M / 256, N / 256, F.G, F.bid, 1 << 30, 0};
    pg8::EpiBf16 E{C, ldc, 1.0f};
    pg8::gemm_phase<pg8::EpiBf16, pg8::SchedPlain, false>(F.lds, F.tid, lda, K, K, S, E);
}
__device__ __forceinline__ void ph_fg1_fp8(Frame& F, int l) {
    pg8::SchedPlain S{(const char*)(F.ws + WS_H8), (const char*)(F.ws + WS_W + (size_t)l * WL_STRIDE + WO_IN), DM / 2, DM / 2, TT / 256, PP / 256, F.G, F.bid, 1 << 30, 0};
    pg8::EpiBf16 E{(bf16_t*)(F.ws + WS_PROJ), PP, 1.0f / GATE_WSCALE};
    pg8::gemm_phase<pg8::EpiBf16, pg8::SchedPlain, false, true>(F.lds, F.tid, DM / 2, DM / 2, DM / 2, S, E);
}
__device__ __forceinline__ void ph_fmla_up(Frame& F, int l) {
    pg8::SchedPlain S{(const char*)(F.ws + WS_MK), (const char*)(F.ws + WS_W + (size_t)l * WL_STRIDE + WO_UQ), MCP / 2, 256, TT / 256, MQP / 256, F.G, F.bid, 4, 128};
    pg8::EpiBf16 E{(bf16_t*)(F.ws + WS_MQ), MQP, 1.0f / GATE_WSCALE};
    pg8::gemm_phase<pg8::EpiBf16, pg8::SchedPlain, false, true>(F.lds, F.tid, MCP / 2, 256, 256, S, E);
}
__device__ __forceinline__ void ph_fout(Frame& F, int l) {
    const int M = (l == 0) ? TT : TL;
    const unsigned char* Wt = F.ws + WS_W + (size_t)l * WL_STRIDE + WO_O;
    pg8::SchedPlain S{(const char*)(F.ws + WS_ACC), (const char*)Wt, DM / 2, DM / 2, M / 256, DM / 256, F.G, F.bid, 1 << 30, 0};
    pg8::EpiResid E{l == 0 ? F.in(0) : F.out, l == 0 ? F.in(2) : (const float*)(F.ws + WS_XC), F.out, (float*)(F.ws + WS_XC), (const float*)(F.ws + WS_MOD) + (size_t)l * 3 * 6 * DM, 2, 1.0f / (ACC_SCALE * GATE_WSCALE)};
    pg8::gemm_phase<pg8::EpiResid, pg8::SchedPlain, false, true>(F.lds, F.tid, DM / 2, DM / 2, DM / 2, S, E);
}

constexpr int LDS_BYTES = 147456;
constexpr int MISC_OFF = 131072 + 320;
constexpr int N_PHASES = 1 + 12 * DEPTH + 1;

__global__ void __launch_bounds__(NTHREADS, 2) mega(Args args) {
    extern __shared__ __attribute__((aligned(16))) unsigned char lds[];
    Frame F;
    F.lds = (LAS unsigned char*)lds; F.out = args.out; F.ws = args.ws;
    F.tid = threadIdx.x; F.lane = F.tid & 63; F.wave = __builtin_amdgcn_readfirstlane(F.tid >> 6); F.G = gridDim.x; F.bid = blockIdx.x;
    volatile LAS unsigned* MISC = (volatile LAS unsigned*)(F.lds + MISC_OFF);
    if (F.tid < 32) MISC[F.tid] = 0u;
    __syncthreads();
    XcdBarrier bar; bar.bar = (unsigned*)(F.ws + WS_CTL) + CW_BAR; bar.x = 0; bar.st = nullptr;
    if (args.ph_hi - args.ph_lo > 1) bar = xcd_barrier_post((unsigned*)(F.ws + WS_CTL) + CW_BAR, MISC + 8, F.tid);
#define IN(k) (launder(F), lo <= (k) && (k) < hi)
#define SEAM(k) do { if (IN(k) && IN((k) + 1)) xcd_barrier(bar, F.tid); } while (0)
#define LAYER(l) do { \
        const int pb = 1 + 12 * l; \
        if (IN(pb + 0)) { ph_prep1(F, l); } SEAM(pb + 0); \
        unsigned char* wl = F.ws + WS_W + (size_t)l * WL_STRIDE; \
        if (IN(pb + 1)) { \
            if (FAST_MASK & 1) { for (int rep = 0; rep < REP_GEMM; ++rep) ph_fg1_fp8(F, l); } \
            else ph_ngemm_bf16(F, (const bf16_t*)(F.ws + WS_H), DM, F.in(8) + (size_t)l * DM * DIN, DIN, DM, TT, DIN, (bf16_t*)(F.ws + WS_PROJ), PP); \
        } SEAM(pb + 1); \
        if (IN(pb + 2)) { if (FAST_MASK & 64) ph_prep2_fast(F, l); else ph_prep2(F, l); } SEAM(pb + 2); \
        if (IN(pb + 3)) { \
            if (FAST_MASK & 2) { \
                ph_fmla_up(F, l); \
            } else { \
                ph_ngemm_bf16(F, (const bf16_t*)(F.ws + WS_PROJ) + C_MCQ, PP, F.in(10) + (size_t)l * 384 * 768, 768, 384, TT, 768, (bf16_t*)(F.ws + WS_MQ), 768); \
                ph_ngemm_bf16(F, (const bf16_t*)(F.ws + WS_PROJ) + C_MCKV, PP, F.in(12) + (size_t)l * 256 * 1024, 1024, 256, TT, 1024, (bf16_t*)(F.ws + WS_MKV), 1024); \
            } \
        } SEAM(pb + 3); \
        if (IN(pb + 4)) { if (FAST_MASK & 64) ph_prep3_fast(F, l); else ph_prep3(F, l); } SEAM(pb + 4); \
        if (IN(pb + 5)) { if (FAST_MASK & 32) { for (int rep = 0; rep < REP_ATT; ++rep) ph_fattn8(F, l); } else ph_nattn(F, l); } SEAM(pb + 5); \
        if (IN(pb + 6)) { if (FAST_MASK & 8) { for (int rep = 0; rep < REP_GEMM; ++rep) ph_fbranch(F, l); } } SEAM(pb + 6); \
        if (IN(pb + 7)) { if (FAST_MASK & 8) { for (int rep = 0; rep < REP_GEMM; ++rep) ph_fgate(F, l); } else ph_nmerge(F, l); } SEAM(pb + 7); \
        if (IN(pb + 8)) { if (FAST_MASK & 4) ph_fout(F, l); else ph_nout(F, l); } SEAM(pb + 8); \
        if (IN(pb + 9)) { ph_prep4(F, l); } SEAM(pb + 9); \
        if (IN(pb + 10)) { if (FAST_MASK & 16) { for (int rep = 0; rep < REP_MOE; ++rep) ph_fmoe_up(F, l); } else ph_nmoe(F, l); } SEAM(pb + 10); \
        if (IN(pb + 11)) { if (FAST_MASK & 16) { for (int rep = 0; rep < REP_MOE; ++rep) ph_fmoe_down(F, l); } } SEAM(pb + 11); \
    } while (0)
#if PREFIX_K > 0
    {
        const int lo = 0, hi = PREFIX_K;
        if (IN(0)) { ph_mod(F); if (FAST_MASK) { rope_tables_build(F); ph_convert(F); } } SEAM(0);
        LAYER(0);
        xcd_barrier(bar, F.tid);
        if (F.bid == 0 && F.tid < 32) ((unsigned*)(F.ws + WS_CTL))[CW_ECNT + F.tid] = 0u;
        xcd_barrier(bar, F.tid);
    }
#endif
    const int lo = args.ph_lo, hi = args.ph_hi;
    if (IN(0)) { for (int rep = 0; rep < REP_PRO; ++rep) { ph_mod(F); if (FAST_MASK) { rope_tables_build(F); ph_convert(F); } } } SEAM(0);
    LAYER(0);
    LAYER(1);
#undef LAYER
    if (IN(N_PHASES - 1)) { ph_prep1(F, DEPTH); }
#undef IN
#undef SEAM
}

extern "C" void kernel_launch(void* const* d_in, const int* in_sizes, int n_in, void* d_out, int out_size, void* d_ws, size_t ws_size, hipStream_t stream) {
    static int grid = 0;
    if (grid == 0) {
        if (n_in != 32 || in_sizes[0] != TL * DM || out_size != TL * DM || ws_size < WS_END) {
            fprintf(stderr, "kernel_launch: shape mismatch n_in %d in0 %d out %d ws %zu (need %zu)\n", n_in, n_in > 0 ? in_sizes[0] : -1, out_size, ws_size, (size_t)WS_END); grid = -1; return; }
        int dev = 0, cus = 0, per_cu = 0;
        if (hipGetDevice(&dev) != hipSuccess || hipDeviceGetAttribute(&cus, hipDeviceAttributeMultiprocessorCount, dev) != hipSuccess) { grid = -1; return; }
        if (hipFuncSetAttribute((const void*)mega, hipFuncAttributeMaxDynamicSharedMemorySize, LDS_BYTES) != hipSuccess) { fprintf(stderr, "kernel_launch: hipFuncSetAttribute failed\n"); grid = -1; return; }
        if (hipOccupancyMaxActiveBlocksPerMultiprocessor(&per_cu, (const void*)mega, NTHREADS, LDS_BYTES) != hipSuccess || per_cu < 1) { fprintf(stderr, "kernel_launch: occupancy query says %d\n", per_cu); }
        (void)hipGetLastError();
        grid = cus;
    }
    if (grid < 0) return;
    if (hipMemsetAsync((char*)d_ws + WS_CTL, 0, CTL_ZERO_BYTES, stream) != hipSuccess) return;
    Args a{};
    for (int i = 0; i < 32; ++i) a.in[i] = (const float*)d_in[i];
    a.out = (float*)d_out; a.ws = (unsigned char*)d_ws;
#if MK_N_LAUNCHES == 1
    a.ph_lo = 0; a.ph_hi = N_PHASES;
    hipLaunchKernelGGL(mega, dim3(grid), dim3(NTHREADS), LDS_BYTES, stream, a);
#else
    for (int p = 0; p < N_PHASES; ++p) { a.ph_lo = p; a.ph_hi = p + 1; hipLaunchKernelGGL(mega, dim3(grid), dim3(NTHREADS), LDS_BYTES, stream, a); }
#endif
    const hipError_t le = hipPeekAtLastError();
    if (le != hipSuccess) fprintf(stderr, "kernel_launch: launch failed: %s\n", hipGetErrorName(le));
}
```

```cpp
#include <hip/hip_runtime.h>
#include <cstdio>
#include <cstdint>

#ifndef FAST_MASK
#define FAST_MASK 127
#endif
#ifndef REP_PRO
#define REP_PRO 1
#endif
#ifndef REP_ATT
#define REP_ATT 1
#endif
#ifndef REP_GEMM
#define REP_GEMM 1
#endif
#ifndef REP_MOE
#define REP_MOE 1
#endif
#ifndef PREFIX_K
#define PREFIX_K 0
#define CLK_PROBE 0
#define VALU_PROBE 0
#define SCL_DIV 1
#define PROBE_PH 13
#endif
#ifndef FA_SEL
#define FA_SEL 31
#endif
#ifndef MK_N_LAUNCHES
#define MK_N_LAUNCHES 1
#endif

constexpr int DM = 2048, NB = 2, SEQ = 8192, NCTX = 256, TL = NB * SEQ, TC = NB * NCTX, TT = TL + TC, DEPTH = 2;
constexpr int DIN = 4288, PP = 4352;
constexpr int C_AQ = 0, C_AK = 512, C_AV = 768, C_MCQ = 1024, C_MCKV = 1408, C_MKR = 1664, C_WQ = 1728, C_WK = 2240, C_WV = 2496, C_NQ = 2752, C_NK = 3264, C_NV = 3776;
constexpr int NEXP = 16, DEXP = 512;
constexpr float EPS = 1e-6f;
constexpr float BV_SCALE = 64.0f;
constexpr float ACC_SCALE = 64.0f;
constexpr float OUT_SCALE = 32.0f;
constexpr float GATE_WSCALE = 32.0f;
constexpr int NWAVES = 8, NTHREADS = 512;

constexpr size_t MiB = 1u << 20;
constexpr size_t WS_CTL = 0, CTL_ZERO_BYTES = 1 * MiB;
constexpr size_t WS_MOD = 1 * MiB;
constexpr size_t WS_ROPE = 1 * MiB + 512 * 1024;
constexpr size_t WS_XC = 2 * MiB;
constexpr size_t WS_ELIST = 7 * MiB;
constexpr size_t WS_ELW = 9 * MiB;
constexpr size_t WS_H = 16 * MiB;
constexpr size_t WS_PROJ = 82 * MiB;
constexpr size_t WS_MQ = 223 * MiB;
constexpr size_t WS_MKV = 248 * MiB;
constexpr size_t WS_MK = 281 * MiB;
constexpr int MCP = 640, MQP = 1792;
constexpr size_t WS_HID = 306 * MiB;
constexpr size_t WS_BV = 82 * MiB;
constexpr size_t WS_OUTS = 346 * MiB;
constexpr size_t WS_ACC = 412 * MiB;
constexpr size_t WS_W = 478 * MiB;
constexpr size_t WL_STRIDE = 163 * MiB;
constexpr size_t WO_IN = 0, WO_UQ = 17 * MiB, WO_UKV = 18 * MiB, WO_G = 19 * MiB, WO_B = 51 * MiB, WO_O = 59 * MiB, WO_13 = 67 * MiB, WO_2 = 131 * MiB;
constexpr size_t WS_H8 = 804 * MiB;
constexpr size_t WS_Q8 = 838 * MiB;
constexpr size_t WS_K8 = 876 * MiB;
constexpr size_t WS_V8T = 905 * MiB;
constexpr size_t WS_END = 930 * MiB;
constexpr int Q8P = 2304, K8P = 1792, VTP = 8448;
constexpr int Q8_A = 0, Q8_W = 512, Q8_N = 1024, Q8_M = 1536, K8_A = 0, K8_W = 256, K8_N = 512, K8_M = 1024;
static_assert(WS_BV + (size_t)TT * 8192 * 2 <= WS_OUTS && WS_HID + (size_t)148 * 256 * 512 * 2 <= WS_OUTS && WS_W + 2 * WL_STRIDE <= WS_END, "d_ws map");
constexpr int CW_ECNT = 64;
constexpr int CW_BAR = 4096;

typedef unsigned short bf16_t;
#define LAS __attribute__((address_space(3)))
#define GAS __attribute__((address_space(1)))
typedef float f32x4 __attribute__((ext_vector_type(4)));
typedef unsigned u32x4 __attribute__((ext_vector_type(4)));
typedef unsigned u32x2 __attribute__((ext_vector_type(2)));
typedef float f32x2v __attribute__((ext_vector_type(2)));

__device__ __forceinline__ float bf2f(unsigned v) { return __uint_as_float(v << 16); }
__device__ __forceinline__ unsigned f2bf(float f) { unsigned u = __float_as_uint(f); return (u + 0x7fffu + ((u >> 16) & 1u)) >> 16; }
__device__ __forceinline__ unsigned pk2(float lo, float hi) { return f2bf(lo) | (f2bf(hi) << 16); }
__device__ __forceinline__ float lo16(unsigned w) { return __uint_as_float(w << 16); }
__device__ __forceinline__ float hi16(unsigned w) { return __uint_as_float(w & 0xffff0000u); }
__device__ __forceinline__ int cvt8s(float a, float b, int old, bool hi) {
    a = __builtin_amdgcn_fmed3f(a, -448.f, 448.f); b = __builtin_amdgcn_fmed3f(b, -448.f, 448.f);
    return hi ? __builtin_amdgcn_cvt_pk_fp8_f32(a, b, old, true) : __builtin_amdgcn_cvt_pk_fp8_f32(a, b, old, false);
}
__device__ __forceinline__ float wave_sum(float v) {
#pragma unroll
    for (int o = 1; o < 64; o <<= 1) v += __shfl_xor(v, o);
    return v;
}
__device__ __forceinline__ float sigmoidf_(float x) { return 1.0f / (1.0f + __expf(-x)); }
__device__ __forceinline__ float siluf_(float x) { return x / (1.0f + __expf(-x)); }

#define XB_TMO      128
#define XB_XCNT(j)  (256  + 64 * (j))
#define XB_XSUB(j)  (1280 + 64 * (j))
#define XB_XGEN(j)  (2304 + 64 * (j))
#define XB_TOP      3328
#define XB_TOPGEN   3392
#define XCD_BAR_WORDS 3456
#define XB_SPIN_CAP (1u << 22)

__device__ __forceinline__ unsigned xb_ld(unsigned* p)              { return __hip_atomic_load(p, __ATOMIC_RELAXED, __HIP_MEMORY_SCOPE_AGENT); }
__device__ __forceinline__ unsigned xb_add(unsigned* p, unsigned v) { return __hip_atomic_fetch_add(p, v, __ATOMIC_RELAXED, __HIP_MEMORY_SCOPE_AGENT); }
__device__ __forceinline__ unsigned xb_xcc_id() { return (unsigned)__builtin_amdgcn_s_getreg((3 << 11) | 20) & 0xFu; }
#define XB_SPIN(cond, bar) do { unsigned _sp = 0; while (cond) { __builtin_amdgcn_s_sleep(1); \
    if ((++_sp & 255u) == 0u) { if (xb_ld(&(bar)[XB_TMO])) break; if (_sp > XB_SPIN_CAP) { atomicAdd(&(bar)[XB_TMO], 1u); break; } } } } while (0)

struct XcdBarrier { unsigned* bar; unsigned x; volatile LAS unsigned* st; };

__device__ __forceinline__ XcdBarrier xcd_barrier_post(unsigned* bar, volatile LAS unsigned* st, int tid) {
    XcdBarrier b; b.bar = bar; b.x = xb_xcc_id(); b.st = st;
    if (tid == 0) (void)xb_add(&bar[XB_XCNT(b.x)], 1u);
    return b;
}
__device__ __forceinline__ void xcd_barrier_complete(unsigned* bar, unsigned x, unsigned& nloc, unsigned& nx) {
    const unsigned G = gridDim.x * gridDim.y * gridDim.z;
    unsigned sum, cnt, mine, sp = 0u;
    for (;;) {
        sum = 0u; cnt = 0u; mine = 0u;
#pragma unroll
        for (unsigned j = 0; j < 16; ++j) { const unsigned c = xb_ld(&bar[XB_XCNT(j)]); sum += c; cnt += (c > 0u) ? 1u : 0u; mine = (j == x) ? c : mine; }
        if (sum == G) break;
        __builtin_amdgcn_s_sleep(1);
        if ((++sp & 255u) == 0u) { if (xb_ld(&bar[XB_TMO])) break; if (sp > XB_SPIN_CAP) { atomicAdd(&bar[XB_TMO], 1u); break; } }
    }
    nloc = mine > 0u ? mine : 1u; nx = cnt > 0u ? cnt : 1u;
}
__device__ __forceinline__ void xcd_barrier(const XcdBarrier& b, int tid) {
    asm volatile("s_waitcnt vmcnt(0)" ::: "memory");
    __syncthreads();
    if (tid == 0) {
        unsigned* bar = b.bar;
        __builtin_amdgcn_s_waitcnt(0);
        unsigned nloc = b.st[0], nx = b.st[1];
        if (nloc == 0u) { xcd_barrier_complete(bar, b.x, nloc, nx); b.st[0] = nloc; b.st[1] = nx; }
        const unsigned old = xb_add(&bar[XB_XSUB(b.x)], 1u);
        const unsigned gen = old / nloc;
        if (old + 1u == (gen + 1u) * nloc) {
            __builtin_amdgcn_fence(__ATOMIC_RELEASE, "agent");
            asm volatile("s_waitcnt vmcnt(0)" ::: "memory");
            const unsigned og = xb_add(&bar[XB_TOP], 1u);
            const unsigned tg = og / nx;
            if (og + 1u == (tg + 1u) * nx) xb_add(&bar[XB_TOPGEN], 1u);
            else XB_SPIN(xb_ld(&bar[XB_TOPGEN]) == tg, bar);
            __builtin_amdgcn_fence(__ATOMIC_ACQUIRE, "agent");
            xb_add(&bar[XB_XGEN(b.x)], 1u);
            asm volatile("s_waitcnt vmcnt(0)" ::: "memory");
        } else {
            XB_SPIN(xb_ld(&bar[XB_XGEN(b.x)]) == gen, bar);
            __builtin_amdgcn_fence(__ATOMIC_ACQUIRE, "agent");
            asm volatile("s_waitcnt vmcnt(0)" ::: "memory");
        }
    }
    __syncthreads();
}

struct Args { const float* in[32]; float* out; unsigned char* ws; int ph_lo, ph_hi; };

struct Frame {
    LAS unsigned char* lds;
    float* out; unsigned char* ws;
    int tid, lane, wave, G, bid;
    __device__ __forceinline__ const float* in(int k) const {
        const __attribute__((address_space(4))) char* ka = (const __attribute__((address_space(4))) char*)__builtin_amdgcn_kernarg_segment_ptr();
        int z = 0; asm volatile("" : "+v"(z)); z = __builtin_amdgcn_readfirstlane(z);
        return *(const float* const __attribute__((address_space(4)))*)(ka + k * 8 + z);
    }
};
__device__ __forceinline__ float* xs_row(const Frame& F, int r) { return r < TL ? F.out + (size_t)r * DM : (float*)(F.ws + WS_XC) + (size_t)(r - TL) * DM; }
__device__ __forceinline__ const float* xin_row(const Frame& F, int l, int r) {
    if (l == 0) return r < TL ? F.in(0) + (size_t)r * DM : F.in(2) + (size_t)(r - TL) * DM;
    return xs_row(F, r);
}
__device__ __forceinline__ const float* mod_vec(const Frame& F, int l, int r, int which) {
    const int s = r < TL ? (r / SEQ) : 2;
    return (const float*)(F.ws + WS_MOD) + (size_t)(l * 3 + s) * 6 * DM + which * DM;
}

__device__ __forceinline__ void launder(Frame& F) {
    asm volatile("" : "+s"(F.wave), "+s"(F.bid), "+s"(F.G));
    int z = 0; asm volatile("" : "+v"(z));
    F.lane = (int)__builtin_amdgcn_mbcnt_hi(~0u, __builtin_amdgcn_mbcnt_lo(~0u, (unsigned)z)); F.tid = F.wave * 64 + F.lane;
}

__device__ __forceinline__ void ph_mod(Frame& F) {
    LAS float* sv = (LAS float*)F.lds;
    LAS float* red = sv + 3 * DM;
    for (int i = F.tid; i < 3 * DM; i += NTHREADS) { const int s = i / DM, k = i % DM; const float v = s < 2 ? F.in(1)[s * DM + k] : F.in(3)[k]; sv[i] = siluf_(v); }
    __syncthreads();
    for (int item = F.bid; item < DEPTH * 96; item += F.G) {
        const int l = item / 96, ch = item % 96, col = ch * 128 + F.lane * 2;
        const float* W = F.in(4) + (size_t)l * DM * 6 * DM + col;
        float a[3][2] = {{0.f, 0.f}, {0.f, 0.f}, {0.f, 0.f}};
        const int k0 = F.wave * 256;
#pragma unroll 8
        for (int k = 0; k < 256; ++k) {
            const float2 w = *(const float2*)(W + (size_t)(k0 + k) * 6 * DM);
#pragma unroll
            for (int s = 0; s < 3; ++s) { const float x = sv[s * DM + k0 + k]; a[s][0] += x * w.x; a[s][1] += x * w.y; }
        }
#pragma unroll
        for (int s = 0; s < 3; ++s) { red[(F.wave * 3 + s) * 128 + F.lane * 2] = a[s][0]; red[(F.wave * 3 + s) * 128 + F.lane * 2 + 1] = a[s][1]; }
        __syncthreads();
        if (F.tid < 384) {
            const int s = F.tid / 128, c = F.tid % 128; float t = 0.f;
#pragma unroll
            for (int w = 0; w < 8; ++w) t += red[(w * 3 + s) * 128 + c];
            const int j = ch * 128 + c;
            ((float*)(F.ws + WS_MOD))[(size_t)(l * 3 + s) * 6 * DM + j] = t + F.in(5)[(size_t)l * 6 * DM + j];
        }
        __syncthreads();
    }
}

__device__ __forceinline__ void ph_prep1(Frame& F, int l) {
    const int gw = F.bid * NWAVES + F.wave, NGW = F.G * NWAVES;
    const int nrows = (l == DEPTH) ? TL : TT;
    const bf16_t* Y = (const bf16_t*)(F.ws + WS_PROJ);
    bf16_t* H = (bf16_t*)(F.ws + WS_H);
    const float* gn_mix = F.in(6) + (size_t)(l < DEPTH ? l : 0) * DM;
    for (int r = gw; r < nrows; r += NGW) {
        f32x4 v[8];
        const float* xr = xin_row(F, l == 0 ? 0 : 1, r);
#pragma unroll
        for (int j = 0; j < 8; ++j) v[j] = *(const f32x4*)(xr + j * 256 + F.lane * 4);
        if (l > 0) {
            const bool has_moe = (l == 1) || (r < TL);
            if (has_moe) {
                const float* g2 = mod_vec(F, l - 1, r, 5);
                const bf16_t* y0 = Y + (size_t)r * DM, *y1 = Y + (size_t)TT * DM + (size_t)r * DM;
#pragma unroll
                for (int j = 0; j < 8; ++j) {
                    const int c = j * 256 + F.lane * 4;
                    const u32x2 a = *(const u32x2*)(y0 + c), b = *(const u32x2*)(y1 + c); const f32x4 g = *(const f32x4*)(g2 + c);
                    v[j].x += g.x * (lo16(a.x) + lo16(b.x)); v[j].y += g.y * (hi16(a.x) + hi16(b.x));
                    v[j].z += g.z * (lo16(a.y) + lo16(b.y)); v[j].w += g.w * (hi16(a.y) + hi16(b.y));
                }
                float* xo = xs_row(F, r);
#pragma unroll
                for (int j = 0; j < 8; ++j) *(f32x4*)(xo + j * 256 + F.lane * 4) = v[j];
            }
        }
        if (l == DEPTH) continue;
        float ss = 0.f;
#pragma unroll
        for (int j = 0; j < 8; ++j) ss += v[j].x * v[j].x + v[j].y * v[j].y + v[j].z * v[j].z + v[j].w * v[j].w;
        const float rstd = rsqrtf(wave_sum(ss) * (1.0f / DM) + EPS);
        const float* gn = gn_mix; const float* sh = mod_vec(F, l, r, 0); const float* sc = mod_vec(F, l, r, 1);
#pragma unroll
        for (int j = 0; j < 8; ++j) {
            const int c = j * 256 + F.lane * 4;
            const f32x4 g = *(const f32x4*)(gn + c), s1 = *(const f32x4*)(sc + c), s0 = *(const f32x4*)(sh + c);
            const f32x4 h = (v[j] * rstd * g) * (s1 + 1.0f) + s0;
            if (!(FAST_MASK & 1)) { u32x2 w; w.x = pk2(h.x, h.y); w.y = pk2(h.z, h.w); *(u32x2*)(H + (size_t)r * DM + c) = w; }
            int w8 = 0; w8 = cvt8s(h.x, h.y, w8, false); w8 = cvt8s(h.z, h.w, w8, true);
            *(int*)(F.ws + WS_H8 + (size_t)r * DM + c) = w8;
        }
    }
}

__device__ __forceinline__ void ngemm_tile(float (&acc)[4][4], const bf16_t* A, int lda, const float* B, int ldb, int K, int row0, int col0, LAS float* lds, int tid) {
    LAS float* As = lds;
    LAS float* Bs = lds + 16 * 132;
    const int ty = tid >> 4, tx = tid & 15;
    const int ar = tid >> 2, ak = (tid & 3) * 4;
    const int bk = (tid & 255) >> 4, bc = (tid & 15) * 4;
    for (int k0 = 0; k0 < K; k0 += 16) {
        const u32x2 av = *(const u32x2*)(A + (size_t)(row0 + ar) * lda + k0 + ak);
        f32x4 bv = (f32x4){0.f, 0.f, 0.f, 0.f};
        if (tid < 256) bv = *(const f32x4*)(B + (size_t)(k0 + bk) * ldb + col0 + bc);
        __syncthreads();
        As[(ak + 0) * 132 + ar] = lo16(av.x); As[(ak + 1) * 132 + ar] = hi16(av.x); As[(ak + 2) * 132 + ar] = lo16(av.y); As[(ak + 3) * 132 + ar] = hi16(av.y);
        if (tid < 256) *(LAS f32x4*)(Bs + bk * 64 + bc) = bv;
        __syncthreads();
#pragma unroll
        for (int kk = 0; kk < 16; ++kk) {
            const f32x4 a = *(const LAS f32x4*)(As + kk * 132 + ty * 4);
            const f32x4 b = *(const LAS f32x4*)(Bs + kk * 64 + tx * 4);
#pragma unroll
            for (int i = 0; i < 4; ++i)
#pragma unroll
                for (int j = 0; j < 4; ++j) acc[i][j] += a[i] * b[j];
        }
    }
    __syncthreads();
}
#define ZERO44(a) do { _Pragma("unroll") for (int i_ = 0; i_ < 4; ++i_) _Pragma("unroll") for (int j_ = 0; j_ < 4; ++j_) a[i_][j_] = 0.f; } while (0)

__device__ __forceinline__ void ph_ngemm_bf16(Frame& F, const bf16_t* A, int lda, const float* B, int ldb, int K, int M, int N, bf16_t* C, int ldc) {
    const int nn = N / 64, ntiles = (M / 128) * nn;
    const int ty = F.tid >> 4, tx = F.tid & 15;
    for (int t = F.bid; t < ntiles; t += F.G) {
        const int row0 = (t / nn) * 128, col0 = (t % nn) * 64;
        float acc[4][4]; ZERO44(acc);
        ngemm_tile(acc, A, lda, B, ldb, K, row0, col0, (LAS float*)F.lds, F.tid);
#pragma unroll
        for (int i = 0; i < 4; ++i) { u32x2 w; w.x = pk2(acc[i][0], acc[i][1]); w.y = pk2(acc[i][2], acc[i][3]);
            *(u32x2*)(C + (size_t)(row0 + ty * 4 + i) * ldc + col0 + tx * 4) = w; }
    }
}

__device__ __forceinline__ float rope_freq(int i, int n) { return exp2f(-(float)i * (13.287712379549449f / (float)n)); }
__device__ __forceinline__ void head128(bf16_t* p, const float* g, bool rope, int prow, int pcol, int lane) {
    float e0 = bf2f(p[lane]), e1 = bf2f(p[lane + 64]);
    const float rstd = rsqrtf(wave_sum(e0 * e0 + e1 * e1) * (1.0f / 128.0f) + EPS);
    e0 = e0 * rstd * g[lane]; e1 = e1 * rstd * g[lane + 64];
    if (rope) {
        const float fr = rope_freq(lane & 31, 32);
        float s0, c0, s1, c1; sincosf((float)prow * fr, &s0, &c0); sincosf((float)pcol * fr, &s1, &c1);
        const float p0 = __shfl_xor(e0, 32), p1 = __shfl_xor(e1, 32);
        if (lane < 32) { e0 = e0 * c0 - p0 * s0; e1 = e1 * c1 - p1 * s1; }
        else { e0 = p0 * s0 + e0 * c0; e1 = p1 * s1 + e1 * c1; }
    }
    p[lane] = (bf16_t)f2bf(e0); p[lane + 64] = (bf16_t)f2bf(e1);
}
__device__ __forceinline__ void ph_prep2(Frame& F, int l) {
    const int gw = F.bid * NWAVES + F.wave, NGW = F.G * NWAVES, lane = F.lane;
    bf16_t* PROJ = (bf16_t*)(F.ws + WS_PROJ);
    for (int r = gw; r < TT; r += NGW) {
        bf16_t* p = PROJ + (size_t)r * PP;
        const bool lat = r < TL; const int t = r % SEQ, prow = t / 64, pcol = t % 64;
        for (int h = 0; h < 4; ++h) head128(p + C_AQ + h * 128, F.in(13) + l * 128, lat, prow, pcol, lane);
        for (int h = 0; h < 2; ++h) head128(p + C_AK + h * 128, F.in(14) + l * 128, lat, prow, pcol, lane);
        for (int h = 0; h < 4; ++h) head128(p + C_WQ + h * 128, F.in(17) + l * 128, lat, prow, pcol, lane);
        for (int h = 0; h < 2; ++h) head128(p + C_WK + h * 128, F.in(18) + l * 128, lat, prow, pcol, lane);
        for (int h = 0; h < 4; ++h) head128(p + C_NQ + h * 128, F.in(19) + l * 128, false, 0, 0, lane);
        for (int h = 0; h < 4; ++h) head128(p + C_NK + h * 128, F.in(20) + l * 128, false, 0, 0, lane);
        {
            float e[6]; float ss = 0.f;
#pragma unroll
            for (int j = 0; j < 6; ++j) { e[j] = bf2f(p[C_MCQ + j * 64 + lane]); ss += e[j] * e[j]; }
            const float rstd = rsqrtf(wave_sum(ss) * (1.0f / 384.0f) + EPS);
#pragma unroll
            for (int j = 0; j < 6; ++j) p[C_MCQ + j * 64 + lane] = (bf16_t)f2bf(e[j] * rstd * F.in(9)[l * 384 + j * 64 + lane]);
        }
        {
            float e[4]; float ss = 0.f;
#pragma unroll
            for (int j = 0; j < 4; ++j) { e[j] = bf2f(p[C_MCKV + j * 64 + lane]); ss += e[j] * e[j]; }
            const float rstd = rsqrtf(wave_sum(ss) * (1.0f / 256.0f) + EPS);
#pragma unroll
            for (int j = 0; j < 4; ++j) p[C_MCKV + j * 64 + lane] = (bf16_t)f2bf(e[j] * rstd * F.in(11)[l * 256 + j * 64 + lane]);
        }
    }
}

__device__ __forceinline__ void mla_head(float e0, float e1, float e2, const float* g, bool rope, int prow, int pcol, int lane, bf16_t* dst) {
    const float rstd = rsqrtf(wave_sum(e0 * e0 + e1 * e1 + e2 * e2) * (1.0f / 192.0f) + EPS);
    e0 = e0 * rstd * g[lane]; e1 = e1 * rstd * g[64 + lane]; e2 = e2 * rstd * g[128 + lane];
    if (rope) {
        const float fr = rope_freq(lane & 15, 16); const int pos = (lane < 32) ? prow : pcol;
        float s, c; sincosf((float)pos * fr, &s, &c);
        const float pr = __shfl_xor(e2, 16);
        e2 = ((lane & 31) < 16) ? (e2 * c - pr * s) : (pr * s + e2 * c);
    }
    dst[lane] = (bf16_t)f2bf(e0); dst[64 + lane] = (bf16_t)f2bf(e1); dst[128 + lane] = (bf16_t)f2bf(e2);
}
__device__ __forceinline__ void ph_prep3(Frame& F, int l) {
    const int gw = F.bid * NWAVES + F.wave, NGW = F.G * NWAVES, lane = F.lane;
    const bf16_t* PROJ = (const bf16_t*)(F.ws + WS_PROJ); bf16_t* MQ = (bf16_t*)(F.ws + WS_MQ); const bf16_t* MKV = (const bf16_t*)(F.ws + WS_MKV); bf16_t* MK = (bf16_t*)(F.ws + WS_MK);
    for (int r = gw; r < TT; r += NGW) {
        const bool lat = r < TL; const int t = r % SEQ, prow = t / 64, pcol = t % 64;
        const float kr = bf2f(PROJ[(size_t)r * PP + C_MKR + lane]);
        for (int h = 0; h < 4; ++h) {
            bf16_t* q = MQ + (size_t)r * 768 + h * 192;
            mla_head(bf2f(q[lane]), bf2f(q[64 + lane]), bf2f(q[128 + lane]), F.in(15) + l * 192, lat, prow, pcol, lane, q);
            const bf16_t* kv = MKV + (size_t)r * 1024 + h * 256;
            mla_head(bf2f(kv[lane]), bf2f(kv[64 + lane]), kr, F.in(16) + l * 192, lat, prow, pcol, lane, MK + (size_t)r * 768 + h * 192);
        }
    }
}

constexpr int RT_ROW128 = 0, RT_COL128 = 128 * 32, RT_ROW64 = RT_COL128 + 64 * 32, RT_COL64 = RT_ROW64 + 128 * 16, RT_N = RT_COL64 + 64 * 16;
__device__ __forceinline__ void rope_tables_build(Frame& F) {
    f32x2v* tab = (f32x2v*)(F.ws + WS_ROPE);
    for (int i = F.bid * NTHREADS + F.tid; i < RT_N; i += F.G * NTHREADS) {
        int pos, fi, n;
        if (i < RT_COL128) { pos = i >> 5; fi = i & 31; n = 32; } else if (i < RT_ROW64) { pos = (i - RT_COL128) >> 5; fi = i & 31; n = 32; }
        else if (i < RT_COL64) { pos = (i - RT_ROW64) >> 4; fi = i & 15; n = 16; } else { pos = (i - RT_COL64) >> 4; fi = i & 15; n = 16; }
        float sn, cs; sincosf((float)pos * rope_freq(fi, n), &sn, &cs); tab[i] = (f32x2v){cs, sn};
    }
}
__device__ __forceinline__ void rope_tables(Frame& F, LAS f32x2v* tab) {
    const u32x4* src = (const u32x4*)(F.ws + WS_ROPE);
    for (int i = F.tid; i < RT_N / 2; i += NTHREADS) ((LAS u32x4*)tab)[i] = src[i];
    __syncthreads();
}
__device__ __forceinline__ void unpack8(const u32x4 w, float (&e)[8]) { e[0] = lo16(w.x); e[1] = hi16(w.x); e[2] = lo16(w.y); e[3] = hi16(w.y); e[4] = lo16(w.z); e[5] = hi16(w.z); e[6] = lo16(w.w); e[7] = hi16(w.w); }
__device__ __forceinline__ u32x4 pack8(const float (&e)[8]) { u32x4 w; w.x = pk2(e[0], e[1]); w.y = pk2(e[2], e[3]); w.z = pk2(e[4], e[5]); w.w = pk2(e[6], e[7]); return w; }
__device__ __forceinline__ u32x2 pack8_fp8(const float (&e)[8]) { int a = 0, b = 0;
    a = cvt8s(e[0], e[1], a, false); a = cvt8s(e[2], e[3], a, true);
    b = cvt8s(e[4], e[5], b, false); b = cvt8s(e[6], e[7], b, true);
    u32x2 o; o.x = (unsigned)a; o.y = (unsigned)b; return o; }
__device__ __forceinline__ void vtrans_item(const bf16_t* src, int pitch, int b, int tb, unsigned char* dst  , LAS unsigned char* scr, int lane) {
    const int krow = tb < 4 ? TL + b * NCTX + tb * 64 + lane : b * SEQ + (tb - 4) * 64 + lane;
    const bf16_t* p = src + (size_t)krow * pitch;
    u32x4 w[8];
#pragma unroll
    for (int i = 0; i < 8; ++i) w[i] = *(const u32x4*)(p + i * 8);
    const int pos = 32 * ((lane >> 2) & 1) + (lane & 3) + 4 * ((lane >> 3) & 3) + 16 * (lane >> 5);
#pragma unroll
    for (int i = 0; i < 8; ++i) { float e[8]; unpack8(w[i], e); const u32x2 q = pack8_fp8(e);
#pragma unroll
        for (int j = 0; j < 4; ++j) { scr[(i * 8 + j) * 80 + pos] = (unsigned char)(q.x >> (8 * j)); scr[(i * 8 + 4 + j) * 80 + pos] = (unsigned char)(q.y >> (8 * j)); } }
    asm volatile("s_waitcnt lgkmcnt(0)" ::: "memory");
    unsigned char* o = dst + (size_t)lane * VTP + tb * 64;
#pragma unroll
    for (int c = 0; c < 4; ++c) *(u32x4*)(o + c * 16) = *(const LAS u32x4*)(scr + lane * 80 + c * 16);
    asm volatile("s_waitcnt lgkmcnt(0)" ::: "memory");
}
__device__ __forceinline__ float ssq8(const float (&e)[8]) { float s = 0.f;
#pragma unroll
    for (int i = 0; i < 8; ++i) s += e[i] * e[i]; return s; }
__device__ __forceinline__ float group16_sum(float v) { v += __shfl_xor(v, 1); v += __shfl_xor(v, 2); v += __shfl_xor(v, 4); v += __shfl_xor(v, 8); return v; }
constexpr float QS128 = 0.12751743082459871f, QS192 = 0.10411832783838018f;
__device__ __forceinline__ u32x2 head128_w(const u32x4 w, const float* g, bool rope, int prow, int pcol, int j, const LAS f32x2v* tab, const float osc = 1.0f) {
    float e[8]; unpack8(w, e);
    const float rstd = rsqrtf(group16_sum(ssq8(e)) * (1.0f / 128.0f) + EPS) * osc;
    const f32x4 g0 = *(const f32x4*)(g + 8 * j), g1 = *(const f32x4*)(g + 8 * j + 4);
    e[0] *= rstd * g0.x; e[1] *= rstd * g0.y; e[2] *= rstd * g0.z; e[3] *= rstd * g0.w; e[4] *= rstd * g1.x; e[5] *= rstd * g1.y; e[6] *= rstd * g1.z; e[7] *= rstd * g1.w;
    if (rope) {
        const int d = 8 * j, fi = d & 31; const bool first = (d & 32) == 0;
        const LAS f32x2v* t = tab + ((d < 64) ? RT_ROW128 + prow * 32 : RT_COL128 + pcol * 32) + fi;
#pragma unroll
        for (int i = 0; i < 8; ++i) { const float p = __shfl_xor(e[i], 4); const f32x2v cs = t[i]; e[i] = first ? e[i] * cs.x - p * cs.y : p * cs.y + e[i] * cs.x; }
    }
    return pack8_fp8(e);
}
__device__ __forceinline__ void ph_prep2_fast(Frame& F, int l) {
    LAS f32x2v* tab = (LAS f32x2v*)F.lds;
    rope_tables(F, tab);
    const int gw = F.bid * NWAVES + F.wave, NGW = F.G * NWAVES, lane = F.lane, j = lane & 15, hd = lane >> 4;
    bf16_t* PROJ = (bf16_t*)(F.ws + WS_PROJ);
    const float* qn_att = F.in(13) + l * 128; const float* kn_att = F.in(14) + l * 128; const float* qn_win = F.in(17) + l * 128; const float* kn_win = F.in(18) + l * 128;
    const float* qn_na = F.in(19) + l * 128; const float* kn_na = F.in(20) + l * 128; const float* qa_n = F.in(9) + l * 384; const float* kva_n = F.in(11) + l * 256;
    for (int r = gw; r < TT; r += NGW) {
        bf16_t* p = PROJ + (size_t)r * PP;
        const bool lat = r < TL; const int t = r % SEQ, prow = t / 64, pcol = t % 64;
        bf16_t* a0 = p + C_AQ + lane * 8;
        bf16_t* a1 = p + (hd < 2 ? C_AK : C_WK - 256) + lane * 8;
        bf16_t* a2 = p + C_WQ + lane * 8;
        bf16_t* a3 = p + C_NQ + lane * 8;
        bf16_t* a4 = p + C_NK + lane * 8;
        bf16_t* a5 = p + C_MCQ + (lane < 48 ? lane : 0) * 8;
        bf16_t* a6 = p + C_MCKV + (lane & 31) * 8;
        const u32x4 w0 = *(const u32x4*)a0, w1 = *(const u32x4*)a1, w2 = *(const u32x4*)a2, w3 = *(const u32x4*)a3, w4 = *(const u32x4*)a4, w5 = *(const u32x4*)a5, w6 = *(const u32x4*)a6;
        unsigned char* q8 = F.ws + WS_Q8 + (size_t)r * Q8P; unsigned char* k8 = F.ws + WS_K8 + (size_t)r * K8P;
        *(u32x2*)(q8 + Q8_A + lane * 8) = head128_w(w0, qn_att, lat, prow, pcol, j, tab, QS128);
        *(u32x2*)(k8 + (hd < 2 ? K8_A : K8_W - 256) + lane * 8) = head128_w(w1, hd < 2 ? kn_att : kn_win, lat, prow, pcol, j, tab);
        *(u32x2*)(q8 + Q8_W + lane * 8) = head128_w(w2, qn_win, lat, prow, pcol, j, tab, QS128);
        *(u32x2*)(q8 + Q8_N + lane * 8) = head128_w(w3, qn_na, false, 0, 0, j, tab, QS128);
        *(u32x2*)(k8 + K8_N + lane * 8) = head128_w(w4, kn_na, false, 0, 0, j, tab);
        float e5[8], e6[8]; unpack8(w5, e5); unpack8(w6, e6);
        const float r5 = rsqrtf(wave_sum(lane < 48 ? ssq8(e5) : 0.f) * (1.0f / 384.0f) + EPS);
        const float r6 = rsqrtf(wave_sum(lane < 32 ? ssq8(e6) : 0.f) * (1.0f / 256.0f) + EPS);
        {
            const float* g5 = qa_n + (lane < 48 ? lane : 0) * 8; const float* g6 = kva_n + (lane & 31) * 8;
            const f32x4 ga = *(const f32x4*)g5, gb = *(const f32x4*)(g5 + 4), gc = *(const f32x4*)g6, gd = *(const f32x4*)(g6 + 4);
            e5[0] *= r5 * ga.x; e5[1] *= r5 * ga.y; e5[2] *= r5 * ga.z; e5[3] *= r5 * ga.w; e5[4] *= r5 * gb.x; e5[5] *= r5 * gb.y; e5[6] *= r5 * gb.z; e5[7] *= r5 * gb.w;
            e6[0] *= r6 * gc.x; e6[1] *= r6 * gc.y; e6[2] *= r6 * gc.z; e6[3] *= r6 * gc.w; e6[4] *= r6 * gd.x; e6[5] *= r6 * gd.y; e6[6] *= r6 * gd.z; e6[7] *= r6 * gd.w;
        }
        unsigned char* mc8 = F.ws + WS_MK + (size_t)r * MCP;
        if (lane < 48) *(u32x2*)(mc8 + 256 + lane * 8) = pack8_fp8(e5);
        if (lane < 32) *(u32x2*)(mc8 + lane * 8) = pack8_fp8(e6);
    }
    __syncthreads();
    {
        LAS unsigned char* scr = F.lds + F.wave * 5120;
        for (int it = gw; it < 2 * 132 * 16; it += NGW) {
            const int g = it & 15, tb = (it >> 4) % 132, b = (it >> 4) / 132;
            const int hidx = g >> 1, half = g & 1;
            const int col = (hidx < 2 ? C_AV + hidx * 128 : (hidx < 4 ? C_WV + (hidx - 2) * 128 : C_NV + (hidx - 4) * 128)) + half * 64;
            vtrans_item(PROJ + col, PP, b, tb, F.ws + WS_V8T + ((size_t)(hidx * 2 + b) * 128 + half * 64) * VTP, scr, lane);
        }
        __syncthreads();
    }
}
__device__ __forceinline__ void mla_rope8(float (&e)[8], int rp  , int prow, int pcol, const LAS f32x2v* tab, int delta_lane) {
    const int blk = rp >> 2, pp = rp & 3; const bool first = pp < 2;
    const LAS f32x2v* t = tab + (blk == 0 ? RT_ROW64 + prow * 16 : RT_COL64 + pcol * 16) + 8 * (pp & 1);
#pragma unroll
    for (int i = 0; i < 8; ++i) { const float p = __shfl_xor(e[i], delta_lane); const f32x2v cs = t[i]; e[i] = first ? e[i] * cs.x - p * cs.y : p * cs.y + e[i] * cs.x; }
}
__device__ __forceinline__ void scale8(float (&e)[8], float rstd, const float* g) { const f32x4 a = *(const f32x4*)g, b = *(const f32x4*)(g + 4);
    e[0] *= rstd * a.x; e[1] *= rstd * a.y; e[2] *= rstd * a.z; e[3] *= rstd * a.w; e[4] *= rstd * b.x; e[5] *= rstd * b.y; e[6] *= rstd * b.z; e[7] *= rstd * b.w; }
__device__ __forceinline__ void ph_prep3_fast(Frame& F, int l) {
    LAS f32x2v* tab = (LAS f32x2v*)F.lds;
    rope_tables(F, tab);
    const int gw = F.bid * NWAVES + F.wave, NGW = F.G * NWAVES, lane = F.lane;
    const bf16_t* PROJ = (const bf16_t*)(F.ws + WS_PROJ); const bf16_t* MKV = (const bf16_t*)(F.ws + WS_MQ); const bf16_t* MQ = MKV + 1024;
    const float* qn = F.in(15) + l * 192; const float* kn = F.in(16) + l * 192;
    const int hA = lane / 24, wA = lane % 24, cB = 64 + (lane & 31), hB = cB / 24, wB = cB % 24;
    for (int r = gw; r < TT; r += NGW) {
        const bool lat = r < TL; const int t = r % SEQ, prow = t / 64, pcol = t % 64;
        const bf16_t* q = MQ + (size_t)r * MQP;
        const u32x4 qa = *(const u32x4*)(q + lane * 8), qb = *(const u32x4*)(q + cB * 8);
        const u32x4 kw = *(const u32x4*)(MKV + (size_t)r * MQP + (lane >> 4) * 256 + (lane & 15) * 8);
        const u32x4 rw = *(const u32x4*)(PROJ + (size_t)r * PP + C_MKR + (lane & 7) * 8);
        float ea[8], eb[8], ek[8], er[8]; unpack8(qa, ea); unpack8(qb, eb); unpack8(kw, ek); unpack8(rw, er);
        const float sA = ssq8(ea), sB = (lane < 32) ? ssq8(eb) : 0.f;
        float rq[4];
#pragma unroll
        for (int h = 0; h < 4; ++h) rq[h] = rsqrtf(wave_sum((hA == h ? sA : 0.f) + (hB == h ? sB : 0.f)) * (1.0f / 192.0f) + EPS);
        const float rA = hA == 0 ? rq[0] : (hA == 1 ? rq[1] : rq[2]), rB = hB == 2 ? rq[2] : rq[3];
        scale8(ea, rA * QS192, qn + wA * 8); scale8(eb, rB * QS192, qn + wB * 8);
        if (lat) {
            float ta[8], tb[8];
#pragma unroll
            for (int i = 0; i < 8; ++i) { ta[i] = ea[i]; tb[i] = eb[i]; }
            mla_rope8(ta, (wA - 16) & 7, prow, pcol, tab, 2); mla_rope8(tb, (wB - 16) & 7, prow, pcol, tab, 2);
#pragma unroll
            for (int i = 0; i < 8; ++i) { if (wA >= 16) ea[i] = ta[i]; if (wB >= 16) eb[i] = tb[i]; }
        }
        unsigned char* q8 = F.ws + WS_Q8 + (size_t)r * Q8P + Q8_M; unsigned char* k8 = F.ws + WS_K8 + (size_t)r * K8P + K8_M;
        *(u32x2*)(q8 + lane * 8) = pack8_fp8(ea);
        if (lane < 32) *(u32x2*)(q8 + cB * 8) = pack8_fp8(eb);
        const float srope = wave_sum(lane < 8 ? ssq8(er) : 0.f);
        const float rk = rsqrtf((group16_sum(ssq8(ek)) + srope) * (1.0f / 192.0f) + EPS);
        scale8(ek, rk, kn + (lane & 15) * 8);
        *(u32x2*)(k8 + (lane >> 4) * 192 + (lane & 15) * 8) = pack8_fp8(ek);
        const float rkh = __shfl(rk, ((lane >> 3) & 3) * 16);
        scale8(er, rkh, kn + 128 + (lane & 7) * 8);
        if (lat) mla_rope8(er, lane & 7, prow, pcol, tab, 2);
        if (lane < 32) *(u32x2*)(k8 + (lane >> 3) * 192 + 128 + (lane & 7) * 8) = pack8_fp8(er);
    }
    __syncthreads();
    {
        LAS unsigned char* scr = F.lds + F.wave * 5120;
        for (int it = gw; it < 2 * 132 * 8; it += NGW) {
            const int g = it & 7, tb = (it >> 3) % 132, b = (it >> 3) / 132, h = g >> 1, half = g & 1;
            vtrans_item(MKV + h * 256 + 128 + half * 64, MQP, b, tb, F.ws + WS_V8T + ((size_t)((8 + h) * 2 + b) * 128 + half * 64) * VTP, scr, lane);
        }
        __syncthreads();
    }
}

#define QSTR 97
template <int DQK> __device__ __forceinline__ float qk_dot(const LAS unsigned* q, const bf16_t* k) {
    float s = 0.f;
#pragma unroll 4
    for (int c = 0; c < DQK / 8; ++c) {
        const u32x4 kv = *(const u32x4*)(k + c * 8);
#pragma unroll
        for (int j = 0; j < 4; ++j) { const unsigned qw = q[c * 4 + j]; s += lo16(qw) * lo16(kv[j]); s += hi16(qw) * hi16(kv[j]); }
    }
    return s;
}
__device__ __forceinline__ void attn_key(float s, const bf16_t* v, float& m, float& l, float (&o)[64]) {
    if (s > m) { const float al = __expf(m - s); l *= al;
#pragma unroll
        for (int d = 0; d < 64; ++d) o[d] *= al;
        m = s; }
    const float p = __expf(s - m); l += p;
    if (v) {
#pragma unroll
        for (int c = 0; c < 8; ++c) { const u32x4 vv = *(const u32x4*)(v + c * 8);
#pragma unroll
            for (int j = 0; j < 4; ++j) { o[c * 8 + 2 * j] += p * lo16(vv[j]); o[c * 8 + 2 * j + 1] += p * hi16(vv[j]); } }
    }
}
template <int DQK> __device__ __forceinline__ void nattn_item(Frame& F, int l, int mx, int h, int r0, bool is_ctx) {
    const int lane = F.lane;
    const bf16_t* PROJ = (const bf16_t*)(F.ws + WS_PROJ);
    const bf16_t *Q, *Kb, *Vb; int ldq, ldk, ldv;
    if (mx == 0) { Q = PROJ + C_AQ + h * 128; Kb = PROJ + C_AK + (h >> 1) * 128; Vb = PROJ + C_AV + (h >> 1) * 128; ldq = ldk = ldv = PP; }
    else if (mx == 1) { Q = (const bf16_t*)(F.ws + WS_MQ) + h * 192; Kb = (const bf16_t*)(F.ws + WS_MK) + h * 192; Vb = (const bf16_t*)(F.ws + WS_MKV) + h * 256 + 128; ldq = 768; ldk = 768; ldv = 1024; }
    else if (mx == 2) { Q = PROJ + C_WQ + h * 128; Kb = PROJ + C_WK + (h >> 1) * 128; Vb = PROJ + C_WV + (h >> 1) * 128; ldq = ldk = ldv = PP; }
    else { Q = PROJ + C_NQ + h * 128; Kb = PROJ + C_NK + h * 128; Vb = PROJ + C_NV + h * 128; ldq = ldk = ldv = PP; }
    const float scale = (DQK == 128) ? 0.08838834764831845f : 0.07216878364870323f;
    const int r = r0 + (lane & 31), half = lane >> 5;
    Vb += half * 64;
    LAS unsigned* qs = (LAS unsigned*)F.lds + (F.wave * 64 + lane) * QSTR;
    {
        const bf16_t* qp = Q + (size_t)r * ldq;
#pragma unroll
        for (int c = 0; c < DQK / 8; ++c) { const u32x4 v = *(const u32x4*)(qp + c * 8); qs[c * 4 + 0] = v.x; qs[c * 4 + 1] = v.y; qs[c * 4 + 2] = v.z; qs[c * 4 + 3] = v.w; }
    }
    float m = -1e30f, lsum = 0.f; float o[64];
#pragma unroll
    for (int d = 0; d < 64; ++d) o[d] = 0.f;
    const int b = is_ctx ? (r0 - TL) / NCTX : r0 / SEQ;
    for (int j = 0; j < NCTX; ++j) { const size_t kr = (size_t)(TL + b * NCTX + j);
        const float s = qk_dot<DQK>(qs, Kb + kr * ldk) * scale; attn_key(s, Vb + kr * ldv, m, lsum, o); }
    if (!is_ctx) {
        const int t = r - b * SEQ;
        if (mx <= 1) {
            for (int j = 0; j < SEQ; ++j) { const size_t kr = (size_t)(b * SEQ + j);
                const float s = qk_dot<DQK>(qs, Kb + kr * ldk) * scale; attn_key(s, Vb + kr * ldv, m, lsum, o); }
        } else if (mx == 2) {
            const int t0 = r0 - b * SEQ;
            for (int j = t0 - 128; j <= t0 + 31 + 128; ++j) {
                const int d = t - j;
                if (j >= 0 && j < SEQ && d <= 128 && d >= -128) { const size_t kr = (size_t)(b * SEQ + j);
                    const float s = qk_dot<DQK>(qs, Kb + kr * ldk) * scale; attn_key(s, Vb + kr * ldv, m, lsum, o); }
            }
        } else {
            const int rr = t / 64, cc = t % 64;
            const int rs = min(max(rr - 4, 0), 128 - 8), cs = min(max(cc - 8, 0), 64 - 16);
            const float* rpb = F.in(22) + (size_t)(l * 4 + h) * 15 * 31;
            for (int y = 0; y < 8; ++y)
                for (int kx = 0; kx < 16; ++kx) {
                    const size_t kr = (size_t)(b * SEQ + (rs + y) * 64 + cs + kx);
                    const int dy = rs + y - rr + 7, dx = cs + kx - cc + 15;
                    const float s = qk_dot<DQK>(qs, Kb + kr * ldk) * scale + rpb[dy * 31 + dx]; attn_key(s, Vb + kr * ldv, m, lsum, o); }
        }
    }
    if (mx == 2) attn_key(F.in(21)[l * 4 + h], nullptr, m, lsum, o);
    const float inv = 1.0f / lsum;
    bf16_t* op = (bf16_t*)(F.ws + WS_OUTS) + (size_t)r * DM + mx * 512 + h * 128 + half * 64;
#pragma unroll
    for (int c = 0; c < 8; ++c) { u32x4 w;
#pragma unroll
        for (int j = 0; j < 4; ++j) w[j] = pk2(o[c * 8 + 2 * j] * inv, o[c * 8 + 2 * j + 1] * inv);
        *(u32x4*)(op + c * 8) = w; }
}
__device__ __forceinline__ void ph_nattn(Frame& F, int l) {
    if (F.wave >= 4) return;
    const int slot = F.bid * 4 + F.wave, nslots = F.G * 4;
    const int total = 8192 + (l == 0 ? 256 : 0);
    for (int it = slot; it < total; it += nslots) {
        if (it < 8192) {
            const int grp = it >> 11, rem = it & 2047, h = rem >> 9, qi = rem & 511;
            const int mx = grp == 0 ? 1 : (grp == 1 ? 0 : grp);
            if (mx == 1) nattn_item<192>(F, l, 1, h, qi * 32, false); else nattn_item<128>(F, l, mx, h, qi * 32, false);
        } else {
            const int i2 = it - 8192, mx = i2 >> 6, h = (i2 >> 4) & 3, qi = i2 & 15;
            if (mx == 1) nattn_item<192>(F, l, 1, h, TL + qi * 32, true); else nattn_item<128>(F, l, mx, h, TL + qi * 32, true);
        }
    }
}

__device__ __forceinline__ void ph_nmerge(Frame& F, int l) {
    const int M = (l == 0) ? TT : TL, nn = DM / 64, ntiles = (M / 128) * nn;
    const int ty = F.tid >> 4, tx = F.tid & 15;
    const bf16_t* H = (const bf16_t*)(F.ws + WS_H); const bf16_t* OUTS = (const bf16_t*)(F.ws + WS_OUTS); bf16_t* ACC = (bf16_t*)(F.ws + WS_ACC);
    for (int t = F.bid; t < ntiles; t += F.G) {
        const int row0 = (t / nn) * 128, col0 = (t % nn) * 64;
        float tot[4][4]; ZERO44(tot);
        for (int i = 0; i < 4; ++i) {
            float ag[4][4], ab[4][4]; ZERO44(ag); ZERO44(ab);
            ngemm_tile(ag, H, DM, F.in(24) + (size_t)(l * 4 + i) * DM * DM, DM, DM, row0, col0, (LAS float*)F.lds, F.tid);
            ngemm_tile(ab, OUTS + i * 512, DM, F.in(23) + (size_t)(l * 4 + i) * 512 * DM, DM, 512, row0, col0, (LAS float*)F.lds, F.tid);
            const f32x4 bg = *(const f32x4*)(F.in(25) + (size_t)(l * 4 + i) * DM + col0 + tx * 4);
#pragma unroll
            for (int a = 0; a < 4; ++a)
#pragma unroll
                for (int b = 0; b < 4; ++b) tot[a][b] += sigmoidf_(ag[a][b] + bg[b]) * ab[a][b];
        }
#pragma unroll
        for (int a = 0; a < 4; ++a) { u32x2 w; w.x = pk2(tot[a][0], tot[a][1]); w.y = pk2(tot[a][2], tot[a][3]);
            *(u32x2*)(ACC + (size_t)(row0 + ty * 4 + a) * DM + col0 + tx * 4) = w; }
    }
}
__device__ __forceinline__ void ph_nout(Frame& F, int l) {
    const int M = (l == 0) ? TT : TL, nn = DM / 64, ntiles = (M / 128) * nn;
    const int ty = F.tid >> 4, tx = F.tid & 15;
    const bf16_t* ACC = (const bf16_t*)(F.ws + WS_ACC);
    for (int t = F.bid; t < ntiles; t += F.G) {
        const int row0 = (t / nn) * 128, col0 = (t % nn) * 64;
        float acc[4][4]; ZERO44(acc);
        ngemm_tile(acc, ACC, DM, F.in(26) + (size_t)l * DM * DM, DM, DM, row0, col0, (LAS float*)F.lds, F.tid);
#pragma unroll
        for (int a = 0; a < 4; ++a) { const int r = row0 + ty * 4 + a, c = col0 + tx * 4;
            const f32x4 xi = *(const f32x4*)(xin_row(F, l, r) + c), g1 = *(const f32x4*)(mod_vec(F, l, r, 2) + c);
            f32x4 o; o.x = xi.x + g1.x * acc[a][0]; o.y = xi.y + g1.y * acc[a][1]; o.z = xi.z + g1.z * acc[a][2]; o.w = xi.w + g1.w * acc[a][3];
            *(f32x4*)(xs_row(F, r) + c) = o; }
    }
}

__device__ __forceinline__ void ph_prep4(Frame& F, int l) {
    const int gw = F.bid * NWAVES + F.wave, NGW = F.G * NWAVES, lane = F.lane;
    const int nrows = (l == 0) ? TT : TL;
    bf16_t* H = (bf16_t*)(F.ws + WS_H);
    unsigned* ecnt = (unsigned*)(F.ws + WS_CTL) + CW_ECNT + l * 16;
    int* elist = (int*)(F.ws + WS_ELIST); float* elw = (float*)(F.ws + WS_ELW);
    LAS float* wrT = (LAS float*)F.lds;
    { const float* wr = F.in(27);
      for (int i = F.tid; i < DM * 4; i += NTHREADS) { const int k = i >> 2, e4 = i & 3; const f32x4 v = *(const f32x4*)(wr + (size_t)k * 16 + e4 * 4);
          wrT[(e4 * 4 + 0) * DM + k] = v.x; wrT[(e4 * 4 + 1) * DM + k] = v.y; wrT[(e4 * 4 + 2) * DM + k] = v.z; wrT[(e4 * 4 + 3) * DM + k] = v.w; }
      __syncthreads(); }
    const float* gn_ffn = F.in(7) + (size_t)l * DM; const float* rbias = F.in(28);
    constexpr int RPW = 12;
    LAS unsigned* lcnt = (LAS unsigned*)(F.lds + 131072 + 1024); LAS unsigned* lbase = lcnt + 16;
    LAS int* rt_e = (LAS int*)(lbase + 16); LAS int* rt_r = rt_e + NWAVES * RPW; LAS float* rt_w1 = (LAS float*)(rt_r + NWAVES * RPW); LAS float* rt_w2 = rt_w1 + NWAVES * RPW;
    if (F.tid < 16) lcnt[F.tid] = 0u;
    __syncthreads();
    int nloc = 0;
    f32x4 vn[8];
    if (gw < nrows) { const float* xr0 = xs_row(F, gw);
#pragma unroll
        for (int j = 0; j < 8; ++j) vn[j] = *(const f32x4*)(xr0 + j * 256 + lane * 4); }
    for (int r = gw; r < nrows; r += NGW) {
        f32x4 v[8];
        float ss = 0.f;
#pragma unroll
        for (int j = 0; j < 8; ++j) { v[j] = vn[j]; ss += v[j].x * v[j].x + v[j].y * v[j].y + v[j].z * v[j].z + v[j].w * v[j].w; }
        if (r + NGW < nrows) { const float* xr1 = xs_row(F, r + NGW);
#pragma unroll
            for (int j = 0; j < 8; ++j) vn[j] = *(const f32x4*)(xr1 + j * 256 + lane * 4); }
        const float rstd = rsqrtf(wave_sum(ss) * (1.0f / DM) + EPS);
        const float* gn = gn_ffn; const float* sh = mod_vec(F, l, r, 3); const float* sc = mod_vec(F, l, r, 4);
        float lg[16];
#pragma unroll
        for (int e = 0; e < 16; ++e) lg[e] = 0.f;
#pragma unroll
        for (int j = 0; j < 8; ++j) {
            const int c = j * 256 + lane * 4;
            const f32x4 g = *(const f32x4*)(gn + c), s1 = *(const f32x4*)(sc + c), s0 = *(const f32x4*)(sh + c);
            const f32x4 h = (v[j] * rstd * g) * (s1 + 1.0f) + s0;
            if (FAST_MASK & 16) { int w8 = 0; w8 = cvt8s(h.x, h.y, w8, false); w8 = cvt8s(h.z, h.w, w8, true);
                *(int*)(F.ws + WS_H8 + (size_t)r * DM + c) = w8; }
            else { u32x2 w; w.x = pk2(h.x, h.y); w.y = pk2(h.z, h.w); *(u32x2*)(H + (size_t)r * DM + c) = w; }
#pragma unroll
            for (int e = 0; e < 16; ++e) { const f32x4 wv = *(const LAS f32x4*)(wrT + e * DM + c); lg[e] += (h.x * wv.x + h.y * wv.y) + (h.z * wv.z + h.w * wv.w); }
        }
        float q8[8], q4[4], q2[2], q1;
        { const bool b5 = (lane & 32) != 0;
#pragma unroll
          for (int i = 0; i < 8; ++i) { const float keep = b5 ? lg[8 + i] : lg[i], send = b5 ? lg[i] : lg[8 + i]; q8[i] = keep + __shfl_xor(send, 32); }
          const bool b4 = (lane & 16) != 0;
#pragma unroll
          for (int i = 0; i < 4; ++i) { const float keep = b4 ? q8[4 + i] : q8[i], send = b4 ? q8[i] : q8[4 + i]; q4[i] = keep + __shfl_xor(send, 16); }
          const bool b3 = (lane & 8) != 0;
#pragma unroll
          for (int i = 0; i < 2; ++i) { const float keep = b3 ? q4[2 + i] : q4[i], send = b3 ? q4[i] : q4[2 + i]; q2[i] = keep + __shfl_xor(send, 8); }
          const bool b2 = (lane & 4) != 0;
          { const float keep = b2 ? q2[1] : q2[0], send = b2 ? q2[0] : q2[1]; q1 = keep + __shfl_xor(send, 4); }
          q1 += __shfl_xor(q1, 2); q1 += __shfl_xor(q1, 1); }
        float sc_[16], bs[16];
#pragma unroll
        for (int e = 0; e < 16; ++e) { const float z = __uint_as_float(__builtin_amdgcn_readlane(__float_as_uint(q1), 4 * e));
            sc_[e] = __builtin_amdgcn_rcpf(1.0f + __expf(-z)); bs[e] = sc_[e] + rbias[e]; }
        int bg = 0; float bgs;
#pragma unroll
        for (int g = 0; g < 4; ++g) {
            const float a0 = bs[g * 4], a1 = bs[g * 4 + 1], a2 = bs[g * 4 + 2], a3 = bs[g * 4 + 3];
            const float lo1 = fminf(a0, a1), hi1 = fmaxf(a0, a1), lo2 = fminf(a2, a3), hi2 = fmaxf(a2, a3);
            const float gs = fmaxf(hi1, hi2) + fmaxf(fminf(hi1, hi2), fmaxf(lo1, lo2));
            if (g == 0) bgs = gs; else { const bool t = gs > bgs; bgs = t ? gs : bgs; bg = t ? g : bg; }
        }
        float x[4], su[4];
#pragma unroll
        for (int q = 0; q < 4; ++q) { x[q] = bg == 0 ? bs[q] : (bg == 1 ? bs[4 + q] : (bg == 2 ? bs[8 + q] : bs[12 + q])); su[q] = bg == 0 ? sc_[q] : (bg == 1 ? sc_[4 + q] : (bg == 2 ? sc_[8 + q] : sc_[12 + q])); }
        int i1 = 0; float v1 = x[0], s1 = su[0];
#pragma unroll
        for (int q = 1; q < 4; ++q) { const bool t = x[q] > v1; v1 = t ? x[q] : v1; s1 = t ? su[q] : s1; i1 = t ? q : i1; }
        int i2 = -1; float v2 = -3.0e38f, s2 = 0.f;
#pragma unroll
        for (int q = 0; q < 4; ++q) { const bool t = (q != i1) && (x[q] > v2); v2 = t ? x[q] : v2; s2 = t ? su[q] : s2; i2 = t ? q : i2; }
        const int e1 = bg * 4 + i1, e2 = bg * 4 + i2;
        if (lane == 0) {
            const float inv = 1.0f / (s1 + s2); const int slot = F.wave * RPW + nloc;
            rt_e[slot] = e1 | (e2 << 8); rt_r[slot] = r; rt_w1[slot] = s1 * inv; rt_w2[slot] = s2 * inv;
            (void)__hip_atomic_fetch_add(&lcnt[e1], 1u, __ATOMIC_RELAXED, __HIP_MEMORY_SCOPE_WORKGROUP); (void)__hip_atomic_fetch_add(&lcnt[e2], 1u, __ATOMIC_RELAXED, __HIP_MEMORY_SCOPE_WORKGROUP);
        }
        ++nloc;
    }
    __syncthreads();
    if (F.tid < 16) { const unsigned n = lcnt[F.tid]; lbase[F.tid] = n ? atomicAdd(ecnt + F.tid, n) : 0u; lcnt[F.tid] = 0u; }
    __syncthreads();
    if (lane == 0) for (int i = 0; i < nloc; ++i) {
        const int slot = F.wave * RPW + i; const int e1 = rt_e[slot] & 255, e2 = rt_e[slot] >> 8, r = rt_r[slot];
        const unsigned p1 = lbase[e1] + __hip_atomic_fetch_add(&lcnt[e1], 1u, __ATOMIC_RELAXED, __HIP_MEMORY_SCOPE_WORKGROUP); elist[(size_t)e1 * TT + p1] = r * 2 + 0; elw[(size_t)e1 * TT + p1] = rt_w1[slot];
        const unsigned p2 = lbase[e2] + __hip_atomic_fetch_add(&lcnt[e2], 1u, __ATOMIC_RELAXED, __HIP_MEMORY_SCOPE_WORKGROUP); elist[(size_t)e2 * TT + p2] = r * 2 + 1; elw[(size_t)e2 * TT + p2] = rt_w2[slot];
    }
    __syncthreads();
}

__device__ __forceinline__ void ph_nmoe(Frame& F, int l) {
    const unsigned* ecnt = (const unsigned*)(F.ws + WS_CTL) + CW_ECNT + l * 16;
    const int* elist = (const int*)(F.ws + WS_ELIST); const float* elw = (const float*)(F.ws + WS_ELW);
    const bf16_t* H = (const bf16_t*)(F.ws + WS_H); bf16_t* Y = (bf16_t*)(F.ws + WS_PROJ);
    LAS float* hx = (LAS float*)F.lds;
    LAS float* hid = hx + 8 * DM;
    LAS int* ent = (LAS int*)(hid + 8 * DEXP);
    LAS float* entw = (LAS float*)(ent + 8);
    int total = 0;
    for (int e = 0; e < 16; ++e) total += ((int)ecnt[e] + 7) >> 3;
    const int tid = F.tid;
    for (int item = F.bid; item < total; item += F.G) {
        int e = 0, cbase = 0, acc = 0, cnt = 0;
        for (int i = 0; i < 16; ++i) { const int n = (int)ecnt[i], c = (n + 7) >> 3; if (item >= acc && item < acc + c) { e = i; cbase = acc; cnt = n; } acc += c; }
        const int p0 = (item - cbase) * 8, nv = min(8, cnt - p0);
        __syncthreads();
        if (tid < 8) { ent[tid] = tid < nv ? elist[(size_t)e * TT + p0 + tid] : -1; entw[tid] = tid < nv ? elw[(size_t)e * TT + p0 + tid] : 0.f; }
        __syncthreads();
        for (int i = tid; i < 8 * DM; i += NTHREADS) { const int t = i / DM, k = i % DM; const int en = ent[t]; hx[i] = en >= 0 ? bf2f(H[(size_t)(en >> 1) * DM + k]) : 0.f; }
        __syncthreads();
        {
            const float* w1 = F.in(29) + (size_t)(l * 16 + e) * DM * DEXP + tid; const float* w3 = F.in(30) + (size_t)(l * 16 + e) * DM * DEXP + tid;
            float a1[8], a3[8];
#pragma unroll
            for (int t = 0; t < 8; ++t) { a1[t] = 0.f; a3[t] = 0.f; }
#pragma unroll 4
            for (int d = 0; d < DM; ++d) { const float x1 = w1[(size_t)d * DEXP], x3 = w3[(size_t)d * DEXP];
#pragma unroll
                for (int t = 0; t < 8; ++t) { const float hv = hx[t * DM + d]; a1[t] += hv * x1; a3[t] += hv * x3; } }
#pragma unroll
            for (int t = 0; t < 8; ++t) hid[t * DEXP + tid] = siluf_(a1[t]) * a3[t];
        }
        __syncthreads();
        {
            const float* w2 = F.in(31) + (size_t)(l * 16 + e) * DEXP * DM + tid * 4;
            f32x4 a[8];
#pragma unroll
            for (int t = 0; t < 8; ++t) a[t] = (f32x4){0.f, 0.f, 0.f, 0.f};
#pragma unroll 4
            for (int j = 0; j < DEXP; ++j) { const f32x4 w = *(const f32x4*)(w2 + (size_t)j * DM);
#pragma unroll
                for (int t = 0; t < 8; ++t) a[t] += w * hid[t * DEXP + j]; }
#pragma unroll
            for (int t = 0; t < 8; ++t) { const int en = ent[t]; if (en >= 0) { const float w = entw[t];
                u32x2 o; o.x = pk2(a[t].x * w, a[t].y * w); o.y = pk2(a[t].z * w, a[t].w * w);
                *(u32x2*)(Y + (size_t)(en & 1) * TT * DM + (size_t)(en >> 1) * DM + tid * 4) = o; } }
        }
    }
    __syncthreads();
}


namespace pg8 {
typedef short bf16x8 __attribute__((ext_vector_type(8)));
typedef int v4i_t __attribute__((ext_vector_type(4)));
typedef int v8i_t __attribute__((ext_vector_type(8)));
constexpr int BM = 256, BK = 64, HALF = 128, HTB = HALF * BK * 2, STAGE_BYTES = 8 * HTB, NXCD = 8, WGM = 8;
__host__ __device__ __forceinline__ int lds_byte(int r, int c) { const int st = (r >> 4) * 2 + (c >> 5), rr = r & 15, cc = c & 31, ob = rr * 64 + cc * 2; return st * 1024 + (ob ^ (((ob >> 9) & 1) << 5)); }
__host__ __device__ __forceinline__ void stage_rc(int b, int& R, int& C) { const int st = b / 1024, sb = b % 1024, swz = sb ^ (((sb >> 9) & 1) << 5); R = (st >> 1) * 16 + swz / 64; C = (st & 1) * 32 + (swz % 64) / 2; }
__host__ __device__ __forceinline__ void stage_rc8(int b, int& R, int& C) { const int st = b / 1024, sb = b % 1024, r = sb / 64, j = ((sb % 64) / 16) ^ ((r >> 3) & 1); R = (st >> 1) * 16 + r; C = (st & 1) * 32 + j * 8; }
__host__ __device__ __forceinline__ int lds_byte8(int r, int fq, int half) { const int rr = r & 15; return ((r >> 4) * 2 + (fq >> 1)) * 1024 + rr * 64 + (((2 * (fq & 1) + half) ^ ((rr >> 3) & 1)) * 16); }
__host__ __device__ __forceinline__ int perm32(int rho) { const int n = rho >> 4, i = rho & 15; return 8 * (i >> 2) + 4 * n + (i & 3); }

struct Unit { int pm, pn; const char* A; const char* B; const int* list; int nrows; int aux; };

__device__ __forceinline__ void xcd_decode(int L, int nM, int nN, int& pm, int& pn) {
    const int nwg = nM * nN; int wgid = L;
    { const int q = nwg / NXCD, r = nwg % NXCD, xcd = wgid % NXCD, off = wgid / NXCD; wgid = (xcd < r ? xcd * (q + 1) : r * (q + 1) + (xcd - r) * q) + off; }
    const int nig = WGM * nN, gid = wgid / nig, fm = gid * WGM, gsz = (nM - fm) < WGM ? (nM - fm) : WGM;
    pm = fm + ((wgid % nig) % gsz); pn = (wgid % nig) / gsz;
}
struct SchedPlain {
    const char* A; const char* B; int lda, ldb, nM, nN, G, c, a_div, a_colbytes;
    __device__ __forceinline__ bool next(int i, Unit& u) const {
        const long L = (long)i * G + c; if (L >= (long)nM * nN) return false;
        int pm, pn; xcd_decode((int)L, nM, nN, pm, pn);
        u.pm = pm; u.pn = pn; u.A = A + (size_t)pm * BM * lda * 2 + (size_t)(pn / a_div) * a_colbytes; u.B = B + (size_t)pn * BM * ldb * 2; u.list = nullptr; u.nrows = BM; u.aux = 0; return true;
    }
};

__device__ __forceinline__ unsigned cvt_pk_bf16(float lo, float hi) { unsigned r; asm volatile("v_cvt_pk_bf16_f32 %0, %1, %2" : "=v"(r) : "v"(lo), "v"(hi)); return r; }

struct EpiBf16 {
    static constexpr bool PERM = true;
    bf16_t* O; int ldc; float scale;
    __device__ __forceinline__ void operator()(const f32x4 (&acc)[2][2][4][2], const Unit& u, int wr, int wc, int fr, int fq) const {
        const int row0 = u.pm * BM + wr * 64 + fr, col0 = u.pn * BM + wc * 32 + 8 * fq;
#pragma unroll
        for (int ai = 0; ai < 2; ++ai)
#pragma unroll
            for (int m = 0; m < 4; ++m) { bf16_t* rowp = O + (size_t)(row0 + ai * HALF + m * 16) * ldc + col0;
#pragma unroll
                for (int bj = 0; bj < 2; ++bj) { const f32x4 v0 = acc[ai][bj][m][0] * scale, v1 = acc[ai][bj][m][1] * scale;
                    u32x4 w; w.x = cvt_pk_bf16(v0[0], v0[1]); w.y = cvt_pk_bf16(v0[2], v0[3]); w.z = cvt_pk_bf16(v1[0], v1[1]); w.w = cvt_pk_bf16(v1[2], v1[3]);
                    *(u32x4*)(rowp + bj * HALF) = w; } }
    }
};
struct EpiFp8 {
    static constexpr bool PERM = true;
    unsigned char* O; int ldc; float scale;
    __device__ __forceinline__ void operator()(const f32x4 (&acc)[2][2][4][2], const Unit& u, int wr, int wc, int fr, int fq) const {
        const int row0 = u.pm * BM + wr * 64 + fr, col0 = u.pn * BM + wc * 32 + 8 * fq;
#pragma unroll
        for (int ai = 0; ai < 2; ++ai)
#pragma unroll
            for (int m = 0; m < 4; ++m) { unsigned char* rowp = O + (size_t)(row0 + ai * HALF + m * 16) * ldc + col0;
#pragma unroll
                for (int bj = 0; bj < 2; ++bj) { const f32x4 v0 = acc[ai][bj][m][0] * scale, v1 = acc[ai][bj][m][1] * scale;
                    int a = 0, b = 0; a = cvt8s(v0[0], v0[1], a, false); a = cvt8s(v0[2], v0[3], a, true); b = cvt8s(v1[0], v1[1], b, false); b = cvt8s(v1[2], v1[3], b, true);
                    u32x2 w; w.x = (unsigned)a; w.y = (unsigned)b; *(u32x2*)(rowp + bj * HALF) = w; } }
    }
};
struct EpiResid {
    static constexpr bool PERM = true;
    const float* xin_lat; const float* xin_ctx; float* xs_lat; float* xs_ctx; const float* modbase; int which; float scale;
    __device__ __forceinline__ void operator()(const f32x4 (&acc)[2][2][4][2], const Unit& u, int wr, int wc, int fr, int fq) const {
        const bool lat = u.pm < TL / BM; const int s = lat ? (u.pm * BM) / SEQ : 2;
        const float* xi = lat ? xin_lat + (size_t)u.pm * BM * DM : xin_ctx + (size_t)(u.pm * BM - TL) * DM;
        float* xo = lat ? xs_lat + (size_t)u.pm * BM * DM : xs_ctx + (size_t)(u.pm * BM - TL) * DM;
        const float* g = modbase + (size_t)s * 6 * DM + which * DM;
        const int col0 = u.pn * BM + wc * 32 + 8 * fq;
        const size_t ro0 = (size_t)(wr * 64 + fr) * DM + col0;
#pragma unroll
        for (int bj = 0; bj < 2; ++bj) { const f32x4 g0 = *(const f32x4*)(g + col0 + bj * HALF) * scale, g1 = *(const f32x4*)(g + col0 + bj * HALF + 4) * scale;
#pragma unroll
            for (int ai = 0; ai < 2; ++ai) {
#pragma unroll
                for (int m = 0; m < 4; ++m) { const size_t ro = ro0 + (size_t)(ai * HALF + m * 16) * DM + bj * HALF;
                    const f32x4 x0 = *(const f32x4*)(xi + ro), x1 = *(const f32x4*)(xi + ro + 4);
                    *(f32x4*)(xo + ro) = x0 + g0 * acc[ai][bj][m][0]; *(f32x4*)(xo + ro + 4) = x1 + g1 * acc[ai][bj][m][1]; }
                asm volatile("" ::: "memory"); } }
    }
};

template <class Epi, class Sched, bool GATHER, bool FP8 = false>
__device__ __forceinline__ void gemm_phase(LAS unsigned char* lds, const int tid_in, const int lda, const int ldb, const int K, const Sched& S, const Epi& E) {
    const int wid = __builtin_amdgcn_readfirstlane(tid_in >> 6), lane = tid_in & 63, wr = wid >> 2, wc = wid & 3, fr = lane & 15, fq = lane >> 4;
    const int nt = K / BK;
#define tid (wid * 64 + lane)
    unsigned ao[2][2], voffA[2], voffB[2];
#pragma unroll
    for (int i = 0; i < 2; ++i) { int R, C; if constexpr (FP8) stage_rc8(tid * 16 + i * 8192, R, C); else stage_rc(tid * 16 + i * 8192, R, C); const int Rb = Epi::PERM ? ((R & ~31) + perm32(R & 31)) : R;
        voffB[i] = (unsigned)(Rb * ldb + C) * 2u; voffA[i] = (unsigned)(R * lda + C) * 2u;
        ao[0][i] = 0u; ao[1][i] = 0u; }
    const size_t kstep = (size_t)(BK * 2);
    const size_t hstepB = (size_t)HALF * ldb * 2, hstepA = (size_t)HALF * lda * 2;
    const unsigned ldsw = (unsigned)wid * 1024u;
    const int aoff = lds_byte(wr * 64 + fr, fq * 8), boff = lds_byte(wc * 32 + fr, fq * 8);
    const int aoff8 = lds_byte8(wr * 64 + fr, fq, 0), boff8 = lds_byte8(wc * 32 + fr, fq, 0), aoff8b = lds_byte8(wr * 64 + fr, fq, 1), boff8b = lds_byte8(wc * 32 + fr, fq, 1);
#define PG8_SA(b, h) (((b) * 2 + (h)) * HTB)
#define PG8_SB(b, h) ((4 + (b) * 2 + (h)) * HTB)
#define PG8_STAGE(bufoff, gbase, voff) do { _Pragma("unroll") for (int _i = 0; _i < 2; ++_i) \
        __builtin_amdgcn_global_load_lds((const unsigned*)((const char*)(gbase) + (voff)[_i]), (LAS unsigned*)(lds + (bufoff) + ldsw + _i * 8192), 16, 0, 0); } while (0)
#define PG8_STAGE_A(bufoff, gbase, h, nx) do { if constexpr (GATHER) { _Pragma("unroll") for (int _i = 0; _i < 2; ++_i) { const unsigned _o = ao[h][_i]; \
        __builtin_amdgcn_global_load_lds((const unsigned*)((const char*)(gbase) + _o), (LAS unsigned*)(lds + (bufoff) + ldsw + _i * 8192), 16, 0, 0); } } \
        else { PG8_STAGE(bufoff, (const char*)(gbase) + ((h) ? hstepA : (size_t)0), voffA); } } while (0)
#define PG8_LDA(dst, b, h) do { if constexpr (FP8) { _Pragma("unroll") for (int m = 0; m < 4; ++m) dst##8[m] = __builtin_shufflevector(*(const LAS v4i_t*)(lds + PG8_SA(b, h) + aoff8 + m * 2048), *(const LAS v4i_t*)(lds + PG8_SA(b, h) + aoff8b + m * 2048), 0, 1, 2, 3, 4, 5, 6, 7); } \
        else { _Pragma("unroll") for (int m = 0; m < 4; ++m) _Pragma("unroll") for (int k = 0; k < 2; ++k) dst[m][k] = *(const LAS bf16x8*)(lds + PG8_SA(b, h) + aoff + m * 2048 + k * 1024); } } while (0)
#define PG8_LDB(dst, b, h) do { if constexpr (FP8) { _Pragma("unroll") for (int n = 0; n < 2; ++n) dst##8[n] = __builtin_shufflevector(*(const LAS v4i_t*)(lds + PG8_SB(b, h) + boff8 + n * 2048), *(const LAS v4i_t*)(lds + PG8_SB(b, h) + boff8b + n * 2048), 0, 1, 2, 3, 4, 5, 6, 7); } \
        else { _Pragma("unroll") for (int n = 0; n < 2; ++n) _Pragma("unroll") for (int k = 0; k < 2; ++k) dst[n][k] = *(const LAS bf16x8*)(lds + PG8_SB(b, h) + boff + n * 2048 + k * 1024); } } while (0)
#define PG8_MMA(ai, bj, At, Bt) do { __builtin_amdgcn_s_setprio(1); if constexpr (FP8) { _Pragma("unroll") for (int m = 0; m < 4; ++m) _Pragma("unroll") for (int n = 0; n < 2; ++n) \
        asm volatile("v_mfma_scale_f32_16x16x128_f8f6f4 %0, %1, %2, %0, %3, %3 op_sel_hi:[0,0,0]" : "+v"(acc[ai][bj][m][n]) : "v"(Bt##8[n]), "v"(At##8[m]), "v"(sc1)); } \
        else { _Pragma("unroll") for (int m = 0; m < 4; ++m) _Pragma("unroll") for (int n = 0; n < 2; ++n) _Pragma("unroll") for (int k = 0; k < 2; ++k) \
        acc[ai][bj][m][n] = __builtin_amdgcn_mfma_f32_16x16x32_bf16(Bt[n][k], At[m][k], acc[ai][bj][m][n], 0, 0, 0); } __builtin_amdgcn_s_setprio(0); } while (0)
#define PG8_WAIT_V(n) asm volatile("s_waitcnt vmcnt(" #n ")" ::: "memory")
#define PG8_WAIT_L(n) asm volatile("s_waitcnt lgkmcnt(" #n ")" ::: "memory")
#define PG8_BAR __builtin_amdgcn_s_barrier()
#define PG8_SCHED __builtin_amdgcn_sched_barrier(0)
#define PG8_GOFF(dst, u) do { if constexpr (GATHER) { _Pragma("unroll") for (int _i = 0; _i < 2; ++_i) { int _R, _C; if constexpr (FP8) stage_rc8(tid * 16 + _i * 8192, _R, _C); else stage_rc(tid * 16 + _i * 8192, _R, _C); \
        _Pragma("unroll") for (int _h = 0; _h < 2; ++_h) { const int _r = _R + _h * HALF; \
        const int _e = (_r < (u).nrows) ? (u).list[_r] : (u).list[0]; dst[_h][_i] = (unsigned)(_e >> 1) * (unsigned)(lda * 2) + (unsigned)(_C * 2); } } } } while (0)
    Unit cur, nxt; int ui = 0;
    if (!S.next(0, cur)) return;
    f32x4 acc[2][2][4][2];
#define PG8_ZERO_ACC() do { float _z = 0.f; asm volatile("" : "+v"(_z)); const f32x4 _zv = (f32x4){_z, _z, _z, _z}; \
    _Pragma("unroll") for (int a = 0; a < 2; ++a) _Pragma("unroll") for (int b = 0; b < 2; ++b) _Pragma("unroll") for (int m = 0; m < 4; ++m) _Pragma("unroll") for (int n = 0; n < 2; ++n) acc[a][b][m][n] = _zv; \
    if constexpr (FP8) asm volatile("s_nop 15" ::: "memory"); } while (0)
    PG8_ZERO_ACC();
    const int sc1 = 0x7f7f7f7f;
    bf16x8 At[4][2], B0[2][2], B1[2][2]; v8i_t At8[4], B08[2], B18[2];
    const char* cA = cur.A; const char* cB = cur.B;
    PG8_GOFF(ao, cur);
    PG8_STAGE(PG8_SB(0, 0), cB, voffB); PG8_STAGE(PG8_SB(0, 1), cB + hstepB, voffB); PG8_STAGE_A(PG8_SA(0, 0), cA, 0, false); PG8_STAGE_A(PG8_SA(0, 1), cA, 1, false);
    if (wr == 1) PG8_BAR;
    PG8_WAIT_V(2); PG8_BAR;
    PG8_STAGE(PG8_SB(1, 0), cB + kstep, voffB); PG8_STAGE_A(PG8_SA(1, 0), cA + kstep, 0, false); PG8_STAGE(PG8_SB(1, 1), cB + hstepB + kstep, voffB);
    PG8_WAIT_V(6); PG8_BAR;
    for (;;) {
        const bool has_next = S.next(ui + 1, nxt);
        const char* nA = has_next ? nxt.A : cA; const char* nB = has_next ? nxt.B : cB;
#if CLK_PROBE >= 3 && CLK_PROBE <= 5
        if (FP8 && (ui == 1 || ui == 2) && blockIdx.x == 0 && tid_in == 0 && ((volatile LAS unsigned*)(lds + 131072 + 320))[20] == 1u) { volatile LAS unsigned* M_ = (volatile LAS unsigned*)(lds + 131072 + 320);
            const unsigned now = (unsigned)__builtin_readcyclecounter();
            if (ui == 1) M_[16] = now; else { if (CLK_PROBE == 4) M_[18] = now - M_[17]; if (CLK_PROBE == 5) M_[18] = (now - M_[16]) / 2u; } }
#endif
        for (int t = 0; t < nt; t += 2) {
            const bool last = (t == nt - 2);
            const char* a1 = cA + (size_t)(t + 1) * kstep;
            const char* a2 = last ? nA : cA + (size_t)(t + 2) * kstep; const char* b2 = last ? nB : cB + (size_t)(t + 2) * kstep;
            const char* a3 = a2 + kstep; const char* b3 = b2 + kstep;
            const bool nx = GATHER && last;
            PG8_LDB(B0, 0, 0); PG8_LDB(B1, 0, 1); PG8_SCHED; PG8_LDA(At, 0, 0); PG8_STAGE_A(PG8_SA(1, 1), a1, 1, false);
            if constexpr (GATHER) { if (last && has_next) { PG8_GOFF(ao, nxt); } }
            PG8_WAIT_V(8); PG8_WAIT_L(0); PG8_BAR; PG8_MMA(0, 0, At, B0); PG8_MMA(0, 1, At, B1); PG8_BAR; PG8_SCHED;
            PG8_LDA(At, 0, 1); PG8_STAGE(PG8_SB(0, 0), b2, voffB); PG8_STAGE(PG8_SB(0, 1), b2 + hstepB, voffB); PG8_STAGE_A(PG8_SA(0, 0), a2, 0, nx);
            PG8_WAIT_V(8); PG8_WAIT_L(0); PG8_BAR; PG8_MMA(1, 0, At, B0); PG8_MMA(1, 1, At, B1); PG8_BAR; PG8_SCHED;
            PG8_LDB(B0, 1, 0); PG8_LDB(B1, 1, 1); PG8_SCHED; PG8_LDA(At, 1, 0); PG8_STAGE_A(PG8_SA(0, 1), a2, 1, nx);
            PG8_WAIT_V(8); PG8_WAIT_L(0); PG8_BAR; PG8_MMA(0, 0, At, B0); PG8_MMA(0, 1, At, B1); PG8_BAR; PG8_SCHED;
            PG8_LDA(At, 1, 1); PG8_STAGE(PG8_SB(1, 0), b3, voffB); PG8_STAGE(PG8_SB(1, 1), b3 + hstepB, voffB); PG8_STAGE_A(PG8_SA(1, 0), a3, 0, nx);
            PG8_WAIT_V(8); PG8_WAIT_L(0); PG8_BAR; PG8_MMA(1, 0, At, B0); PG8_MMA(1, 1, At, B1); PG8_BAR; PG8_SCHED;
        }
#if CLK_PROBE >= 3 && CLK_PROBE <= 5
        if (FP8 && ui == 1 && blockIdx.x == 0 && tid_in == 0 && ((volatile LAS unsigned*)(lds + 131072 + 320))[20] == 1u) { volatile LAS unsigned* M_ = (volatile LAS unsigned*)(lds + 131072 + 320);
            const unsigned now = (unsigned)__builtin_readcyclecounter(); M_[17] = now; if (CLK_PROBE == 3) M_[18] = (now - M_[16]) / (unsigned)nt * 10u; }
#endif
        if (wr == 0) PG8_BAR;
        if constexpr (FP8) asm volatile("s_nop 15\n\ts_nop 15" ::: "memory");
        { int ln = lane; asm volatile("" : "+v"(ln)); E(acc, cur, wr, wc, ln & 15, ln >> 4); }
        if (!has_next) break;
        PG8_ZERO_ACC();
        cur = nxt; cA = nA; cB = nB; ++ui;
        if (wr == 1) PG8_BAR;
    }
    PG8_WAIT_V(0);
    PG8_BAR;
#undef PG8_SA
#undef PG8_SB
#undef PG8_STAGE
#undef PG8_STAGE_A
#undef PG8_LDA
#undef PG8_LDB
#undef PG8_MMA
#undef PG8_WAIT_V
#undef PG8_WAIT_L
#undef PG8_BAR
#undef PG8_SCHED
#undef PG8_GOFF
#undef PG8_ZERO_ACC
#undef tid
}
}


struct MapPlain { __device__ __forceinline__ int operator()(int n) const { return n; } };
struct MapGate { int i; __device__ __forceinline__ int operator()(int ch) const { return (ch >> 6) * 256 + 128 * (i >> 1) + 32 * ((ch & 63) >> 4) + 16 * (i & 1) + (ch & 15); } };
struct MapW13 { int which; __device__ __forceinline__ int operator()(int j) const { return (j >> 7) * 256 + which * 128 + (j & 127); } };
template <class Map> __device__ __forceinline__ void cvt_item(const float* W, int N, int k0, int n0, bf16_t* WT, int ldk, const Map& map, LAS float* scr, int lane) {
#pragma unroll 8
    for (int i = 0; i < 32; ++i) { const int kk = 2 * i + (lane >> 5); scr[kk * 33 + (lane & 31)] = W[(size_t)(k0 + kk) * N + n0 + (lane & 31)]; }
    asm volatile("s_waitcnt lgkmcnt(0)" ::: "memory");
    const int c = lane & 7;
#pragma unroll
    for (int j = 0; j < 4; ++j) { const int n = (lane >> 3) + 8 * j; const LAS float* sp = scr + (8 * c) * 33 + n;
        u32x4 o; o.x = pk2(sp[0 * 33], sp[1 * 33]); o.y = pk2(sp[2 * 33], sp[3 * 33]); o.z = pk2(sp[4 * 33], sp[5 * 33]); o.w = pk2(sp[6 * 33], sp[7 * 33]);
        *(u32x4*)(WT + (size_t)map(n0 + n) * ldk + k0 + 8 * c) = o; }
    asm volatile("s_waitcnt lgkmcnt(0)" ::: "memory");
}
template <class Map> __device__ __forceinline__ void cvt_item8(const float* W, int N, int k0, int n0, unsigned char* WT, int ldk, const Map& map, float scale, LAS float* scr, int lane) {
#pragma unroll 8
    for (int i = 0; i < 32; ++i) { const int kk = 2 * i + (lane >> 5); scr[kk * 33 + (lane & 31)] = W[(size_t)(k0 + kk) * N + n0 + (lane & 31)]; }
    asm volatile("s_waitcnt lgkmcnt(0)" ::: "memory");
    const int c = lane & 7;
#pragma unroll
    for (int j = 0; j < 4; ++j) { const int n = (lane >> 3) + 8 * j; const LAS float* sp = scr + (8 * c) * 33 + n;
        int a = 0, b = 0;
        a = __builtin_amdgcn_cvt_pk_fp8_f32(sp[0 * 33] * scale, sp[1 * 33] * scale, a, false); a = __builtin_amdgcn_cvt_pk_fp8_f32(sp[2 * 33] * scale, sp[3 * 33] * scale, a, true);
        b = __builtin_amdgcn_cvt_pk_fp8_f32(sp[4 * 33] * scale, sp[5 * 33] * scale, b, false); b = __builtin_amdgcn_cvt_pk_fp8_f32(sp[6 * 33] * scale, sp[7 * 33] * scale, b, true);
        u32x2 o; o.x = (unsigned)a; o.y = (unsigned)b;
        *(u32x2*)(WT + (size_t)map(n0 + n) * ldk + k0 + 8 * c) = o; }
    asm volatile("s_waitcnt lgkmcnt(0)" ::: "memory");
}
template <class Map> __device__ __forceinline__ int cvt_matrix8(Frame& F, const float* W, int K, int N, unsigned char* WT, const Map& map, float scale, int run, int ldk = 0) {
    LAS float* scr = (LAS float*)(F.lds + F.wave * 8448);
    const int gw = F.bid * NWAVES + F.wave, NGW = F.G * NWAVES;
    const int nblk = N / 32, nitems = (K / 64) * nblk;
    int first = (gw - (run % NGW) + NGW) % NGW;
    for (int it = first; it < nitems; it += NGW) cvt_item8(W, N, (it / nblk) * 64, (it % nblk) * 32, WT, ldk ? ldk : K, map, scale, scr, F.lane);
    return run + nitems;
}
template <class Map> __device__ __forceinline__ int cvt_matrix(Frame& F, const float* W, int K, int N, bf16_t* WT, const Map& map, int run) {
    LAS float* scr = (LAS float*)(F.lds + F.wave * 8448);
    const int gw = F.bid * NWAVES + F.wave, NGW = F.G * NWAVES;
    const int nblk = N / 32, nitems = (K / 64) * nblk;
    int first = (gw - (run % NGW) + NGW) % NGW;
    for (int it = first; it < nitems; it += NGW) cvt_item(W, N, (it / nblk) * 64, (it % nblk) * 32, WT, K, map, scr, F.lane);
    return run + nitems;
}
__device__ __forceinline__ void ph_convert(Frame& F) {
    int run = 0;
    for (int l = 0; l < DEPTH; ++l) {
        unsigned char* wl = F.ws + WS_W + (size_t)l * WL_STRIDE;
        run = cvt_matrix8(F, F.in(8) + (size_t)l * DM * DIN, DM, DIN, (unsigned char*)(wl + WO_IN), MapPlain{}, GATE_WSCALE, run);
        {
            u32x4* z = (u32x4*)((unsigned char*)(wl + WO_IN) + (size_t)DIN * DM); const int n16 = (PP - DIN) * DM / 16;
            for (int i = F.bid * NTHREADS + F.tid; i < n16; i += F.G * NTHREADS) z[i] = (u32x4){0u, 0u, 0u, 0u};
        }
        run = cvt_matrix8(F, F.in(12) + (size_t)l * 256 * 1024, 256, 1024, (unsigned char*)(wl + WO_UQ), MapPlain{}, GATE_WSCALE, run, 512);
        run = cvt_matrix8(F, F.in(10) + (size_t)l * 384 * 768, 384, 768, (unsigned char*)(wl + WO_UQ) + 1024 * 512 + 128, MapPlain{}, GATE_WSCALE, run, 512);
        {
            unsigned char* wb = (unsigned char*)(wl + WO_UQ);
            for (int i = F.bid * NTHREADS + F.tid; i < 1024 * 16 + 768 * 8; i += F.G * NTHREADS) {
                u32x4* z = (i < 1024 * 16) ? (u32x4*)(wb + (size_t)(i >> 4) * 512 + 256 + (i & 15) * 16) : (u32x4*)(wb + (size_t)(1024 + ((i - 1024 * 16) >> 3)) * 512 + ((i - 1024 * 16) & 7) * 16);
                *z = (u32x4){0u, 0u, 0u, 0u};
            }
        }
        for (int i = 0; i < 4; ++i) run = cvt_matrix8(F, F.in(24) + (size_t)(l * 4 + i) * DM * DM, DM, DM, (unsigned char*)(wl + WO_G), MapGate{i}, GATE_WSCALE, run);
        for (int i = 0; i < 4; ++i) run = cvt_matrix8(F, F.in(23) + (size_t)(l * 4 + i) * 512 * DM, 512, DM, (unsigned char*)(wl + WO_B) + (size_t)i * DM * 512, MapPlain{}, GATE_WSCALE, run);
        run = cvt_matrix8(F, F.in(26) + (size_t)l * DM * DM, DM, DM, (unsigned char*)(wl + WO_O), MapPlain{}, GATE_WSCALE, run);
        for (int e = 0; e < NEXP; ++e) {
            run = cvt_matrix8(F, F.in(29) + (size_t)(l * NEXP + e) * DM * DEXP, DM, DEXP, (unsigned char*)(wl + WO_13) + (size_t)e * 1024 * DM, MapW13{0}, GATE_WSCALE, run);
            run = cvt_matrix8(F, F.in(30) + (size_t)(l * NEXP + e) * DM * DEXP, DM, DEXP, (unsigned char*)(wl + WO_13) + (size_t)e * 1024 * DM, MapW13{1}, GATE_WSCALE, run);
            run = cvt_matrix8(F, F.in(31) + (size_t)(l * NEXP + e) * DEXP * DM, DEXP, DM, (unsigned char*)(wl + WO_2) + (size_t)e * DM * DEXP, MapPlain{}, GATE_WSCALE, run);
        }
    }
}

namespace pg8 {
__device__ __forceinline__ float fsigmoid(float x) { return __builtin_amdgcn_rcpf(1.0f + __builtin_amdgcn_exp2f(-1.4426950408889634f * x)); }
struct EpiGate {
    static constexpr bool PERM = false;
    const unsigned char* BV; const float* bg; bf16_t* ACC;
    __device__ __forceinline__ void operator()(const f32x4 (&acc)[2][2][4][2], const Unit& u, int wr, int wc, int fr, int fq) const {
        const int ch0 = u.pn * 64 + wc * 16 + fq * 4;
        f32x4 b[4];
#pragma unroll
        for (int i = 0; i < 4; ++i) b[i] = *(const f32x4*)(bg + i * DM + ch0);
#pragma unroll
        for (int ai = 0; ai < 2; ++ai) {
            int v[4][4];
#pragma unroll
            for (int m = 0; m < 4; ++m) { const unsigned char* bv = BV + (size_t)(u.pm * BM + ai * HALF + wr * 64 + m * 16 + fr) * 8192 + ch0;
#pragma unroll
                for (int i = 0; i < 4; ++i) v[m][i] = *(const int*)(bv + i * DM); }
#pragma unroll
            for (int m = 0; m < 4; ++m) { const size_t row = (size_t)(u.pm * BM + ai * HALF + wr * 64 + m * 16 + fr);
                f32x4 tot = (f32x4){0.f, 0.f, 0.f, 0.f};
#pragma unroll
                for (int bj = 0; bj < 2; ++bj)
#pragma unroll
                    for (int n = 0; n < 2; ++n) { const int i = 2 * bj + n; const f32x4 a = acc[ai][bj][m][n] * (1.0f / GATE_WSCALE) + b[i];
                        tot.x += fsigmoid(a.x) * __builtin_amdgcn_cvt_f32_fp8(v[m][i], 0); tot.y += fsigmoid(a.y) * __builtin_amdgcn_cvt_f32_fp8(v[m][i], 1);
                        tot.z += fsigmoid(a.z) * __builtin_amdgcn_cvt_f32_fp8(v[m][i], 2); tot.w += fsigmoid(a.w) * __builtin_amdgcn_cvt_f32_fp8(v[m][i], 3); }
                const float os = ACC_SCALE / BV_SCALE;
                int o8 = 0; o8 = cvt8s(tot.x * os, tot.y * os, o8, false); o8 = cvt8s(tot.z * os, tot.w * os, o8, true);
                *(int*)((unsigned char*)ACC + row * DM + ch0) = o8; }
            asm volatile("" ::: "memory"); }
    }
};
struct SchedMoe {
    const unsigned* ecnt; const int* elist; const char* A; const char* W; int npn, G, c; size_t w_estride, w_pnstride, a_tstride; bool gather;
    __device__ __forceinline__ bool next(int i, Unit& u) const {
        int nt = 0;
        for (int e = 0; e < NEXP; ++e) nt += ((int)ecnt[e] + 255) >> 8;
        const long L = (long)i * G + c; if (L >= (long)nt * npn) return false;
        const int ti = (int)(L / npn), pn = (int)(L % npn);
        int e = 0, tb = 0, cn = 0, run = 0;
        for (int q = 0; q < NEXP; ++q) { const int n = (int)ecnt[q], t = (n + 255) >> 8; if (ti >= run && ti < run + t) { e = q; tb = run; cn = n; } run += t; }
        u.pm = ti; u.pn = pn; u.A = gather ? A : A + (size_t)ti * a_tstride; u.B = W + (size_t)e * w_estride + (size_t)pn * w_pnstride;
        u.list = elist + (size_t)e * TT + (size_t)(ti - tb) * 256; u.nrows = min(256, cn - (ti - tb) * 256); u.aux = e; return true;
    }
};
__device__ __forceinline__ float fsilu(float x) { return x * fsigmoid(x); }
struct EpiSwiGLU {
    static constexpr bool PERM = true;
    unsigned char* HID;
    __device__ __forceinline__ void operator()(const f32x4 (&acc)[2][2][4][2], const Unit& u, int wr, int wc, int fr, int fq) const {
        const int col0 = u.pn * 128 + wc * 32 + 8 * fq; const float is = 1.0f / GATE_WSCALE;
#pragma unroll
        for (int ai = 0; ai < 2; ++ai)
#pragma unroll
            for (int m = 0; m < 4; ++m) { const size_t row = (size_t)(u.pm * BM + ai * HALF + wr * 64 + m * 16 + fr);
                const f32x4 a0 = acc[ai][0][m][0] * is, a1 = acc[ai][0][m][1] * is, c0 = acc[ai][1][m][0] * is, c1 = acc[ai][1][m][1] * is;
                int x = 0, y = 0;
                x = cvt8s(fsilu(a0.x) * c0.x, fsilu(a0.y) * c0.y, x, false); x = cvt8s(fsilu(a0.z) * c0.z, fsilu(a0.w) * c0.w, x, true);
                y = cvt8s(fsilu(a1.x) * c1.x, fsilu(a1.y) * c1.y, y, false); y = cvt8s(fsilu(a1.z) * c1.z, fsilu(a1.w) * c1.w, y, true);
                u32x2 w; w.x = (unsigned)x; w.y = (unsigned)y;
                *(u32x2*)(HID + row * DEXP + col0) = w; }
    }
};
struct EpiMoeDown {
    static constexpr bool PERM = true;
    bf16_t* Y;
    __device__ __forceinline__ void operator()(const f32x4 (&acc)[2][2][4][2], const Unit& u, int wr, int wc, int fr, int fq) const {
        const int col0 = u.pn * BM + wc * 32 + 8 * fq;
        const float* lw = (const float*)((const char*)u.list + (WS_ELW - WS_ELIST));
#pragma unroll
        for (int ai = 0; ai < 2; ++ai)
#pragma unroll
            for (int m = 0; m < 4; ++m) { const int r = ai * HALF + wr * 64 + m * 16 + fr;
                if (r < u.nrows) { const int en = u.list[r]; const float w = lw[r] * (1.0f / GATE_WSCALE);
                    bf16_t* rowp = Y + (size_t)(en & 1) * TT * DM + (size_t)(en >> 1) * DM + col0;
#pragma unroll
                    for (int bj = 0; bj < 2; ++bj) { const f32x4 v0 = acc[ai][bj][m][0] * w, v1 = acc[ai][bj][m][1] * w;
                        u32x4 o; o.x = cvt_pk_bf16(v0[0], v0[1]); o.y = cvt_pk_bf16(v0[2], v0[3]); o.z = cvt_pk_bf16(v1[0], v1[1]); o.w = cvt_pk_bf16(v1[2], v1[3]);
                        *(u32x4*)(rowp + bj * HALF) = o; } }
                asm volatile("" ::: "memory"); }
    }
};
}
__device__ __forceinline__ void ph_fbranch(Frame& F, int l) {
    const int M = (l == 0) ? TT : TL;
    pg8::SchedPlain S{(const char*)(F.ws + WS_OUTS), (const char*)(F.ws + WS_W + (size_t)l * WL_STRIDE + WO_B), DM / 2, 256, M / 256, 32, F.G, F.bid, 8, 512};
    pg8::EpiFp8 E{F.ws + WS_BV, 8192, BV_SCALE / (OUT_SCALE * GATE_WSCALE)};
    pg8::gemm_phase<pg8::EpiFp8, pg8::SchedPlain, false, true>(F.lds, F.tid, DM / 2, 256, 256, S, E);
}
__device__ __forceinline__ void ph_fgate(Frame& F, int l) {
    const int M = (l == 0) ? TT : TL;
    pg8::SchedPlain S{(const char*)(F.ws + WS_H8), (const char*)(F.ws + WS_W + (size_t)l * WL_STRIDE + WO_G), DM / 2, DM / 2, M / 256, 32, F.G, F.bid, 1 << 30, 0};
    pg8::EpiGate E{F.ws + WS_BV, F.in(25) + (size_t)l * 4 * DM, (bf16_t*)(F.ws + WS_ACC)};
    pg8::gemm_phase<pg8::EpiGate, pg8::SchedPlain, false, true>(F.lds, F.tid, DM / 2, DM / 2, DM / 2, S, E);
}
__device__ __forceinline__ void ph_fmoe_up(Frame& F, int l) {
    pg8::SchedMoe S{(const unsigned*)(F.ws + WS_CTL) + CW_ECNT + l * 16, (const int*)(F.ws + WS_ELIST), (const char*)(F.ws + WS_H8), (const char*)(F.ws + WS_W + (size_t)l * WL_STRIDE + WO_13), 4, F.G, F.bid,
                    (size_t)1024 * DM, (size_t)256 * DM, 0, true};
    pg8::EpiSwiGLU E{(unsigned char*)(F.ws + WS_HID)};
    pg8::gemm_phase<pg8::EpiSwiGLU, pg8::SchedMoe, true, true>(F.lds, F.tid, DM / 2, DM / 2, DM / 2, S, E);
}
__device__ __forceinline__ void ph_fmoe_down(Frame& F, int l) {
    pg8::SchedMoe S{(const unsigned*)(F.ws + WS_CTL) + CW_ECNT + l * 16, (const int*)(F.ws + WS_ELIST), (const char*)(F.ws + WS_HID), (const char*)(F.ws + WS_W + (size_t)l * WL_STRIDE + WO_2), 8, F.G, F.bid,
                    (size_t)DM * DEXP, (size_t)256 * DEXP, (size_t)256 * DEXP, false};
    pg8::EpiMoeDown E{(bf16_t*)(F.ws + WS_PROJ)};
    pg8::gemm_phase<pg8::EpiMoeDown, pg8::SchedMoe, false, true>(F.lds, F.tid, DEXP / 2, DEXP / 2, DEXP / 2, S, E);
}

namespace fa {
using bf16x8 = __attribute__((ext_vector_type(8))) short;
using s16x4 = __attribute__((ext_vector_type(4))) short;
using f32x16 = __attribute__((ext_vector_type(16))) float;
constexpr int NW = 8, QBLK = 32, KVBLK = 64;
constexpr float THR = 8.f;
#define FA_SBAR() __builtin_amdgcn_sched_barrier(0)
__device__ __forceinline__ int crow(int r, int hi) { return (r & 3) + 8 * (r >> 2) + 4 * hi; }
__device__ __forceinline__ unsigned cvtpk(float lo, float hi) { unsigned r; asm volatile("v_cvt_pk_bf16_f32 %0, %1, %2" : "=v"(r) : "v"(lo), "v"(hi)); return r; }
template <int DQK> __device__ __forceinline__ int kswz(int row, int colB) { return row * (DQK * 2) + (colB ^ ((row & 7) << 4)); }
__device__ __forceinline__ int v_st(int k, int c) { const int kk = (k & ~0xC) | ((k & 4) << 1) | ((k & 8) >> 1); return ((kk >> 3) * 4 + (c >> 5)) * 512 + ((kk & 7) * 32 + (c & 31)) * 2; }
__device__ __forceinline__ int v_rd_base(int lane) { return ((lane & 3) << 3) | (((lane >> 2) & 3) << 6) | (((lane >> 4) & 1) << 5) | (((lane >> 5) & 1) << 8); }
constexpr int v_rd_off(int d0, int ks, int half) { return d0 * 512 + ks * 4096 + half * 2048; }
template <int OFF> __device__ __forceinline__ s16x4 tr_read(int vb) { s16x4 r; asm volatile("ds_read_b64_tr_b16 %0, %1 offset:%2" : "=&v"(r) : "v"(vb), "i"(OFF) : "memory"); return r; }
template <int D0> __device__ __forceinline__ void pv_one(f32x16& od, int vb, bf16x8 pa0, bf16x8 pa1, bf16x8 pa2, bf16x8 pa3) {
    const s16x4 l0 = tr_read<v_rd_off(D0, 0, 0)>(vb), h0 = tr_read<v_rd_off(D0, 0, 1)>(vb), l1 = tr_read<v_rd_off(D0, 1, 0)>(vb), h1 = tr_read<v_rd_off(D0, 1, 1)>(vb);
    const s16x4 l2 = tr_read<v_rd_off(D0, 2, 0)>(vb), h2 = tr_read<v_rd_off(D0, 2, 1)>(vb), l3 = tr_read<v_rd_off(D0, 3, 0)>(vb), h3 = tr_read<v_rd_off(D0, 3, 1)>(vb);
    asm volatile("s_waitcnt lgkmcnt(0)" ::: "memory"); FA_SBAR();
#define FA_PK(L, H) (bf16x8){L[0], L[1], L[2], L[3], H[0], H[1], H[2], H[3]}
    od = __builtin_amdgcn_mfma_f32_32x32x16_bf16(pa0, FA_PK(l0, h0), od, 0, 0, 0);
    od = __builtin_amdgcn_mfma_f32_32x32x16_bf16(pa1, FA_PK(l1, h1), od, 0, 0, 0);
    od = __builtin_amdgcn_mfma_f32_32x32x16_bf16(pa2, FA_PK(l2, h2), od, 0, 0, 0);
    od = __builtin_amdgcn_mfma_f32_32x32x16_bf16(pa3, FA_PK(l3, h3), od, 0, 0, 0);
#undef FA_PK
}
__device__ __forceinline__ void pv_d0(f32x16* o, int vb, bf16x8 pa0, bf16x8 pa1, bf16x8 pa2, bf16x8 pa3) {
    pv_one<0>(o[0], vb, pa0, pa1, pa2, pa3); pv_one<1>(o[1], vb, pa0, pa1, pa2, pa3); pv_one<2>(o[2], vb, pa0, pa1, pa2, pa3); pv_one<3>(o[3], vb, pa0, pa1, pa2, pa3);
}
__device__ __forceinline__ void partialSM(f32x16& p0, f32x16& p1, float& m_reg, float& mn, float& alpha, const float C, const float thr_raw) {
    float pmax = p0[0];
#pragma unroll
    for (int r = 1; r < 16; ++r) pmax = fmaxf(pmax, p0[r]);
#pragma unroll
    for (int r = 0; r < 16; ++r) pmax = fmaxf(pmax, p1[r]);
    { auto rr = __builtin_amdgcn_permlane32_swap(__float_as_uint(pmax), __float_as_uint(pmax), false, false); pmax = fmaxf(__uint_as_float(rr[0]), __uint_as_float(rr[1])); }
    if (__builtin_expect(__all(pmax - m_reg <= thr_raw), 1)) { mn = m_reg; alpha = 1.f; }
    else { mn = fmaxf(m_reg, pmax); alpha = __builtin_amdgcn_exp2f((m_reg - mn) * C); m_reg = mn; }
    const float mnC = -mn * C;
#pragma unroll
    for (int r = 0; r < 16; ++r) p0[r] = fmaf(p0[r], C, mnC);
#pragma unroll
    for (int r = 0; r < 16; ++r) p1[r] = fmaf(p1[r], C, mnC);
#pragma unroll
    for (int r = 0; r < 16; ++r) p0[r] = __builtin_amdgcn_exp2f(p0[r]);
}
__device__ __forceinline__ void finishSM(f32x16& p0, f32x16& p1, float alpha, float& l_reg, bf16x8& pa0, bf16x8& pa1, bf16x8& pa2, bf16x8& pa3) {
#pragma unroll
    for (int r = 0; r < 16; ++r) p1[r] = __builtin_amdgcn_exp2f(p1[r]);
    float ps = 0;
#pragma unroll
    for (int r = 0; r < 16; ++r) ps += p0[r];
#pragma unroll
    for (int r = 0; r < 16; ++r) ps += p1[r];
    { auto rr = __builtin_amdgcn_permlane32_swap(__float_as_uint(ps), __float_as_uint(ps), false, false); ps = __uint_as_float(rr[0]) + __uint_as_float(rr[1]); }
    l_reg = l_reg * alpha + ps;
#define FA_PK4(P, BASE, OUT) do { unsigned a0 = cvtpk(P[BASE + 0], P[BASE + 1]), a1 = cvtpk(P[BASE + 2], P[BASE + 3]);   \
    unsigned b0 = cvtpk(P[BASE + 4], P[BASE + 5]), b1 = cvtpk(P[BASE + 6], P[BASE + 7]);                              \
    auto r0 = __builtin_amdgcn_permlane32_swap(a0, b0, false, false); auto r1 = __builtin_amdgcn_permlane32_swap(a1, b1, false, false); \
    u32x4 w = {r0[0], r1[0], r0[1], r1[1]}; OUT = *reinterpret_cast<bf16x8*>(&w); } while (0)
    FA_PK4(p0, 0, pa0); FA_PK4(p0, 8, pa1); FA_PK4(p1, 0, pa2); FA_PK4(p1, 8, pa3);
#undef FA_PK4
}
template <int DQK> __device__ __forceinline__ void qkt(f32x16& p0, f32x16& p1, const char* Ks, const bf16x8* qr, const char* qx, int r32, int hi) {
    p0 = f32x16{}; p1 = f32x16{};
#pragma unroll
    for (int d0 = 0; d0 < DQK / 16; ++d0) { const int cb = (d0 * 16 + hi * 8) * 2;
        const bf16x8 b0 = *reinterpret_cast<const bf16x8*>(Ks + kswz<DQK>(r32, cb));
        const bf16x8 b1 = *reinterpret_cast<const bf16x8*>(Ks + kswz<DQK>(32 + r32, cb));
        const bf16x8 q = d0 < 8 ? qr[d0 < 8 ? d0 : 0] : *reinterpret_cast<const bf16x8*>(qx + (d0 - 8) * 1024);
        p0 = __builtin_amdgcn_mfma_f32_32x32x16_bf16(b0, q, p0, 0, 0, 0);
        p1 = __builtin_amdgcn_mfma_f32_32x32x16_bf16(b1, q, p1, 0, 0, 0);
        if (DQK == 192 && (d0 & 3) == 3) FA_SBAR(); }
}
struct Tiles {
    int nctx_t;
    int ctx_row0;
    int lat_row0;
    int NT;
    __device__ __forceinline__ int krow(int t) const { return t < nctx_t ? ctx_row0 + t * KVBLK : lat_row0 + (t - nctx_t) * KVBLK; }
};
constexpr float NEGM = -1e30f;
template <int MODE> __device__ __forceinline__ void mask_tile(f32x16& p0, f32x16& p1, int t, const Tiles& T, int q_a, int q_b, int k_a, int hi, const float* rpbL) {
    if (MODE == 0 || t < T.nctx_t) return;
    const int tl = t - T.nctx_t;
    if (MODE == 1) {
        const int kb = k_a + tl * KVBLK + 4 * hi - q_a;
#pragma unroll
        for (int r = 0; r < 16; ++r) { const int d0 = kb + (r & 3) + 8 * (r >> 2), d1 = d0 + 32;
            if (d0 > 128 || d0 < -128) p0[r] = NEGM; if (d1 > 128 || d1 < -128) p1[r] = NEGM; }
    } else {
        const int kr = k_a + tl;
        const int rs = min(max(q_a - 4, 0), 128 - 8), cs = min(max(q_b - 8, 0), 64 - 16);
        const bool rok = (kr >= rs) && (kr < rs + 8);
        const float* brow = rpbL + (kr - q_a + 7) * 31 + (15 - q_b);
#pragma unroll
        for (int r = 0; r < 16; ++r) { const int c0 = 4 * hi + (r & 3) + 8 * (r >> 2), c1 = c0 + 32;
            const bool ok0 = rok && c0 >= cs && c0 < cs + 16, ok1 = rok && c1 >= cs && c1 < cs + 16;
            p0[r] = ok0 ? p0[r] + brow[c0] : NEGM; p1[r] = ok1 ? p1[r] + brow[c1] : NEGM;
            if ((r & 3) == 3) asm volatile("" ::: "memory"); }
    }
}

template <int DQK, int SDEPTH, int MODE, int LDQ, int LDK, int LDV>
__device__ __forceinline__ void attn_unit(const bf16_t* __restrict__ Qb, const bf16_t* __restrict__ Kb, const bf16_t* __restrict__ Vb,
                                          bf16_t* __restrict__ Ob, const Tiles T, const float scale, const bool has_sink, const float sink,
                                          const int q_a0, const int k_a, const float* rpbL, char* lds, const int tid_in) {
    constexpr int LDO = DM;
    int tid = tid_in; asm volatile("" : "+v"(tid));
    constexpr int SHM_V = KVBLK * 128 * 2, SHM_K = KVBLK * DQK * 2;
    constexpr int KCH = DQK / 8 * KVBLK / 512;
    const int wid = tid >> 6, lane = tid & 63, r32 = lane & 31, hi = lane >> 5;
    char* V_lds = lds; char* K_lds = lds + 2 * SHM_V;
    float* ws = (float*)(lds + 2 * SHM_V + 2 * SHM_K) + wid * 64; float* li_l = ws; float* al_l = ws + 32;
    const float C = scale * 1.4426950408889634f, thr_raw = THR / scale;
    float m_reg = -1e30f, l_reg = 0; f32x16 o[4] = {}; bf16x8 qr[8];
    const bf16_t* Qw = Qb + (size_t)(wid * QBLK + r32) * LDQ + hi * 8;
#pragma unroll
    for (int d0 = 0; d0 < 8; ++d0) qr[d0] = *reinterpret_cast<const bf16x8*>(Qw + d0 * 16);
    char* qx = lds + 2 * SHM_V + 2 * SHM_K + NW * 256 + wid * 4096 + lane * 16;
    if constexpr (DQK == 192) {
#pragma unroll
        for (int d0 = 8; d0 < 12; ++d0) *(bf16x8*)(qx + (d0 - 8) * 1024) = *reinterpret_cast<const bf16x8*>(Qw + d0 * 16);
    }
    const int sr = tid >> 4, sc = (tid & 15) * 8, vst0 = v_st(sr, sc), vst1 = v_st(32 + sr, sc);
    int krw[KCH], kcb[KCH];
#pragma unroll
    for (int i = 0; i < KCH; ++i) { const int id = tid + 512 * i; krw[i] = id / (DQK / 8); kcb[i] = (id % (DQK / 8)) * 16; }
    const int vb0 = (int)(uintptr_t)V_lds + v_rd_base(lane);
    struct { bf16x8 vs0, vs1, ks[KCH]; } sr_[SDEPTH];
    const char* Vp = (const char*)(Vb + (size_t)sr * LDV + sc);
    const char* Kp[KCH];
#pragma unroll
    for (int c_ = 0; c_ < KCH; ++c_) Kp[c_] = (const char*)Kb + (size_t)krw[c_] * LDK * 2 + kcb[c_];
#define FA_SLOAD(i, t) do { const size_t kr_ = (size_t)T.krow(t); sr_[i].vs0 = *reinterpret_cast<const bf16x8*>(Vp + kr_ * (LDV * 2)); sr_[i].vs1 = *reinterpret_cast<const bf16x8*>(Vp + (kr_ + 32) * (LDV * 2)); \
    _Pragma("unroll") for (int c_ = 0; c_ < KCH; ++c_) sr_[i].ks[c_] = *reinterpret_cast<const bf16x8*>(Kp[c_] + kr_ * (LDK * 2)); } while (0)
#define FA_SWRITE(b, i) do { *(bf16x8*)(V_lds + (b) * SHM_V + vst0) = sr_[i].vs0; *(bf16x8*)(V_lds + (b) * SHM_V + vst1) = sr_[i].vs1; \
    _Pragma("unroll") for (int c_ = 0; c_ < KCH; ++c_) *(bf16x8*)(K_lds + (b) * SHM_K + kswz<DQK>(krw[c_], kcb[c_])) = sr_[i].ks[c_]; } while (0)
#define FA_SWAIT() do { if constexpr (SDEPTH == 2) { if constexpr (KCH == 2) asm volatile("s_waitcnt vmcnt(4)" ::: "memory"); else asm volatile("s_waitcnt vmcnt(5)" ::: "memory"); } else asm volatile("s_waitcnt vmcnt(0)" ::: "memory"); } while (0)
#define FA_RESC(a) do { if (__any((a) < 1.f)) { if (hi == 0) al_l[r32] = (a); asm volatile("s_waitcnt lgkmcnt(0)" ::: "memory"); \
    _Pragma("unroll") for (int d = 0; d < 4; ++d) _Pragma("unroll") for (int r = 0; r < 16; ++r) o[d][r] *= al_l[crow(r, hi)]; } } while (0)
    const int q_a = (MODE == 1) ? q_a0 + wid * QBLK + r32 : q_a0 + ((wid * QBLK + r32) >> 6), q_b = (wid * QBLK + r32) & 63;
#define FA_MASK(P0, P1, t) mask_tile<MODE>(P0, P1, t, T, q_a, q_b, k_a, hi, rpbL)
    f32x16 pA0, pA1, pB0, pB1; float mnA, mnB, alA, alB; bf16x8 pa0, pa1, pa2, pa3; const int NT = T.NT;
    constexpr int SE = 0, SO = SDEPTH - 1;
    FA_SLOAD(SE, 0); asm volatile("s_waitcnt vmcnt(0)" ::: "memory"); FA_SWRITE(0, SE); __syncthreads();
    qkt<DQK>(pA0, pA1, K_lds, qr, qx, r32, hi); FA_MASK(pA0, pA1, 0); partialSM(pA0, pA1, m_reg, mnA, alA, C, thr_raw);
    FA_SLOAD(SO, 1); if constexpr (SDEPTH == 2) { if (2 < NT) FA_SLOAD(SE, 2); }
    FA_SWAIT(); FA_SWRITE(1, SO); __syncthreads();
    for (int j = 1; j + 1 < NT; j += 2) {
        FA_SBAR(); qkt<DQK>(pB0, pB1, K_lds + SHM_K, qr, qx, r32, hi); FA_MASK(pB0, pB1, j);
        finishSM(pA0, pA1, alA, l_reg, pa0, pa1, pa2, pa3); FA_SBAR();
        FA_SLOAD(SO, j + SDEPTH); FA_SBAR();
        pv_d0(o, vb0, pa0, pa1, pa2, pa3); partialSM(pB0, pB1, m_reg, mnB, alB, C, thr_raw);
        __syncthreads(); FA_SWAIT(); FA_SWRITE(0, SE);
        FA_RESC(alB); __syncthreads();
        FA_SBAR(); qkt<DQK>(pA0, pA1, K_lds, qr, qx, r32, hi); FA_MASK(pA0, pA1, j + 1);
        finishSM(pB0, pB1, alB, l_reg, pa0, pa1, pa2, pa3); FA_SBAR();
        if (SDEPTH == 1 || j + 3 < NT) FA_SLOAD(SE, j + 1 + SDEPTH); FA_SBAR();
        pv_d0(o, vb0 + SHM_V, pa0, pa1, pa2, pa3); partialSM(pA0, pA1, m_reg, mnA, alA, C, thr_raw);
        __syncthreads(); FA_SWAIT(); FA_SWRITE(1, SO);
        FA_RESC(alA); __syncthreads();
    }
    FA_SBAR(); qkt<DQK>(pB0, pB1, K_lds + SHM_K, qr, qx, r32, hi); FA_MASK(pB0, pB1, NT - 1);
    finishSM(pA0, pA1, alA, l_reg, pa0, pa1, pa2, pa3); FA_SBAR();
    pv_d0(o, vb0, pa0, pa1, pa2, pa3); partialSM(pB0, pB1, m_reg, mnB, alB, C, thr_raw);
    __syncthreads(); FA_RESC(alB);
    finishSM(pB0, pB1, alB, l_reg, pa0, pa1, pa2, pa3); FA_SBAR();
    pv_d0(o, vb0 + SHM_V, pa0, pa1, pa2, pa3);
    if (has_sink) l_reg += __builtin_amdgcn_exp2f(sink * 1.4426950408889634f - m_reg * C);
    if (hi == 0) li_l[r32] = l_reg; asm volatile("s_waitcnt lgkmcnt(0)" ::: "memory");
    float rli[16];
#pragma unroll
    for (int r = 0; r < 16; ++r) rli[r] = __builtin_amdgcn_rcpf(li_l[crow(r, hi)]);
    __syncthreads();
    int tid2 = tid_in; asm volatile("" : "+v"(tid2));
    const int lane2 = tid2 & 63, wid2 = tid2 >> 6;
    bf16_t* stg = (bf16_t*)(lds + wid2 * (32 * 272));
#pragma unroll
    for (int r = 0; r < 16; ++r) { const int orow = crow(r, hi);
#pragma unroll
        for (int d0 = 0; d0 < 4; ++d0) stg[orow * 136 + d0 * 32 + r32] = (bf16_t)f2bf(o[d0][r] * rli[r]); }
    asm volatile("s_waitcnt lgkmcnt(0)" ::: "memory");
    bf16_t* Ow = Ob + (size_t)(wid2 * QBLK) * LDO;
#pragma unroll
    for (int i = 0; i < 8; ++i) { const int row = i * 4 + (lane2 >> 4), ch = lane2 & 15; const u32x4 v = *(const u32x4*)(stg + row * 136 + ch * 8); *(u32x4*)(Ow + (size_t)row * LDO + ch * 8) = v; }
    __syncthreads();
#undef FA_SLOAD
#undef FA_SWRITE
#undef FA_SWAIT
#undef FA_RESC
#undef FA_MASK
}

template <int LDQ, int LDK, int LDV>
__device__ __forceinline__ void attn_unit_sp192(const bf16_t* __restrict__ Qb, const bf16_t* __restrict__ Kb, const bf16_t* __restrict__ Vb, bf16_t* __restrict__ Ob, const Tiles T, const float scale, char* lds, const int tid_in) {
    constexpr int DQK = 192, LDO = DM, SHM_V = KVBLK * 128 * 2, SHM_K = KVBLK * DQK * 2, KCH = 3;
    int tid = tid_in; asm volatile("" : "+v"(tid));
    const int wid = tid >> 6, lane = tid & 63, r32 = lane & 31, hi = lane >> 5;
    char* V_lds = lds; char* K_lds = lds + 2 * SHM_V;
    float* ws = (float*)(lds + 2 * SHM_V + 2 * SHM_K) + wid * 64; float* li_l = ws; float* al_l = ws + 32;
    const float C = scale * 1.4426950408889634f, thr_raw = THR / scale;
    float m_reg = -1e30f, l_reg = 0; f32x16 o[4] = {}; bf16x8 qr[12];
    const bf16_t* Qw = Qb + (size_t)(wid * QBLK + r32) * LDQ + hi * 8;
#pragma unroll
    for (int d0 = 0; d0 < 12; ++d0) qr[d0] = *reinterpret_cast<const bf16x8*>(Qw + d0 * 16);
    const int sr = tid >> 4, sc = (tid & 15) * 8, vst0 = v_st(sr, sc), vst1 = v_st(32 + sr, sc);
    int krw[KCH], kcb[KCH];
#pragma unroll
    for (int i = 0; i < KCH; ++i) { const int id = tid + 512 * i; krw[i] = id / 24; kcb[i] = (id % 24) * 16; }
    const int vb0 = (int)(uintptr_t)V_lds + v_rd_base(lane);
    const char* Vp = (const char*)(Vb + (size_t)sr * LDV + sc);
    const char* Kp[KCH];
#pragma unroll
    for (int c_ = 0; c_ < KCH; ++c_) Kp[c_] = (const char*)Kb + (size_t)krw[c_] * LDK * 2 + kcb[c_];
    bf16x8 vs0, vs1, ks[KCH];
#define FB_SLOAD(t) do { const size_t kr_ = (size_t)T.krow(t); vs0 = *reinterpret_cast<const bf16x8*>(Vp + kr_ * (LDV * 2)); vs1 = *reinterpret_cast<const bf16x8*>(Vp + (kr_ + 32) * (LDV * 2)); \
    _Pragma("unroll") for (int c_ = 0; c_ < KCH; ++c_) ks[c_] = *reinterpret_cast<const bf16x8*>(Kp[c_] + kr_ * (LDK * 2)); } while (0)
#define FB_SWRITE(b) do { *(bf16x8*)(V_lds + (b) * SHM_V + vst0) = vs0; *(bf16x8*)(V_lds + (b) * SHM_V + vst1) = vs1; \
    _Pragma("unroll") for (int c_ = 0; c_ < KCH; ++c_) *(bf16x8*)(K_lds + (b) * SHM_K + kswz<DQK>(krw[c_], kcb[c_])) = ks[c_]; } while (0)
    const int NT = T.NT;
    FB_SLOAD(0); asm volatile("s_waitcnt vmcnt(0)" ::: "memory"); FB_SWRITE(0); __syncthreads();
    for (int j = 0; j < NT; ++j) {
        const int b = j & 1;
        if (j + 1 < NT) FB_SLOAD(j + 1);
        __builtin_amdgcn_sched_barrier(0);
        f32x16 p0 = f32x16{}, p1 = f32x16{};
        { const char* Ks = K_lds + b * SHM_K;
#pragma unroll
          for (int d0 = 0; d0 < 12; ++d0) { const int cb = (d0 * 16 + hi * 8) * 2;
              const bf16x8 b0 = *reinterpret_cast<const bf16x8*>(Ks + kswz<DQK>(r32, cb));
              const bf16x8 b1 = *reinterpret_cast<const bf16x8*>(Ks + kswz<DQK>(32 + r32, cb));
              p0 = __builtin_amdgcn_mfma_f32_32x32x16_bf16(b0, qr[d0], p0, 0, 0, 0);
              p1 = __builtin_amdgcn_mfma_f32_32x32x16_bf16(b1, qr[d0], p1, 0, 0, 0); } }
        float mn, al; bf16x8 pa0, pa1, pa2, pa3;
        partialSM(p0, p1, m_reg, mn, al, C, thr_raw);
        if (__any(al < 1.f)) { if (hi == 0) al_l[r32] = al; asm volatile("s_waitcnt lgkmcnt(0)" ::: "memory");
#pragma unroll
            for (int d = 0; d < 4; ++d)
#pragma unroll
                for (int r = 0; r < 16; ++r) o[d][r] *= al_l[crow(r, hi)]; }
        finishSM(p0, p1, al, l_reg, pa0, pa1, pa2, pa3);
        __builtin_amdgcn_sched_barrier(0);
        pv_d0(o, vb0 + b * SHM_V, pa0, pa1, pa2, pa3);
        if (j + 1 < NT) { asm volatile("s_waitcnt vmcnt(0)" ::: "memory"); FB_SWRITE(b ^ 1); }
        __syncthreads();
    }
    if (hi == 0) li_l[r32] = l_reg; asm volatile("s_waitcnt lgkmcnt(0)" ::: "memory");
    float rli[16];
#pragma unroll
    for (int r = 0; r < 16; ++r) rli[r] = __builtin_amdgcn_rcpf(li_l[crow(r, hi)]);
    __syncthreads();
    int tid2 = tid_in; asm volatile("" : "+v"(tid2));
    const int lane2 = tid2 & 63, wid2 = tid2 >> 6;
    bf16_t* stg = (bf16_t*)(lds + wid2 * (32 * 272));
#pragma unroll
    for (int r = 0; r < 16; ++r) { const int orow = crow(r, hi);
#pragma unroll
        for (int d0 = 0; d0 < 4; ++d0) stg[orow * 136 + d0 * 32 + r32] = (bf16_t)f2bf(o[d0][r] * rli[r]); }
    asm volatile("s_waitcnt lgkmcnt(0)" ::: "memory");
    bf16_t* Ow = Ob + (size_t)(wid2 * QBLK) * LDO;
#pragma unroll
    for (int i = 0; i < 8; ++i) { const int row = i * 4 + (lane2 >> 4), ch = lane2 & 15; const u32x4 v = *(const u32x4*)(stg + row * 136 + ch * 8); *(u32x4*)(Ow + (size_t)row * LDO + ch * 8) = v; }
    __syncthreads();
#undef FB_SLOAD
#undef FB_SWRITE
}
#undef FA_SBAR
}

namespace fa8 {
typedef int v8i_t __attribute__((ext_vector_type(8)));
typedef int v4i_t __attribute__((ext_vector_type(4)));
using fa::f32x16; using fa::crow;
constexpr int VP = 80;
constexpr float THR8 = 3.f, POFF = 4.f;
struct Tiles8 {
    int nctx_t, ctx_row0, lat_row0, NT, vk_lat0;
    __device__ __forceinline__ int krow(int t) const { return t < nctx_t ? ctx_row0 + t * 64 : lat_row0 + (t - nctx_t) * 64; }
    __device__ __forceinline__ int vkey(int t) const { return t < nctx_t ? t * 64 : vk_lat0 + (t - nctx_t) * 64; }
};
#define FA8_SBAR() __builtin_amdgcn_sched_barrier(0)
#define FA8_MFMA(a, b, c) __builtin_amdgcn_mfma_scale_f32_32x32x64_f8f6f4(a, b, c, 0, 0, 0, 0x7f7f7f7f, 0, 0x7f7f7f7f)
#define FA8_LD32(p) __builtin_shufflevector(*(const v4i_t*)(p), *(const v4i_t*)((p) + 16), 0, 1, 2, 3, 4, 5, 6, 7)
#define FA8_MX3(a, b, c) __builtin_fmaxf(__builtin_fmaxf((a), (b)), (c))
typedef short v2s_t __attribute__((ext_vector_type(2)));
template <bool FIRST>
__device__ __forceinline__ void partialSM8(f32x16& p0, f32x16& p1, float& m_reg, float& alpha, float& scl, const float thr2) {
    float pa_ = FA8_MX3(p0[0], p0[1], p1[0]), pb_ = FA8_MX3(p0[2], p0[3], p1[1]); pa_ = FA8_MX3(pa_, p1[2], p1[3]);
#pragma unroll
    for (int r = 4; r < 16; r += 4) { pa_ = FA8_MX3(pa_, p0[r], p0[r + 1]); pb_ = FA8_MX3(pb_, p0[r + 2], p0[r + 3]); pa_ = FA8_MX3(pa_, p1[r], p1[r + 1]); pb_ = FA8_MX3(pb_, p1[r + 2], p1[r + 3]); }
    float pmax = __builtin_fmaxf(pa_, pb_);
    { auto rr = __builtin_amdgcn_permlane32_swap(__float_as_uint(pmax), __float_as_uint(pmax), false, false); pmax = fmaxf(__uint_as_float(rr[0]), __uint_as_float(rr[1])); }
    if (!FIRST && __builtin_expect(__all(pmax - m_reg <= thr2), 1)) { alpha = 1.f; }
    else {
        const float mn = (FIRST || pmax - m_reg > thr2) ? __builtin_ceilf(pmax) : m_reg;
        alpha = FIRST ? 0.f : __builtin_ldexpf(1.0f, (int)(m_reg - mn));
        m_reg = mn;
        scl = __builtin_ldexpf(1.0f, SCL_DIV ? (int)(mn - POFF) : (int)(POFF - mn));
    }
#if VALU_PROBE
#pragma unroll
    for (int r = 0; r < 16; ++r) { asm volatile("v_mul_f32 %0, 1.0, %0" : "+v"(p0[r])); asm volatile("v_mul_f32 %0, 1.0, %0" : "+v"(p1[r])); }
#endif
#pragma unroll
    for (int r = 0; r < 16; ++r) p0[r] = __builtin_amdgcn_exp2f(p0[r]);
}
__device__ __forceinline__ void finishSM8(f32x16& p0, f32x16& p1, float& l_reg, v8i_t& pa, const float scl) {
#pragma unroll
    for (int r = 0; r < 16; ++r) p1[r] = __builtin_amdgcn_exp2f(p1[r]);
    float ps = 0;
#pragma unroll
    for (int r = 0; r < 16; ++r) ps += p0[r];
#pragma unroll
    for (int r = 0; r < 16; ++r) ps += p1[r];
    { auto rr = __builtin_amdgcn_permlane32_swap(__float_as_uint(ps), __float_as_uint(ps), false, false); ps = __uint_as_float(rr[0]) + __uint_as_float(rr[1]); }
    l_reg += ps;
#pragma unroll
    for (int k = 0; k < 4; ++k) { v2s_t w = __builtin_bit_cast(v2s_t, p0[4 * k]);
        w = __builtin_amdgcn_cvt_scalef32_pk_fp8_f32(w, p0[4 * k], p0[4 * k + 1], scl, false); w = __builtin_amdgcn_cvt_scalef32_pk_fp8_f32(w, p0[4 * k + 2], p0[4 * k + 3], scl, true); pa[k] = __builtin_bit_cast(int, w); }
#pragma unroll
    for (int k = 0; k < 4; ++k) { v2s_t w = __builtin_bit_cast(v2s_t, p1[4 * k]);
        w = __builtin_amdgcn_cvt_scalef32_pk_fp8_f32(w, p1[4 * k], p1[4 * k + 1], scl, false); w = __builtin_amdgcn_cvt_scalef32_pk_fp8_f32(w, p1[4 * k + 2], p1[4 * k + 3], scl, true); pa[4 + k] = __builtin_bit_cast(int, w); }
}
template <int DQK> __device__ __forceinline__ void qkt8(f32x16& p0, f32x16& p1, const char* Ks, const v8i_t* qf, int r32, int hi) {
    constexpr int KP = DQK + 16;
    p0 = f32x16{}; p1 = f32x16{};
#pragma unroll
    for (int c = 0; c < DQK / 64; ++c) {
        const v8i_t a0 = FA8_LD32(Ks + r32 * KP + c * 64 + hi * 32);
        const v8i_t a1 = FA8_LD32(Ks + (32 + r32) * KP + c * 64 + hi * 32);
        p0 = FA8_MFMA(a0, qf[c], p0);
        p1 = FA8_MFMA(a1, qf[c], p1); }
}
__device__ __forceinline__ void pv8(f32x16* o, const char* Vs, const v8i_t pa, int r32, int hi) {
#pragma unroll
    for (int n = 0; n < 4; ++n) { const v8i_t b = FA8_LD32(Vs + (32 * n + r32) * VP + hi * 32); o[n] = FA8_MFMA(pa, b, o[n]); }
}

template <int DQK, int SDEPTH, int MODE>
__device__ __forceinline__ void attn_unit8(const unsigned char* __restrict__ Qb, const unsigned char* __restrict__ Kb, const unsigned char* __restrict__ Vt, bf16_t* __restrict__ Ob,
                                           const Tiles8 T, const float scale, const bool has_sink, const float sink, const int q_a0, const int k_a, const float* rpbL, char* lds, const int tid_in) {
    constexpr int LDO = DM, KP = DQK + 16, SHM_K = 64 * KP, SHM_V = 128 * VP;
    int tid = tid_in; asm volatile("" : "+v"(tid));
    const int wid = tid >> 6, lane = tid & 63, r32 = lane & 31, hi = lane >> 5;
    char* K_lds = lds; char* V_lds = lds + 3 * SHM_K;
    float* ws = (float*)(lds + 3 * SHM_K + 3 * SHM_V) + wid * 64; float* li_l = ws; float* al_l = ws + 32;
    const float thr2 = THR8 * 1.4426950408889634f;
    float m_reg = 0.f, l_reg = 0, scl = 1.f; f32x16 o[4] = {}; v8i_t qf[DQK / 64];
    { const unsigned char* Qw = Qb + (size_t)(wid * 32 + r32) * Q8P + hi * 32;
#pragma unroll
      for (int c = 0; c < DQK / 64; ++c) qf[c] = FA8_LD32(Qw + c * 64); }
    constexpr int PS = (DQK == 128) ? 16 : 8, PPR = DQK / PS, KCH = 64 * PPR / 512;
    typedef unsigned kpiece_t __attribute__((ext_vector_type(PS / 4)));
    const int krow_ = (tid * KCH) / PPR, kpc_ = (tid * KCH) % PPR; const int kdst0 = krow_ * KP + kpc_ * PS; const unsigned char* Kp0 = Kb + (size_t)krow_ * K8P + kpc_ * PS;
    const int vdst = (tid >> 2) * VP + (tid & 3) * 16; const unsigned char* Vp = Vt + (size_t)(tid >> 2) * VTP + (tid & 3) * 16;
    struct { kpiece_t ks[KCH]; u32x4 vs; } sr_[SDEPTH];
#define FA8_SLOAD(i, t) do { const size_t kr_ = (size_t)T.krow(t); const int vk_ = T.vkey(t); sr_[i].vs = *(const u32x4*)(Vp + vk_); \
    _Pragma("unroll") for (int c_ = 0; c_ < KCH; ++c_) sr_[i].ks[c_] = *(const kpiece_t*)(Kp0 + kr_ * K8P + c_ * PS); } while (0)
#define FA8_SWRITE(b, i) do { *(u32x4*)(V_lds + (b) * SHM_V + vdst) = sr_[i].vs; \
    _Pragma("unroll") for (int c_ = 0; c_ < KCH; ++c_) *(kpiece_t*)(K_lds + (b) * SHM_K + kdst0 + c_ * PS) = sr_[i].ks[c_]; } while (0)
#define FA8_SWAIT() do { if constexpr (KCH == 1) asm volatile("s_waitcnt vmcnt(2)" ::: "memory"); else asm volatile("s_waitcnt vmcnt(4)" ::: "memory"); } while (0)
#define FA8_RESC(a) do { if (__any((a) < 1.f)) { if (hi == 0) al_l[r32] = (a); asm volatile("s_waitcnt lgkmcnt(0)" ::: "memory"); \
    _Pragma("unroll") for (int d = 0; d < 4; ++d) _Pragma("unroll") for (int r = 0; r < 16; ++r) o[d][r] *= al_l[crow(r, hi)]; } } while (0)
    const int q_a = (MODE == 1) ? q_a0 + wid * 32 + r32 : q_a0 + ((wid * 32 + r32) >> 6), q_b = (wid * 32 + r32) & 63;
    const fa::Tiles TM{T.nctx_t, 0, 0, T.NT};
#define FA8_MASK(P0, P1, t) fa::mask_tile<MODE>(P0, P1, t, TM, q_a, q_b, k_a, hi, rpbL)
    f32x16 pA0, pA1, pB0, pB1; float alA, alB; v8i_t pa; const int NT = T.NT;
    constexpr int SE = 0, SO = SDEPTH - 1;
    static_assert(SDEPTH == 2, "the three-slot ring is written for two-deep register staging");
    FA8_SLOAD(SE, 0); asm volatile("s_waitcnt vmcnt(0)" ::: "memory"); FA8_SWRITE(0, SE); __syncthreads();
    qkt8<DQK>(pA0, pA1, K_lds, qf, r32, hi); FA8_MASK(pA0, pA1, 0); partialSM8<true>(pA0, pA1, m_reg, alA, scl, thr2);
    FA8_SLOAD(SO, 1); if (2 < NT) FA8_SLOAD(SE, 2);
    FA8_SWAIT(); FA8_SWRITE(1, SO); __syncthreads();
    int s_m = 0, s_c = 1, s_p = 2;
    for (int j = 1; j + 1 < NT; j += 2) {
        FA8_SBAR(); qkt8<DQK>(pB0, pB1, K_lds + s_c * SHM_K, qf, r32, hi); FA8_MASK(pB0, pB1, j);
        finishSM8(pA0, pA1, l_reg, pa, scl); FA8_SBAR();
        FA8_SLOAD(SO, j + 2); FA8_SBAR();
        pv8(o, V_lds + s_m * SHM_V, pa, r32, hi); partialSM8<false>(pB0, pB1, m_reg, alB, scl, thr2);
        FA8_SWAIT(); FA8_SWRITE(s_p, SE);
        FA8_RESC(alB); __syncthreads();
        FA8_SBAR(); qkt8<DQK>(pA0, pA1, K_lds + s_p * SHM_K, qf, r32, hi); FA8_MASK(pA0, pA1, j + 1);
        finishSM8(pB0, pB1, l_reg, pa, scl); FA8_SBAR();
        if (j + 3 < NT) FA8_SLOAD(SE, j + 3); FA8_SBAR();
        pv8(o, V_lds + s_c * SHM_V, pa, r32, hi); partialSM8<false>(pA0, pA1, m_reg, alA, scl, thr2);
        FA8_SWAIT(); FA8_SWRITE(s_m, SO);
        FA8_RESC(alA); __syncthreads();
        { const int t0 = s_m; s_m = s_p; s_p = s_c; s_c = t0; }
    }
    FA8_SBAR(); qkt8<DQK>(pB0, pB1, K_lds + s_c * SHM_K, qf, r32, hi); FA8_MASK(pB0, pB1, NT - 1);
    finishSM8(pA0, pA1, l_reg, pa, scl); FA8_SBAR();
    pv8(o, V_lds + s_m * SHM_V, pa, r32, hi); partialSM8<false>(pB0, pB1, m_reg, alB, scl, thr2);
    FA8_RESC(alB);
    finishSM8(pB0, pB1, l_reg, pa, scl); FA8_SBAR();
    pv8(o, V_lds + s_c * SHM_V, pa, r32, hi);
    if (has_sink) l_reg += __builtin_amdgcn_exp2f(sink * 1.4426950408889634f);
    l_reg = SCL_DIV ? l_reg * __builtin_amdgcn_rcpf(scl) : l_reg * scl;
    if (hi == 0) li_l[r32] = l_reg; asm volatile("s_waitcnt lgkmcnt(0)" ::: "memory");
    float rli[16];
#pragma unroll
    for (int r = 0; r < 16; ++r) rli[r] = __builtin_amdgcn_rcpf(li_l[crow(r, hi)]);
    __syncthreads();
    int tid2 = tid_in; asm volatile("" : "+v"(tid2));
    const int lane2 = tid2 & 63, wid2 = tid2 >> 6;
    unsigned char* stg = (unsigned char*)(lds + wid2 * (32 * 144));
#pragma unroll
    for (int r = 0; r < 16; ++r) { const int orow = crow(r, hi); const float sc_ = rli[r] * OUT_SCALE;
#pragma unroll
        for (int d0 = 0; d0 < 4; d0 += 2) { int w = 0; w = cvt8s(o[d0][r] * sc_, o[d0 + 1][r] * sc_, w, false);
            stg[orow * 144 + d0 * 32 + r32] = (unsigned char)w; stg[orow * 144 + (d0 + 1) * 32 + r32] = (unsigned char)(w >> 8); } }
    asm volatile("s_waitcnt lgkmcnt(0)" ::: "memory");
    unsigned char* Ow = (unsigned char*)Ob + (size_t)(wid2 * 32) * LDO;
#pragma unroll
    for (int i = 0; i < 4; ++i) { const int row = i * 8 + (lane2 >> 3), ch = lane2 & 7; const u32x4 v = *(const u32x4*)(stg + row * 144 + ch * 16); *(u32x4*)(Ow + (size_t)row * LDO + ch * 16) = v; }
    __syncthreads();
#undef FA8_SLOAD
#undef FA8_SWRITE
#undef FA8_SWAIT
#undef FA8_RESC
#undef FA8_MASK
}
#undef FA8_SBAR
}

#define XCDU(u) ((((u) & 7) << 5) | (((u) >> 3) & 31))
__device__ __forceinline__ void ph_fattn8(Frame& F, int l) {
    unsigned char* OUTS = F.ws + WS_OUTS;
    const unsigned char* Q8 = F.ws + WS_Q8; const unsigned char* K8 = F.ws + WS_K8; const unsigned char* V8T = F.ws + WS_V8T;
    char* lds = (char*)(unsigned char*)F.lds;
    float* rpbL = (float*)(lds + 120 * 1024);
    {
        const float* rpb = F.in(22) + (size_t)l * 4 * 15 * 31;
        for (int i = F.tid; i < 4 * 15 * 31; i += NTHREADS) rpbL[i] = rpb[i] * 1.4426950408889634f;
        __syncthreads();
    }
    const float sc128 = 0.08838834764831845f, sc192 = 0.07216878364870323f;
    const int nctxu = (l == 0) ? 8 : 0;
    if (FA_SEL & 1) for (int u = F.bid; u < 256 + nctxu; u += F.G) {
        launder(F);
        const bool cq = u >= 256; const int v = cq ? u - 256 : XCDU(u), b = cq ? (v >> 2) : (v >> 7), h = cq ? (v & 3) : ((v >> 5) & 3), r0 = cq ? TL + b * NCTX : b * SEQ + (v & 31) * 256;
        fa8::Tiles8 T{4, TL + b * NCTX, b * SEQ, cq ? 4 : 132, 256};
        fa8::attn_unit8<192, 2, 0>(Q8 + (size_t)r0 * Q8P + Q8_M + h * 192, K8 + K8_M + h * 192, V8T + (size_t)((8 + h) * 2 + b) * 128 * VTP, (bf16_t*)(OUTS + (size_t)r0 * DM + 512 + h * 128), T, sc192,
                                   false, 0.f, 0, 0, nullptr, lds, F.tid);
    }
    if (FA_SEL & 2) for (int u = F.bid; u < 256 + 3 * nctxu; u += F.G) {
        launder(F);
        const bool cq = u >= 256; const int v = cq ? u - 256 : XCDU(u);
        const int mx = cq ? ((v >> 3) == 0 ? 0 : (v >> 3) + 1) : 0, b = cq ? ((v >> 2) & 1) : (v >> 7), h = cq ? (v & 3) : ((v >> 5) & 3), r0 = cq ? TL + b * NCTX : b * SEQ + (v & 31) * 256;
        const int qo = mx == 0 ? Q8_A : (mx == 2 ? Q8_W : Q8_N), ko = mx == 0 ? K8_A : (mx == 2 ? K8_W : K8_N), kvh = (mx == 3) ? h : (h >> 1), hidx = (mx == 0 ? 0 : (mx == 2 ? 2 : 4)) + kvh;
        fa8::Tiles8 T{4, TL + b * NCTX, b * SEQ, cq ? 4 : 132, 256};
        fa8::attn_unit8<128, 2, 0>(Q8 + (size_t)r0 * Q8P + qo + h * 128, K8 + ko + kvh * 128, V8T + (size_t)(hidx * 2 + b) * 128 * VTP, (bf16_t*)(OUTS + (size_t)r0 * DM + mx * 512 + h * 128), T, sc128,
                                   mx == 2, F.in(21)[l * 4 + h], 0, 0, nullptr, lds, F.tid);
    }
    if (FA_SEL & 4) for (int u = F.bid; u < 256; u += F.G) {
        launder(F);
        const int uu = XCDU(u), b = uu >> 7, h = (uu >> 5) & 3, qb = uu & 31, r0 = b * SEQ + qb * 256;
        const int q0 = qb * 256, k0 = max(q0 - 128, 0), k1 = min(q0 + 384, SEQ);
        fa8::Tiles8 T{4, TL + b * NCTX, b * SEQ + k0, 4 + (k1 - k0) / 64, 256 + k0};
        fa8::attn_unit8<128, 2, 1>(Q8 + (size_t)r0 * Q8P + Q8_W + h * 128, K8 + K8_W + (h >> 1) * 128, V8T + (size_t)((2 + (h >> 1)) * 2 + b) * 128 * VTP, (bf16_t*)(OUTS + (size_t)r0 * DM + 2 * 512 + h * 128), T, sc128,
                                   true, F.in(21)[l * 4 + h], q0, k0, nullptr, lds, F.tid);
    }
    if (FA_SEL & 8) for (int u = F.bid; u < 256; u += F.G) {
        launder(F);
        const int uu = XCDU(u), b = uu >> 7, h = (uu >> 5) & 3, qb = uu & 31, r0 = b * SEQ + qb * 256;
        const int g0 = qb * 4, ks = min(max(g0 - 4, 0), 120), ke = min(max(g0 + 3 - 4, 0), 120) + 8;
        int nt = ke - ks; nt += (nt & 1);
        const int ks2 = (ks + nt > 128) ? 128 - nt : ks;
        fa8::Tiles8 T{4, TL + b * NCTX, b * SEQ + ks2 * 64, 4 + nt, 256 + ks2 * 64};
        fa8::attn_unit8<128, 2, 2>(Q8 + (size_t)r0 * Q8P + Q8_N + h * 128, K8 + K8_N + h * 128, V8T + (size_t)((4 + h) * 2 + b) * 128 * VTP, (bf16_t*)(OUTS + (size_t)r0 * DM + 3 * 512 + h * 128), T, sc128,
                                   false, 0.f, g0, ks2, rpbL + h * 465, lds, F.tid);
    }
}

__device__ __forceinline__ void ph_fattn(Frame& F, int l) {
    const bf16_t* PROJ = (const bf16_t*)(F.ws + WS_PROJ);
    bf16_t* OUTS = (bf16_t*)(F.ws + WS_OUTS);
    char* lds = (char*)(unsigned char*)F.lds;
    float* rpbL = (float*)(lds + 120 * 1024);
    {
        const float* rpb = F.in(22) + (size_t)l * 4 * 15 * 31;
        for (int i = F.tid; i < 4 * 15 * 31; i += NTHREADS) rpbL[i] = rpb[i] * 11.313708498984761f;
        __syncthreads();
    }
    const float sc128 = 0.08838834764831845f, sc192 = 0.07216878364870323f;
    const int nctxu = (l == 0) ? 8 : 0;
    if (FA_SEL & 1) for (int u = F.bid; u < 256 + nctxu; u += F.G) {
        launder(F);
        const bool cq = u >= 256; const int v = cq ? u - 256 : u, b = cq ? (v >> 2) : (v >> 7), h = cq ? (v & 3) : ((v >> 5) & 3), r0 = cq ? TL + b * NCTX : b * SEQ + (v & 31) * 256;
        fa::Tiles T{4, TL + b * NCTX, b * SEQ, cq ? 4 : 132};
        fa::attn_unit_sp192<768, 768, 1024>((const bf16_t*)(F.ws + WS_MQ) + (size_t)r0 * 768 + h * 192, (const bf16_t*)(F.ws + WS_MK) + h * 192, (const bf16_t*)(F.ws + WS_MKV) + h * 256 + 128,
                                            OUTS + (size_t)r0 * DM + 512 + h * 128, T, sc192, lds, F.tid);
    }
    if (FA_SEL & 2) for (int u = F.bid; u < 256 + 3 * nctxu; u += F.G) {
        launder(F);
        const bool cq = u >= 256; const int v = cq ? u - 256 : u;
        const int mx = cq ? ((v >> 3) == 0 ? 0 : (v >> 3) + 1) : 0, b = cq ? ((v >> 2) & 1) : (v >> 7), h = cq ? (v & 3) : ((v >> 5) & 3), r0 = cq ? TL + b * NCTX : b * SEQ + (v & 31) * 256;
        const int cqo = mx == 0 ? C_AQ : (mx == 2 ? C_WQ : C_NQ), cko = mx == 0 ? C_AK : (mx == 2 ? C_WK : C_NK), cvo = mx == 0 ? C_AV : (mx == 2 ? C_WV : C_NV), kvh = (mx == 3) ? h : (h >> 1);
        fa::Tiles T{4, TL + b * NCTX, b * SEQ, cq ? 4 : 132};
        fa::attn_unit<128, 1, 0, PP, PP, PP>(PROJ + (size_t)r0 * PP + cqo + h * 128, PROJ + cko + kvh * 128, PROJ + cvo + kvh * 128, OUTS + (size_t)r0 * DM + mx * 512 + h * 128, T, sc128,
                                             mx == 2, F.in(21)[l * 4 + h], 0, 0, nullptr, lds, F.tid);
    }
    if (FA_SEL & 4) for (int u = F.bid; u < 256; u += F.G) {
        launder(F);
        const int uu = XCDU(u), b = uu >> 7, h = (uu >> 5) & 3, qb = uu & 31, r0 = b * SEQ + qb * 256;
        const int q0 = qb * 256, k0 = max(q0 - 128, 0), k1 = min(q0 + 384, SEQ);
        fa::Tiles T{4, TL + b * NCTX, b * SEQ + k0, 4 + (k1 - k0) / 64};
        fa::attn_unit<128, 1, 1, PP, PP, PP>(PROJ + (size_t)r0 * PP + C_WQ + h * 128, PROJ + C_WK + (h >> 1) * 128, PROJ + C_WV + (h >> 1) * 128, OUTS + (size_t)r0 * DM + 2 * 512 + h * 128, T, sc128,
                                             true, F.in(21)[l * 4 + h], q0, k0, nullptr, lds, F.tid);
    }
    if (FA_SEL & 8) for (int u = F.bid; u < 256; u += F.G) {
        launder(F);
        const int b = u >> 7, h = (u >> 5) & 3, qb = u & 31, r0 = b * SEQ + qb * 256;
        const int g0 = qb * 4, ks = min(max(g0 - 4, 0), 120), ke = min(max(g0 + 3 - 4, 0), 120) + 8;
        int nt = ke - ks; nt += (nt & 1);
        const int ks2 = (ks + nt > 128) ? 128 - nt : ks;
        fa::Tiles T{4, TL + b * NCTX, b * SEQ + ks2 * 64, 4 + nt};
        fa::attn_unit<128, 1, 2, PP, PP, PP>(PROJ + (size_t)r0 * PP + C_NQ + h * 128, PROJ + C_NK + h * 128, PROJ + C_NV + h * 128, OUTS + (size_t)r0 * DM + 3 * 512 + h * 128, T, sc128,
                                             false, 0.f, g0, ks2, rpbL + h * 465, lds, F.tid);
    }
}

__device__ __forceinline__ void ph_fgemm_bf16(Frame& F, const bf16_t* A, int lda, const bf16_t* Bt, int K, int M, int N, bf16_t* C, int ldc) {
    pg8::SchedPlain S{(const char*)A, (const char*)Bt, lda, K, M / 256, N / 256, F.G, F.bid, 1 << 30, 0};
    pg8::EpiBf16 E{C, ldc, 1.0f};
    pg8::gemm_phase<pg8::EpiBf16, pg8::SchedPlain, false>(F.lds, F.tid, lda, K, K, S, E);
}
__device__ __forceinline__ void ph_fg1_fp8(Frame& F, int l) {
    pg8::SchedPlain S{(const char*)(F.ws + WS_H8), (const char*)(F.ws + WS_W + (size_t)l * WL_STRIDE + WO_IN), DM / 2, DM / 2, TT / 256, PP / 256, F.G, F.bid, 1 << 30, 0};
    pg8::EpiBf16 E{(bf16_t*)(F.ws + WS_PROJ), PP, 1.0f / GATE_WSCALE};
    pg8::gemm_phase<pg8::EpiBf16, pg8::SchedPlain, false, true>(F.lds, F.tid, DM / 2, DM / 2, DM / 2, S, E);
}
__device__ __forceinline__ void ph_fmla_up(Frame& F, int l) {
    pg8::SchedPlain S{(const char*)(F.ws + WS_MK), (const char*)(F.ws + WS_W + (size_t)l * WL_STRIDE + WO_UQ), MCP / 2, 256, TT / 256, MQP / 256, F.G, F.bid, 4, 128};
    pg8::EpiBf16 E{(bf16_t*)(F.ws + WS_MQ), MQP, 1.0f / GATE_WSCALE};
    pg8::gemm_phase<pg8::EpiBf16, pg8::SchedPlain, false, true>(F.lds, F.tid, MCP / 2, 256, 256, S, E);
}
__device__ __forceinline__ void ph_fout(Frame& F, int l) {
    const int M = (l == 0) ? TT : TL;
    const unsigned char* Wt = F.ws + WS_W + (size_t)l * WL_STRIDE + WO_O;
    pg8::SchedPlain S{(const char*)(F.ws + WS_ACC), (const char*)Wt, DM / 2, DM / 2, M / 256, DM / 256, F.G, F.bid, 1 << 30, 0};
    pg8::EpiResid E{l == 0 ? F.in(0) : F.out, l == 0 ? F.in(2) : (const float*)(F.ws + WS_XC), F.out, (float*)(F.ws + WS_XC), (const float*)(F.ws + WS_MOD) + (size_t)l * 3 * 6 * DM, 2, 1.0f / (ACC_SCALE * GATE_WSCALE)};
    pg8::gemm_phase<pg8::EpiResid, pg8::SchedPlain, false, true>(F.lds, F.tid, DM / 2, DM / 2, DM / 2, S, E);
}

constexpr int LDS_BYTES = 147456;
constexpr int MISC_OFF = 131072 + 320;
constexpr int N_PHASES = 1 + 12 * DEPTH + 1;

__global__ void __launch_bounds__(NTHREADS, 2) mega(Args args) {
    extern __shared__ __attribute__((aligned(16))) unsigned char lds[];
    Frame F;
    F.lds = (LAS unsigned char*)lds; F.out = args.out; F.ws = args.ws;
    F.tid = threadIdx.x; F.lane = F.tid & 63; F.wave = __builtin_amdgcn_readfirstlane(F.tid >> 6); F.G = gridDim.x; F.bid = blockIdx.x;
    volatile LAS unsigned* MISC = (volatile LAS unsigned*)(F.lds + MISC_OFF);
    if (F.tid < 32) MISC[F.tid] = 0u;
    __syncthreads();
    XcdBarrier bar; bar.bar = (unsigned*)(F.ws + WS_CTL) + CW_BAR; bar.x = 0; bar.st = nullptr;
    if (args.ph_hi - args.ph_lo > 1) bar = xcd_barrier_post((unsigned*)(F.ws + WS_CTL) + CW_BAR, MISC + 8, F.tid);
#if CLK_PROBE == 6
    if (F.bid == 0 && F.tid == 0) MISC[17] = (unsigned)__builtin_amdgcn_s_memrealtime();
#endif
#define IN(k) (launder(F), lo <= (k) && (k) < hi)
#if CLK_PROBE == 6
#define SEAM(k) do { if (IN(k) && IN((k) + 1)) xcd_barrier(bar, F.tid); if (F.bid == 0 && F.tid == 0) { const unsigned now_ = (unsigned)__builtin_amdgcn_s_memrealtime(); \
        if ((k) == PROBE_PH || (k) == PROBE_PH + 12) MISC[19] += now_ - MISC[17]; MISC[17] = now_; } } while (0)
#else
#define SEAM(k) do { if (IN(k) && IN((k) + 1)) xcd_barrier(bar, F.tid); } while (0)
#endif
#if CLK_PROBE >= 3 && CLK_PROBE <= 5
#define CLKP_BEGIN(l) do { if ((l) == 0 && F.bid == 0 && F.tid == 0) { MISC[20] = 1u; } } while (0)
#define CLKP_END(l) do { if ((l) == 0 && F.bid == 0 && F.tid == 0) { MISC[20] = 0u; } } while (0)
#elif CLK_PROBE && CLK_PROBE != 6
#define CLKP_BEGIN(l) do { if ((l) == 0 && F.bid == 0 && F.tid == 0) { MISC[16] = (unsigned)__builtin_readcyclecounter(); MISC[17] = (unsigned)__builtin_amdgcn_s_memrealtime(); } } while (0)
#define CLKP_END(l) do { if ((l) == 0 && F.bid == 0 && F.tid == 0) { MISC[18] = (unsigned)__builtin_readcyclecounter() - MISC[16]; MISC[19] = (unsigned)__builtin_amdgcn_s_memrealtime() - MISC[17]; } } while (0)
#else
#define CLKP_BEGIN(l) do { } while (0)
#define CLKP_END(l) do { } while (0)
#endif
#define LAYER(l) do { \
        const int pb = 1 + 12 * l; \
        if (IN(pb + 0)) { ph_prep1(F, l); } SEAM(pb + 0); \
        unsigned char* wl = F.ws + WS_W + (size_t)l * WL_STRIDE; \
        if (IN(pb + 1)) { \
            if (FAST_MASK & 1) { CLKP_BEGIN(l); for (int rep = 0; rep < REP_GEMM; ++rep) ph_fg1_fp8(F, l); CLKP_END(l); } \
            else ph_ngemm_bf16(F, (const bf16_t*)(F.ws + WS_H), DM, F.in(8) + (size_t)l * DM * DIN, DIN, DM, TT, DIN, (bf16_t*)(F.ws + WS_PROJ), PP); \
        } SEAM(pb + 1); \
        if (IN(pb + 2)) { if (FAST_MASK & 64) ph_prep2_fast(F, l); else ph_prep2(F, l); } SEAM(pb + 2); \
        if (IN(pb + 3)) { \
            if (FAST_MASK & 2) { \
                ph_fmla_up(F, l); \
            } else { \
                ph_ngemm_bf16(F, (const bf16_t*)(F.ws + WS_PROJ) + C_MCQ, PP, F.in(10) + (size_t)l * 384 * 768, 768, 384, TT, 768, (bf16_t*)(F.ws + WS_MQ), 768); \
                ph_ngemm_bf16(F, (const bf16_t*)(F.ws + WS_PROJ) + C_MCKV, PP, F.in(12) + (size_t)l * 256 * 1024, 1024, 256, TT, 1024, (bf16_t*)(F.ws + WS_MKV), 1024); \
            } \
        } SEAM(pb + 3); \
        if (IN(pb + 4)) { if (FAST_MASK & 64) ph_prep3_fast(F, l); else ph_prep3(F, l); } SEAM(pb + 4); \
        if (IN(pb + 5)) { if (FAST_MASK & 32) { for (int rep = 0; rep < REP_ATT; ++rep) ph_fattn8(F, l); } else ph_nattn(F, l); } SEAM(pb + 5); \
        if (IN(pb + 6)) { if (FAST_MASK & 8) { for (int rep = 0; rep < REP_GEMM; ++rep) ph_fbranch(F, l); } } SEAM(pb + 6); \
        if (IN(pb + 7)) { if (FAST_MASK & 8) { for (int rep = 0; rep < REP_GEMM; ++rep) ph_fgate(F, l); } else ph_nmerge(F, l); } SEAM(pb + 7); \
        if (IN(pb + 8)) { if (FAST_MASK & 4) ph_fout(F, l); else ph_nout(F, l); } SEAM(pb + 8); \
        if (IN(pb + 9)) { ph_prep4(F, l); } SEAM(pb + 9); \
        if (IN(pb + 10)) { if (FAST_MASK & 16) { for (int rep = 0; rep < REP_MOE; ++rep) ph_fmoe_up(F, l); } else ph_nmoe(F, l); } SEAM(pb + 10); \
        if (IN(pb + 11)) { if (FAST_MASK & 16) { for (int rep = 0; rep < REP_MOE; ++rep) ph_fmoe_down(F, l); } } SEAM(pb + 11); \
    } while (0)
#if PREFIX_K > 0
    {
        const int lo = 0, hi = PREFIX_K;
        if (IN(0)) { ph_mod(F); if (FAST_MASK) { rope_tables_build(F); ph_convert(F); } } SEAM(0);
        LAYER(0);
        xcd_barrier(bar, F.tid);
        if (F.bid == 0 && F.tid < 32) ((unsigned*)(F.ws + WS_CTL))[CW_ECNT + F.tid] = 0u;
        xcd_barrier(bar, F.tid);
    }
#endif
    const int lo = args.ph_lo, hi = args.ph_hi;
    if (IN(0)) { for (int rep = 0; rep < REP_PRO; ++rep) { ph_mod(F); if (FAST_MASK) { rope_tables_build(F); ph_convert(F); } } } SEAM(0);
    LAYER(0);
    LAYER(1);
#undef LAYER
    if (IN(N_PHASES - 1)) { ph_prep1(F, DEPTH); }
#if CLK_PROBE
    if (F.bid == 0 && F.tid == 0) {
        const unsigned dc = MISC[18], dw = MISC[19];
        const unsigned long long spin = CLK_PROBE == 1 ? (unsigned long long)dc * 3000ull / (dw ? dw : 1u) : ((CLK_PROBE == 2 || CLK_PROBE == 6) ? (unsigned long long)dw * 2ull : (unsigned long long)dc);
        const unsigned long long t0 = __builtin_amdgcn_s_memrealtime();
        while (__builtin_amdgcn_s_memrealtime() - t0 < spin) __builtin_amdgcn_s_sleep(8);
    }
#endif
#undef IN
#undef SEAM
}

extern "C" void kernel_launch(void* const* d_in, const int* in_sizes, int n_in, void* d_out, int out_size, void* d_ws, size_t ws_size, hipStream_t stream) {
    static int grid = 0;
    if (grid == 0) {
        if (n_in != 32 || in_sizes[0] != TL * DM || out_size != TL * DM || ws_size < WS_END) {
            fprintf(stderr, "kernel_launch: shape mismatch n_in %d in0 %d out %d ws %zu (need %zu)\n", n_in, n_in > 0 ? in_sizes[0] : -1, out_size, ws_size, (size_t)WS_END); grid = -1; return; }
        int dev = 0, cus = 0, per_cu = 0;
        if (hipGetDevice(&dev) != hipSuccess || hipDeviceGetAttribute(&cus, hipDeviceAttributeMultiprocessorCount, dev) != hipSuccess) { grid = -1; return; }
        if (hipFuncSetAttribute((const void*)mega, hipFuncAttributeMaxDynamicSharedMemorySize, LDS_BYTES) != hipSuccess) { fprintf(stderr, "kernel_launch: hipFuncSetAttribute failed\n"); grid = -1; return; }
        if (hipOccupancyMaxActiveBlocksPerMultiprocessor(&per_cu, (const void*)mega, NTHREADS, LDS_BYTES) != hipSuccess || per_cu < 1) { fprintf(stderr, "kernel_launch: occupancy query says %d\n", per_cu); }
        (void)hipGetLastError();
        grid = cus;
    }
    if (grid < 0) return;
    if (hipMemsetAsync((char*)d_ws + WS_CTL, 0, CTL_ZERO_BYTES, stream) != hipSuccess) return;
    Args a{};
    for (int i = 0; i < 32; ++i) a.in[i] = (const float*)d_in[i];
    a.out = (float*)d_out; a.ws = (unsigned char*)d_ws;
#if MK_N_LAUNCHES == 1
    a.ph_lo = 0; a.ph_hi = N_PHASES;
    hipLaunchKernelGGL(mega, dim3(grid), dim3(NTHREADS), LDS_BYTES, stream, a);
#else
    for (int p = 0; p < N_PHASES; ++p) { a.ph_lo = p; a.ph_hi = p + 1; hipLaunchKernelGGL(mega, dim3(grid), dim3(NTHREADS), LDS_BYTES, stream, a); }
#endif
    const hipError_t le = hipPeekAtLastError();
    if (le != hipSuccess) fprintf(stderr, "kernel_launch: launch failed: %s\n", hipGetErrorName(le));
}
```

```cpp
#include <hip/hip_runtime.h>
#include <cstdio>
#include <cstdint>

#ifndef FAST_MASK
#define FAST_MASK 127
#endif
#ifndef REP_PRO
#define REP_PRO 1
#endif
#ifndef REP_ATT
#define REP_ATT 1
#endif
#ifndef REP_GEMM
#define REP_GEMM 1
#endif
#ifndef REP_MOE
#define REP_MOE 1
#endif
#ifndef PREFIX_K
#define PREFIX_K 0
#define CLK_PROBE 0
#define VALU_PROBE 0
#define SCL_DIV 1
#define PROBE_PH 13
#endif
#ifndef FA_SEL
#define FA_SEL 31
#endif
#ifndef MK_N_LAUNCHES
#define MK_N_LAUNCHES 1
#endif

constexpr int DM = 2048, NB = 2, SEQ = 8192, NCTX = 256, TL = NB * SEQ, TC = NB * NCTX, TT = TL + TC, DEPTH = 2;
constexpr int DIN = 4288, PP = 4352;
constexpr int C_AQ = 0, C_AK = 512, C_AV = 768, C_MCQ = 1024, C_MCKV = 1408, C_MKR = 1664, C_WQ = 1728, C_WK = 2240, C_WV = 2496, C_NQ = 2752, C_NK = 3264, C_NV = 3776;
constexpr int NEXP = 16, DEXP = 512;
constexpr float EPS = 1e-6f;
constexpr float BV_SCALE = 64.0f;
constexpr float ACC_SCALE = 64.0f;
constexpr float OUT_SCALE = 32.0f;
constexpr float GATE_WSCALE = 32.0f;
constexpr int NWAVES = 8, NTHREADS = 512;

constexpr size_t MiB = 1u << 20;
constexpr size_t WS_CTL = 0, CTL_ZERO_BYTES = 1 * MiB;
constexpr size_t WS_MOD = 1 * MiB;
constexpr size_t WS_ROPE = 1 * MiB + 512 * 1024;
constexpr size_t WS_XC = 2 * MiB;
constexpr size_t WS_ELIST = 7 * MiB;
constexpr size_t WS_ELW = 9 * MiB;
constexpr size_t WS_H = 16 * MiB;
constexpr size_t WS_PROJ = 82 * MiB;
constexpr size_t WS_MQ = 223 * MiB;
constexpr size_t WS_MKV = 248 * MiB;
constexpr size_t WS_MK = 281 * MiB;
constexpr int MCP = 640, MQP = 1792;
constexpr size_t WS_HID = 306 * MiB;
constexpr size_t WS_BV = 82 * MiB;
constexpr size_t WS_OUTS = 346 * MiB;
constexpr size_t WS_ACC = 412 * MiB;
constexpr size_t WS_W = 478 * MiB;
constexpr size_t WL_STRIDE = 163 * MiB;
constexpr size_t WO_IN = 0, WO_UQ = 17 * MiB, WO_UKV = 18 * MiB, WO_G = 19 * MiB, WO_B = 51 * MiB, WO_O = 59 * MiB, WO_13 = 67 * MiB, WO_2 = 131 * MiB;
constexpr size_t WS_H8 = 804 * MiB;
constexpr size_t WS_Q8 = 838 * MiB;
constexpr size_t WS_K8 = 876 * MiB;
constexpr size_t WS_V8T = 905 * MiB;
constexpr size_t WS_END = 930 * MiB;
constexpr int Q8P = 2304, K8P = 1792, VTP = 8448;
constexpr int Q8_A = 0, Q8_W = 512, Q8_N = 1024, Q8_M = 1536, K8_A = 0, K8_W = 256, K8_N = 512, K8_M = 1024;
static_assert(WS_BV + (size_t)TT * 8192 * 2 <= WS_OUTS && WS_HID + (size_t)148 * 256 * 512 * 2 <= WS_OUTS && WS_W + 2 * WL_STRIDE <= WS_END, "d_ws map");
constexpr int CW_ECNT = 64;
constexpr int CW_BAR = 4096;
constexpr int CW_Q = 8192;

typedef unsigned short bf16_t;
#define LAS __attribute__((address_space(3)))
#define GAS __attribute__((address_space(1)))
typedef float f32x4 __attribute__((ext_vector_type(4)));
typedef unsigned u32x4 __attribute__((ext_vector_type(4)));
typedef unsigned u32x2 __attribute__((ext_vector_type(2)));
typedef float f32x2v __attribute__((ext_vector_type(2)));

__device__ __forceinline__ float bf2f(unsigned v) { return __uint_as_float(v << 16); }
__device__ __forceinline__ unsigned f2bf(float f) { unsigned u = __float_as_uint(f); return (u + 0x7fffu + ((u >> 16) & 1u)) >> 16; }
__device__ __forceinline__ unsigned pk2(float lo, float hi) { return f2bf(lo) | (f2bf(hi) << 16); }
__device__ __forceinline__ float lo16(unsigned w) { return __uint_as_float(w << 16); }
__device__ __forceinline__ float hi16(unsigned w) { return __uint_as_float(w & 0xffff0000u); }
__device__ __forceinline__ int cvt8s(float a, float b, int old, bool hi) {
    a = __builtin_amdgcn_fmed3f(a, -448.f, 448.f); b = __builtin_amdgcn_fmed3f(b, -448.f, 448.f);
    return hi ? __builtin_amdgcn_cvt_pk_fp8_f32(a, b, old, true) : __builtin_amdgcn_cvt_pk_fp8_f32(a, b, old, false);
}
__device__ __forceinline__ float wave_sum(float v) {
#pragma unroll
    for (int o = 1; o < 64; o <<= 1) v += __shfl_xor(v, o);
    return v;
}
__device__ __forceinline__ float sigmoidf_(float x) { return 1.0f / (1.0f + __expf(-x)); }
__device__ __forceinline__ float siluf_(float x) { return x / (1.0f + __expf(-x)); }

#define XB_TMO      128
#define XB_XCNT(j)  (256  + 64 * (j))
#define XB_XSUB(j)  (1280 + 64 * (j))
#define XB_XGEN(j)  (2304 + 64 * (j))
#define XB_TOP      3328
#define XB_TOPGEN   3392
#define XCD_BAR_WORDS 3456
#define XB_SPIN_CAP (1u << 22)

__device__ __forceinline__ unsigned xb_ld(unsigned* p)              { return __hip_atomic_load(p, __ATOMIC_RELAXED, __HIP_MEMORY_SCOPE_AGENT); }
__device__ __forceinline__ unsigned xb_add(unsigned* p, unsigned v) { return __hip_atomic_fetch_add(p, v, __ATOMIC_RELAXED, __HIP_MEMORY_SCOPE_AGENT); }
__device__ __forceinline__ unsigned xb_xcc_id() { return (unsigned)__builtin_amdgcn_s_getreg((3 << 11) | 20) & 0xFu; }
#define XB_SPIN(cond, bar) do { unsigned _sp = 0; while (cond) { __builtin_amdgcn_s_sleep(1); \
    if ((++_sp & 255u) == 0u) { if (xb_ld(&(bar)[XB_TMO])) break; if (_sp > XB_SPIN_CAP) { atomicAdd(&(bar)[XB_TMO], 1u); break; } } } } while (0)

struct XcdBarrier { unsigned* bar; unsigned x; volatile LAS unsigned* st; };

__device__ __forceinline__ XcdBarrier xcd_barrier_post(unsigned* bar, volatile LAS unsigned* st, int tid) {
    XcdBarrier b; b.bar = bar; b.x = xb_xcc_id(); b.st = st;
    if (tid == 0) (void)xb_add(&bar[XB_XCNT(b.x)], 1u);
    return b;
}
__device__ __forceinline__ void xcd_barrier_complete(unsigned* bar, unsigned x, unsigned& nloc, unsigned& nx) {
    const unsigned G = gridDim.x * gridDim.y * gridDim.z;
    unsigned sum, cnt, mine, sp = 0u;
    for (;;) {
        sum = 0u; cnt = 0u; mine = 0u;
#pragma unroll
        for (unsigned j = 0; j < 16; ++j) { const unsigned c = xb_ld(&bar[XB_XCNT(j)]); sum += c; cnt += (c > 0u) ? 1u : 0u; mine = (j == x) ? c : mine; }
        if (sum == G) break;
        __builtin_amdgcn_s_sleep(1);
        if ((++sp & 255u) == 0u) { if (xb_ld(&bar[XB_TMO])) break; if (sp > XB_SPIN_CAP) { atomicAdd(&bar[XB_TMO], 1u); break; } }
    }
    nloc = mine > 0u ? mine : 1u; nx = cnt > 0u ? cnt : 1u;
}
__device__ __forceinline__ void xcd_barrier(const XcdBarrier& b, int tid) {
    asm volatile("s_waitcnt vmcnt(0)" ::: "memory");
    __syncthreads();
    if (tid == 0) {
        unsigned* bar = b.bar;
        __builtin_amdgcn_s_waitcnt(0);
        unsigned nloc = b.st[0], nx = b.st[1];
        if (nloc == 0u) { xcd_barrier_complete(bar, b.x, nloc, nx); b.st[0] = nloc; b.st[1] = nx; }
        const unsigned old = xb_add(&bar[XB_XSUB(b.x)], 1u);
        const unsigned gen = old / nloc;
        if (old + 1u == (gen + 1u) * nloc) {
            __builtin_amdgcn_fence(__ATOMIC_RELEASE, "agent");
            asm volatile("s_waitcnt vmcnt(0)" ::: "memory");
            const unsigned og = xb_add(&bar[XB_TOP], 1u);
            const unsigned tg = og / nx;
            if (og + 1u == (tg + 1u) * nx) xb_add(&bar[XB_TOPGEN], 1u);
            else XB_SPIN(xb_ld(&bar[XB_TOPGEN]) == tg, bar);
            __builtin_amdgcn_fence(__ATOMIC_ACQUIRE, "agent");
            xb_add(&bar[XB_XGEN(b.x)], 1u);
            asm volatile("s_waitcnt vmcnt(0)" ::: "memory");
        } else {
            XB_SPIN(xb_ld(&bar[XB_XGEN(b.x)]) == gen, bar);
            __builtin_amdgcn_fence(__ATOMIC_ACQUIRE, "agent");
            asm volatile("s_waitcnt vmcnt(0)" ::: "memory");
        }
    }
    __syncthreads();
}

struct Args { const float* in[32]; float* out; unsigned char* ws; int ph_lo, ph_hi; };

struct Frame {
    LAS unsigned char* lds;
    float* out; unsigned char* ws;
    int tid, lane, wave, G, bid;
    __device__ __forceinline__ const float* in(int k) const {
        const __attribute__((address_space(4))) char* ka = (const __attribute__((address_space(4))) char*)__builtin_amdgcn_kernarg_segment_ptr();
        int z = 0; asm volatile("" : "+v"(z)); z = __builtin_amdgcn_readfirstlane(z);
        return *(const float* const __attribute__((address_space(4)))*)(ka + k * 8 + z);
    }
};
__device__ __forceinline__ float* xs_row(const Frame& F, int r) { return r < TL ? F.out + (size_t)r * DM : (float*)(F.ws + WS_XC) + (size_t)(r - TL) * DM; }
__device__ __forceinline__ const float* xin_row(const Frame& F, int l, int r) {
    if (l == 0) return r < TL ? F.in(0) + (size_t)r * DM : F.in(2) + (size_t)(r - TL) * DM;
    return xs_row(F, r);
}
__device__ __forceinline__ const float* mod_vec(const Frame& F, int l, int r, int which) {
    const int s = r < TL ? (r / SEQ) : 2;
    return (const float*)(F.ws + WS_MOD) + (size_t)(l * 3 + s) * 6 * DM + which * DM;
}

__device__ __forceinline__ void launder(Frame& F) {
    asm volatile("" : "+s"(F.wave), "+s"(F.bid), "+s"(F.G));
    int z = 0; asm volatile("" : "+v"(z));
    F.lane = (int)__builtin_amdgcn_mbcnt_hi(~0u, __builtin_amdgcn_mbcnt_lo(~0u, (unsigned)z)); F.tid = F.wave * 64 + F.lane;
}

__device__ __forceinline__ void ph_mod(Frame& F) {
    LAS float* sv = (LAS float*)F.lds;
    LAS float* red = sv + 3 * DM;
    for (int i = F.tid; i < 3 * DM; i += NTHREADS) { const int s = i / DM, k = i % DM; const float v = s < 2 ? F.in(1)[s * DM + k] : F.in(3)[k]; sv[i] = siluf_(v); }
    __syncthreads();
    for (int item = F.bid; item < DEPTH * 96; item += F.G) {
        const int l = item / 96, ch = item % 96, col = ch * 128 + F.lane * 2;
        const float* W = F.in(4) + (size_t)l * DM * 6 * DM + col;
        float a[3][2] = {{0.f, 0.f}, {0.f, 0.f}, {0.f, 0.f}};
        const int k0 = F.wave * 256;
#pragma unroll 8
        for (int k = 0; k < 256; ++k) {
            const float2 w = *(const float2*)(W + (size_t)(k0 + k) * 6 * DM);
#pragma unroll
            for (int s = 0; s < 3; ++s) { const float x = sv[s * DM + k0 + k]; a[s][0] += x * w.x; a[s][1] += x * w.y; }
        }
#pragma unroll
        for (int s = 0; s < 3; ++s) { red[(F.wave * 3 + s) * 128 + F.lane * 2] = a[s][0]; red[(F.wave * 3 + s) * 128 + F.lane * 2 + 1] = a[s][1]; }
        __syncthreads();
        if (F.tid < 384) {
            const int s = F.tid / 128, c = F.tid % 128; float t = 0.f;
#pragma unroll
            for (int w = 0; w < 8; ++w) t += red[(w * 3 + s) * 128 + c];
            const int j = ch * 128 + c;
            ((float*)(F.ws + WS_MOD))[(size_t)(l * 3 + s) * 6 * DM + j] = t + F.in(5)[(size_t)l * 6 * DM + j];
        }
        __syncthreads();
    }
}

__device__ __forceinline__ void ph_prep1(Frame& F, int l) {
    const int gw = F.bid * NWAVES + F.wave, NGW = F.G * NWAVES;
    const int nrows = (l == DEPTH) ? TL : TT;
    const bf16_t* Y = (const bf16_t*)(F.ws + WS_PROJ);
    bf16_t* H = (bf16_t*)(F.ws + WS_H);
    const float* gn_mix = F.in(6) + (size_t)(l < DEPTH ? l : 0) * DM;
    for (int r = gw; r < nrows; r += NGW) {
        f32x4 v[8];
        const float* xr = xin_row(F, l == 0 ? 0 : 1, r);
#pragma unroll
        for (int j = 0; j < 8; ++j) v[j] = *(const f32x4*)(xr + j * 256 + F.lane * 4);
        if (l > 0) {
            const bool has_moe = (l == 1) || (r < TL);
            if (has_moe) {
                const float* g2 = mod_vec(F, l - 1, r, 5);
                const bf16_t* y0 = Y + (size_t)r * DM, *y1 = Y + (size_t)TT * DM + (size_t)r * DM;
#pragma unroll
                for (int j = 0; j < 8; ++j) {
                    const int c = j * 256 + F.lane * 4;
                    const u32x2 a = *(const u32x2*)(y0 + c), b = *(const u32x2*)(y1 + c); const f32x4 g = *(const f32x4*)(g2 + c);
                    v[j].x += g.x * (lo16(a.x) + lo16(b.x)); v[j].y += g.y * (hi16(a.x) + hi16(b.x));
                    v[j].z += g.z * (lo16(a.y) + lo16(b.y)); v[j].w += g.w * (hi16(a.y) + hi16(b.y));
                }
                float* xo = xs_row(F, r);
#pragma unroll
                for (int j = 0; j < 8; ++j) *(f32x4*)(xo + j * 256 + F.lane * 4) = v[j];
            }
        }
        if (l == DEPTH) continue;
        float ss = 0.f;
#pragma unroll
        for (int j = 0; j < 8; ++j) ss += v[j].x * v[j].x + v[j].y * v[j].y + v[j].z * v[j].z + v[j].w * v[j].w;
        const float rstd = rsqrtf(wave_sum(ss) * (1.0f / DM) + EPS);
        const float* gn = gn_mix; const float* sh = mod_vec(F, l, r, 0); const float* sc = mod_vec(F, l, r, 1);
#pragma unroll
        for (int j = 0; j < 8; ++j) {
            const int c = j * 256 + F.lane * 4;
            const f32x4 g = *(const f32x4*)(gn + c), s1 = *(const f32x4*)(sc + c), s0 = *(const f32x4*)(sh + c);
            const f32x4 h = (v[j] * rstd * g) * (s1 + 1.0f) + s0;
            if (!(FAST_MASK & 1)) { u32x2 w; w.x = pk2(h.x, h.y); w.y = pk2(h.z, h.w); *(u32x2*)(H + (size_t)r * DM + c) = w; }
            int w8 = 0; w8 = cvt8s(h.x, h.y, w8, false); w8 = cvt8s(h.z, h.w, w8, true);
            *(int*)(F.ws + WS_H8 + (size_t)r * DM + c) = w8;
        }
    }
}

__device__ __forceinline__ void ngemm_tile(float (&acc)[4][4], const bf16_t* A, int lda, const float* B, int ldb, int K, int row0, int col0, LAS float* lds, int tid) {
    LAS float* As = lds;
    LAS float* Bs = lds + 16 * 132;
    const int ty = tid >> 4, tx = tid & 15;
    const int ar = tid >> 2, ak = (tid & 3) * 4;
    const int bk = (tid & 255) >> 4, bc = (tid & 15) * 4;
    for (int k0 = 0; k0 < K; k0 += 16) {
        const u32x2 av = *(const u32x2*)(A + (size_t)(row0 + ar) * lda + k0 + ak);
        f32x4 bv = (f32x4){0.f, 0.f, 0.f, 0.f};
        if (tid < 256) bv = *(const f32x4*)(B + (size_t)(k0 + bk) * ldb + col0 + bc);
        __syncthreads();
        As[(ak + 0) * 132 + ar] = lo16(av.x); As[(ak + 1) * 132 + ar] = hi16(av.x); As[(ak + 2) * 132 + ar] = lo16(av.y); As[(ak + 3) * 132 + ar] = hi16(av.y);
        if (tid < 256) *(LAS f32x4*)(Bs + bk * 64 + bc) = bv;
        __syncthreads();
#pragma unroll
        for (int kk = 0; kk < 16; ++kk) {
            const f32x4 a = *(const LAS f32x4*)(As + kk * 132 + ty * 4);
            const f32x4 b = *(const LAS f32x4*)(Bs + kk * 64 + tx * 4);
#pragma unroll
            for (int i = 0; i < 4; ++i)
#pragma unroll
                for (int j = 0; j < 4; ++j) acc[i][j] += a[i] * b[j];
        }
    }
    __syncthreads();
}
#define ZERO44(a) do { _Pragma("unroll") for (int i_ = 0; i_ < 4; ++i_) _Pragma("unroll") for (int j_ = 0; j_ < 4; ++j_) a[i_][j_] = 0.f; } while (0)

__device__ __forceinline__ void ph_ngemm_bf16(Frame& F, const bf16_t* A, int lda, const float* B, int ldb, int K, int M, int N, bf16_t* C, int ldc) {
    const int nn = N / 64, ntiles = (M / 128) * nn;
    const int ty = F.tid >> 4, tx = F.tid & 15;
    for (int t = F.bid; t < ntiles; t += F.G) {
        const int row0 = (t / nn) * 128, col0 = (t % nn) * 64;
        float acc[4][4]; ZERO44(acc);
        ngemm_tile(acc, A, lda, B, ldb, K, row0, col0, (LAS float*)F.lds, F.tid);
#pragma unroll
        for (int i = 0; i < 4; ++i) { u32x2 w; w.x = pk2(acc[i][0], acc[i][1]); w.y = pk2(acc[i][2], acc[i][3]);
            *(u32x2*)(C + (size_t)(row0 + ty * 4 + i) * ldc + col0 + tx * 4) = w; }
    }
}

__device__ __forceinline__ float rope_freq(int i, int n) { return exp2f(-(float)i * (13.287712379549449f / (float)n)); }
__device__ __forceinline__ void head128(bf16_t* p, const float* g, bool rope, int prow, int pcol, int lane) {
    float e0 = bf2f(p[lane]), e1 = bf2f(p[lane + 64]);
    const float rstd = rsqrtf(wave_sum(e0 * e0 + e1 * e1) * (1.0f / 128.0f) + EPS);
    e0 = e0 * rstd * g[lane]; e1 = e1 * rstd * g[lane + 64];
    if (rope) {
        const float fr = rope_freq(lane & 31, 32);
        float s0, c0, s1, c1; sincosf((float)prow * fr, &s0, &c0); sincosf((float)pcol * fr, &s1, &c1);
        const float p0 = __shfl_xor(e0, 32), p1 = __shfl_xor(e1, 32);
        if (lane < 32) { e0 = e0 * c0 - p0 * s0; e1 = e1 * c1 - p1 * s1; }
        else { e0 = p0 * s0 + e0 * c0; e1 = p1 * s1 + e1 * c1; }
    }
    p[lane] = (bf16_t)f2bf(e0); p[lane + 64] = (bf16_t)f2bf(e1);
}
__device__ __forceinline__ void ph_prep2(Frame& F, int l) {
    const int gw = F.bid * NWAVES + F.wave, NGW = F.G * NWAVES, lane = F.lane;
    bf16_t* PROJ = (bf16_t*)(F.ws + WS_PROJ);
    for (int r = gw; r < TT; r += NGW) {
        bf16_t* p = PROJ + (size_t)r * PP;
        const bool lat = r < TL; const int t = r % SEQ, prow = t / 64, pcol = t % 64;
        for (int h = 0; h < 4; ++h) head128(p + C_AQ + h * 128, F.in(13) + l * 128, lat, prow, pcol, lane);
        for (int h = 0; h < 2; ++h) head128(p + C_AK + h * 128, F.in(14) + l * 128, lat, prow, pcol, lane);
        for (int h = 0; h < 4; ++h) head128(p + C_WQ + h * 128, F.in(17) + l * 128, lat, prow, pcol, lane);
        for (int h = 0; h < 2; ++h) head128(p + C_WK + h * 128, F.in(18) + l * 128, lat, prow, pcol, lane);
        for (int h = 0; h < 4; ++h) head128(p + C_NQ + h * 128, F.in(19) + l * 128, false, 0, 0, lane);
        for (int h = 0; h < 4; ++h) head128(p + C_NK + h * 128, F.in(20) + l * 128, false, 0, 0, lane);
        {
            float e[6]; float ss = 0.f;
#pragma unroll
            for (int j = 0; j < 6; ++j) { e[j] = bf2f(p[C_MCQ + j * 64 + lane]); ss += e[j] * e[j]; }
            const float rstd = rsqrtf(wave_sum(ss) * (1.0f / 384.0f) + EPS);
#pragma unroll
            for (int j = 0; j < 6; ++j) p[C_MCQ + j * 64 + lane] = (bf16_t)f2bf(e[j] * rstd * F.in(9)[l * 384 + j * 64 + lane]);
        }
        {
            float e[4]; float ss = 0.f;
#pragma unroll
            for (int j = 0; j < 4; ++j) { e[j] = bf2f(p[C_MCKV + j * 64 + lane]); ss += e[j] * e[j]; }
            const float rstd = rsqrtf(wave_sum(ss) * (1.0f / 256.0f) + EPS);
#pragma unroll
            for (int j = 0; j < 4; ++j) p[C_MCKV + j * 64 + lane] = (bf16_t)f2bf(e[j] * rstd * F.in(11)[l * 256 + j * 64 + lane]);
        }
    }
}

__device__ __forceinline__ void mla_head(float e0, float e1, float e2, const float* g, bool rope, int prow, int pcol, int lane, bf16_t* dst) {
    const float rstd = rsqrtf(wave_sum(e0 * e0 + e1 * e1 + e2 * e2) * (1.0f / 192.0f) + EPS);
    e0 = e0 * rstd * g[lane]; e1 = e1 * rstd * g[64 + lane]; e2 = e2 * rstd * g[128 + lane];
    if (rope) {
        const float fr = rope_freq(lane & 15, 16); const int pos = (lane < 32) ? prow : pcol;
        float s, c; sincosf((float)pos * fr, &s, &c);
        const float pr = __shfl_xor(e2, 16);
        e2 = ((lane & 31) < 16) ? (e2 * c - pr * s) : (pr * s + e2 * c);
    }
    dst[lane] = (bf16_t)f2bf(e0); dst[64 + lane] = (bf16_t)f2bf(e1); dst[128 + lane] = (bf16_t)f2bf(e2);
}
__device__ __forceinline__ void ph_prep3(Frame& F, int l) {
    const int gw = F.bid * NWAVES + F.wave, NGW = F.G * NWAVES, lane = F.lane;
    const bf16_t* PROJ = (const bf16_t*)(F.ws + WS_PROJ); bf16_t* MQ = (bf16_t*)(F.ws + WS_MQ); const bf16_t* MKV = (const bf16_t*)(F.ws + WS_MKV); bf16_t* MK = (bf16_t*)(F.ws + WS_MK);
    for (int r = gw; r < TT; r += NGW) {
        const bool lat = r < TL; const int t = r % SEQ, prow = t / 64, pcol = t % 64;
        const float kr = bf2f(PROJ[(size_t)r * PP + C_MKR + lane]);
        for (int h = 0; h < 4; ++h) {
            bf16_t* q = MQ + (size_t)r * 768 + h * 192;
            mla_head(bf2f(q[lane]), bf2f(q[64 + lane]), bf2f(q[128 + lane]), F.in(15) + l * 192, lat, prow, pcol, lane, q);
            const bf16_t* kv = MKV + (size_t)r * 1024 + h * 256;
            mla_head(bf2f(kv[lane]), bf2f(kv[64 + lane]), kr, F.in(16) + l * 192, lat, prow, pcol, lane, MK + (size_t)r * 768 + h * 192);
        }
    }
}

constexpr int RT_ROW128 = 0, RT_COL128 = 128 * 32, RT_ROW64 = RT_COL128 + 64 * 32, RT_COL64 = RT_ROW64 + 128 * 16, RT_N = RT_COL64 + 64 * 16;
__device__ __forceinline__ void rope_tables_build(Frame& F) {
    f32x2v* tab = (f32x2v*)(F.ws + WS_ROPE);
    for (int i = F.bid * NTHREADS + F.tid; i < RT_N; i += F.G * NTHREADS) {
        int pos, fi, n;
        if (i < RT_COL128) { pos = i >> 5; fi = i & 31; n = 32; } else if (i < RT_ROW64) { pos = (i - RT_COL128) >> 5; fi = i & 31; n = 32; }
        else if (i < RT_COL64) { pos = (i - RT_ROW64) >> 4; fi = i & 15; n = 16; } else { pos = (i - RT_COL64) >> 4; fi = i & 15; n = 16; }
        float sn, cs; sincosf((float)pos * rope_freq(fi, n), &sn, &cs); tab[i] = (f32x2v){cs, sn};
    }
}
__device__ __forceinline__ void rope_tables(Frame& F, LAS f32x2v* tab) {
    const u32x4* src = (const u32x4*)(F.ws + WS_ROPE);
    for (int i = F.tid; i < RT_N / 2; i += NTHREADS) ((LAS u32x4*)tab)[i] = src[i];
    __syncthreads();
}
__device__ __forceinline__ void unpack8(const u32x4 w, float (&e)[8]) { e[0] = lo16(w.x); e[1] = hi16(w.x); e[2] = lo16(w.y); e[3] = hi16(w.y); e[4] = lo16(w.z); e[5] = hi16(w.z); e[6] = lo16(w.w); e[7] = hi16(w.w); }
__device__ __forceinline__ u32x4 pack8(const float (&e)[8]) { u32x4 w; w.x = pk2(e[0], e[1]); w.y = pk2(e[2], e[3]); w.z = pk2(e[4], e[5]); w.w = pk2(e[6], e[7]); return w; }
__device__ __forceinline__ u32x2 pack8_fp8(const float (&e)[8]) { int a = 0, b = 0;
    a = cvt8s(e[0], e[1], a, false); a = cvt8s(e[2], e[3], a, true);
    b = cvt8s(e[4], e[5], b, false); b = cvt8s(e[6], e[7], b, true);
    u32x2 o; o.x = (unsigned)a; o.y = (unsigned)b; return o; }
__device__ __forceinline__ void vtrans_item(const bf16_t* src, int pitch, int b, int tb, unsigned char* dst  , LAS unsigned char* scr, int lane) {
    const int krow = tb < 4 ? TL + b * NCTX + tb * 64 + lane : b * SEQ + (tb - 4) * 64 + lane;
    const bf16_t* p = src + (size_t)krow * pitch;
    u32x4 w[8];
#pragma unroll
    for (int i = 0; i < 8; ++i) w[i] = *(const u32x4*)(p + i * 8);
    const int pos = 32 * ((lane >> 2) & 1) + (lane & 3) + 4 * ((lane >> 3) & 3) + 16 * (lane >> 5);
#pragma unroll
    for (int i = 0; i < 8; ++i) { float e[8]; unpack8(w[i], e); const u32x2 q = pack8_fp8(e);
#pragma unroll
        for (int j = 0; j < 4; ++j) { scr[(i * 8 + j) * 80 + pos] = (unsigned char)(q.x >> (8 * j)); scr[(i * 8 + 4 + j) * 80 + pos] = (unsigned char)(q.y >> (8 * j)); } }
    asm volatile("s_waitcnt lgkmcnt(0)" ::: "memory");
    unsigned char* o = dst + (size_t)lane * VTP + tb * 64;
#pragma unroll
    for (int c = 0; c < 4; ++c) *(u32x4*)(o + c * 16) = *(const LAS u32x4*)(scr + lane * 80 + c * 16);
    asm volatile("s_waitcnt lgkmcnt(0)" ::: "memory");
}
__device__ __forceinline__ float ssq8(const float (&e)[8]) { float s = 0.f;
#pragma unroll
    for (int i = 0; i < 8; ++i) s += e[i] * e[i]; return s; }
__device__ __forceinline__ float group16_sum(float v) { v += __shfl_xor(v, 1); v += __shfl_xor(v, 2); v += __shfl_xor(v, 4); v += __shfl_xor(v, 8); return v; }
constexpr float QS128 = 0.12751743082459871f, QS192 = 0.10411832783838018f;
__device__ __forceinline__ u32x2 head128_w(const u32x4 w, const float* g, bool rope, int prow, int pcol, int j, const LAS f32x2v* tab, const float osc = 1.0f) {
    float e[8]; unpack8(w, e);
    const float rstd = rsqrtf(group16_sum(ssq8(e)) * (1.0f / 128.0f) + EPS) * osc;
    const f32x4 g0 = *(const f32x4*)(g + 8 * j), g1 = *(const f32x4*)(g + 8 * j + 4);
    e[0] *= rstd * g0.x; e[1] *= rstd * g0.y; e[2] *= rstd * g0.z; e[3] *= rstd * g0.w; e[4] *= rstd * g1.x; e[5] *= rstd * g1.y; e[6] *= rstd * g1.z; e[7] *= rstd * g1.w;
    if (rope) {
        const int d = 8 * j, fi = d & 31; const bool first = (d & 32) == 0;
        const LAS f32x2v* t = tab + ((d < 64) ? RT_ROW128 + prow * 32 : RT_COL128 + pcol * 32) + fi;
#pragma unroll
        for (int i = 0; i < 8; ++i) { const float p = __shfl_xor(e[i], 4); const f32x2v cs = t[i]; e[i] = first ? e[i] * cs.x - p * cs.y : p * cs.y + e[i] * cs.x; }
    }
    return pack8_fp8(e);
}
__device__ __forceinline__ void ph_prep2_fast(Frame& F, int l) {
    LAS f32x2v* tab = (LAS f32x2v*)F.lds;
    rope_tables(F, tab);
    const int gw = F.bid * NWAVES + F.wave, NGW = F.G * NWAVES, lane = F.lane, j = lane & 15, hd = lane >> 4;
    bf16_t* PROJ = (bf16_t*)(F.ws + WS_PROJ);
    const float* qn_att = F.in(13) + l * 128; const float* kn_att = F.in(14) + l * 128; const float* qn_win = F.in(17) + l * 128; const float* kn_win = F.in(18) + l * 128;
    const float* qn_na = F.in(19) + l * 128; const float* kn_na = F.in(20) + l * 128; const float* qa_n = F.in(9) + l * 384; const float* kva_n = F.in(11) + l * 256;
    for (int r = gw; r < TT; r += NGW) {
        bf16_t* p = PROJ + (size_t)r * PP;
        const bool lat = r < TL; const int t = r % SEQ, prow = t / 64, pcol = t % 64;
        bf16_t* a0 = p + C_AQ + lane * 8;
        bf16_t* a1 = p + (hd < 2 ? C_AK : C_WK - 256) + lane * 8;
        bf16_t* a2 = p + C_WQ + lane * 8;
        bf16_t* a3 = p + C_NQ + lane * 8;
        bf16_t* a4 = p + C_NK + lane * 8;
        bf16_t* a5 = p + C_MCQ + (lane < 48 ? lane : 0) * 8;
        bf16_t* a6 = p + C_MCKV + (lane & 31) * 8;
        const u32x4 w0 = *(const u32x4*)a0, w1 = *(const u32x4*)a1, w2 = *(const u32x4*)a2, w3 = *(const u32x4*)a3, w4 = *(const u32x4*)a4, w5 = *(const u32x4*)a5, w6 = *(const u32x4*)a6;
        unsigned char* q8 = F.ws + WS_Q8 + (size_t)r * Q8P; unsigned char* k8 = F.ws + WS_K8 + (size_t)r * K8P;
        *(u32x2*)(q8 + Q8_A + lane * 8) = head128_w(w0, qn_att, lat, prow, pcol, j, tab, QS128);
        *(u32x2*)(k8 + (hd < 2 ? K8_A : K8_W - 256) + lane * 8) = head128_w(w1, hd < 2 ? kn_att : kn_win, lat, prow, pcol, j, tab);
        *(u32x2*)(q8 + Q8_W + lane * 8) = head128_w(w2, qn_win, lat, prow, pcol, j, tab, QS128);
        *(u32x2*)(q8 + Q8_N + lane * 8) = head128_w(w3, qn_na, false, 0, 0, j, tab, QS128);
        *(u32x2*)(k8 + K8_N + lane * 8) = head128_w(w4, kn_na, false, 0, 0, j, tab);
        float e5[8], e6[8]; unpack8(w5, e5); unpack8(w6, e6);
        const float r5 = rsqrtf(wave_sum(lane < 48 ? ssq8(e5) : 0.f) * (1.0f / 384.0f) + EPS);
        const float r6 = rsqrtf(wave_sum(lane < 32 ? ssq8(e6) : 0.f) * (1.0f / 256.0f) + EPS);
        {
            const float* g5 = qa_n + (lane < 48 ? lane : 0) * 8; const float* g6 = kva_n + (lane & 31) * 8;
            const f32x4 ga = *(const f32x4*)g5, gb = *(const f32x4*)(g5 + 4), gc = *(const f32x4*)g6, gd = *(const f32x4*)(g6 + 4);
            e5[0] *= r5 * ga.x; e5[1] *= r5 * ga.y; e5[2] *= r5 * ga.z; e5[3] *= r5 * ga.w; e5[4] *= r5 * gb.x; e5[5] *= r5 * gb.y; e5[6] *= r5 * gb.z; e5[7] *= r5 * gb.w;
            e6[0] *= r6 * gc.x; e6[1] *= r6 * gc.y; e6[2] *= r6 * gc.z; e6[3] *= r6 * gc.w; e6[4] *= r6 * gd.x; e6[5] *= r6 * gd.y; e6[6] *= r6 * gd.z; e6[7] *= r6 * gd.w;
        }
        unsigned char* mc8 = F.ws + WS_MK + (size_t)r * MCP;
        if (lane < 48) *(u32x2*)(mc8 + 256 + lane * 8) = pack8_fp8(e5);
        if (lane < 32) *(u32x2*)(mc8 + lane * 8) = pack8_fp8(e6);
    }
    __syncthreads();
    {
        LAS unsigned char* scr = F.lds + F.wave * 5120;
        for (int it = gw; it < 2 * 132 * 16; it += NGW) {
            const int g = it & 15, tb = (it >> 4) % 132, b = (it >> 4) / 132;
            const int hidx = g >> 1, half = g & 1;
            const int col = (hidx < 2 ? C_AV + hidx * 128 : (hidx < 4 ? C_WV + (hidx - 2) * 128 : C_NV + (hidx - 4) * 128)) + half * 64;
            vtrans_item(PROJ + col, PP, b, tb, F.ws + WS_V8T + ((size_t)(hidx * 2 + b) * 128 + half * 64) * VTP, scr, lane);
        }
        __syncthreads();
    }
}
__device__ __forceinline__ void mla_rope8(float (&e)[8], int rp  , int prow, int pcol, const LAS f32x2v* tab, int delta_lane) {
    const int blk = rp >> 2, pp = rp & 3; const bool first = pp < 2;
    const LAS f32x2v* t = tab + (blk == 0 ? RT_ROW64 + prow * 16 : RT_COL64 + pcol * 16) + 8 * (pp & 1);
#pragma unroll
    for (int i = 0; i < 8; ++i) { const float p = __shfl_xor(e[i], delta_lane); const f32x2v cs = t[i]; e[i] = first ? e[i] * cs.x - p * cs.y : p * cs.y + e[i] * cs.x; }
}
__device__ __forceinline__ void scale8(float (&e)[8], float rstd, const float* g) { const f32x4 a = *(const f32x4*)g, b = *(const f32x4*)(g + 4);
    e[0] *= rstd * a.x; e[1] *= rstd * a.y; e[2] *= rstd * a.z; e[3] *= rstd * a.w; e[4] *= rstd * b.x; e[5] *= rstd * b.y; e[6] *= rstd * b.z; e[7] *= rstd * b.w; }
__device__ __forceinline__ void ph_prep3_fast(Frame& F, int l) {
    LAS f32x2v* tab = (LAS f32x2v*)F.lds;
    rope_tables(F, tab);
    const int gw = F.bid * NWAVES + F.wave, NGW = F.G * NWAVES, lane = F.lane;
    const bf16_t* PROJ = (const bf16_t*)(F.ws + WS_PROJ); const bf16_t* MKV = (const bf16_t*)(F.ws + WS_MQ); const bf16_t* MQ = MKV + 1024;
    const float* qn = F.in(15) + l * 192; const float* kn = F.in(16) + l * 192;
    const int hA = lane / 24, wA = lane % 24, cB = 64 + (lane & 31), hB = cB / 24, wB = cB % 24;
    for (int r = gw; r < TT; r += NGW) {
        const bool lat = r < TL; const int t = r % SEQ, prow = t / 64, pcol = t % 64;
        const bf16_t* q = MQ + (size_t)r * MQP;
        const u32x4 qa = *(const u32x4*)(q + lane * 8), qb = *(const u32x4*)(q + cB * 8);
        const u32x4 kw = *(const u32x4*)(MKV + (size_t)r * MQP + (lane >> 4) * 256 + (lane & 15) * 8);
        const u32x4 rw = *(const u32x4*)(PROJ + (size_t)r * PP + C_MKR + (lane & 7) * 8);
        float ea[8], eb[8], ek[8], er[8]; unpack8(qa, ea); unpack8(qb, eb); unpack8(kw, ek); unpack8(rw, er);
        const float sA = ssq8(ea), sB = (lane < 32) ? ssq8(eb) : 0.f;
        float rq[4];
#pragma unroll
        for (int h = 0; h < 4; ++h) rq[h] = rsqrtf(wave_sum((hA == h ? sA : 0.f) + (hB == h ? sB : 0.f)) * (1.0f / 192.0f) + EPS);
        const float rA = hA == 0 ? rq[0] : (hA == 1 ? rq[1] : rq[2]), rB = hB == 2 ? rq[2] : rq[3];
        scale8(ea, rA * QS192, qn + wA * 8); scale8(eb, rB * QS192, qn + wB * 8);
        if (lat) {
            float ta[8], tb[8];
#pragma unroll
            for (int i = 0; i < 8; ++i) { ta[i] = ea[i]; tb[i] = eb[i]; }
            mla_rope8(ta, (wA - 16) & 7, prow, pcol, tab, 2); mla_rope8(tb, (wB - 16) & 7, prow, pcol, tab, 2);
#pragma unroll
            for (int i = 0; i < 8; ++i) { if (wA >= 16) ea[i] = ta[i]; if (wB >= 16) eb[i] = tb[i]; }
        }
        unsigned char* q8 = F.ws + WS_Q8 + (size_t)r * Q8P + Q8_M; unsigned char* k8 = F.ws + WS_K8 + (size_t)r * K8P + K8_M;
        *(u32x2*)(q8 + lane * 8) = pack8_fp8(ea);
        if (lane < 32) *(u32x2*)(q8 + cB * 8) = pack8_fp8(eb);
        const float srope = wave_sum(lane < 8 ? ssq8(er) : 0.f);
        const float rk = rsqrtf((group16_sum(ssq8(ek)) + srope) * (1.0f / 192.0f) + EPS);
        scale8(ek, rk, kn + (lane & 15) * 8);
        *(u32x2*)(k8 + (lane >> 4) * 192 + (lane & 15) * 8) = pack8_fp8(ek);
        const float rkh = __shfl(rk, ((lane >> 3) & 3) * 16);
        scale8(er, rkh, kn + 128 + (lane & 7) * 8);
        if (lat) mla_rope8(er, lane & 7, prow, pcol, tab, 2);
        if (lane < 32) *(u32x2*)(k8 + (lane >> 3) * 192 + 128 + (lane & 7) * 8) = pack8_fp8(er);
    }
    __syncthreads();
    {
        LAS unsigned char* scr = F.lds + F.wave * 5120;
        for (int it = gw; it < 2 * 132 * 8; it += NGW) {
            const int g = it & 7, tb = (it >> 3) % 132, b = (it >> 3) / 132, h = g >> 1, half = g & 1;
            vtrans_item(MKV + h * 256 + 128 + half * 64, MQP, b, tb, F.ws + WS_V8T + ((size_t)((8 + h) * 2 + b) * 128 + half * 64) * VTP, scr, lane);
        }
        __syncthreads();
    }
}

#define QSTR 97
template <int DQK> __device__ __forceinline__ float qk_dot(const LAS unsigned* q, const bf16_t* k) {
    float s = 0.f;
#pragma unroll 4
    for (int c = 0; c < DQK / 8; ++c) {
        const u32x4 kv = *(const u32x4*)(k + c * 8);
#pragma unroll
        for (int j = 0; j < 4; ++j) { const unsigned qw = q[c * 4 + j]; s += lo16(qw) * lo16(kv[j]); s += hi16(qw) * hi16(kv[j]); }
    }
    return s;
}
__device__ __forceinline__ void attn_key(float s, const bf16_t* v, float& m, float& l, float (&o)[64]) {
    if (s > m) { const float al = __expf(m - s); l *= al;
#pragma unroll
        for (int d = 0; d < 64; ++d) o[d] *= al;
        m = s; }
    const float p = __expf(s - m); l += p;
    if (v) {
#pragma unroll
        for (int c = 0; c < 8; ++c) { const u32x4 vv = *(const u32x4*)(v + c * 8);
#pragma unroll
            for (int j = 0; j < 4; ++j) { o[c * 8 + 2 * j] += p * lo16(vv[j]); o[c * 8 + 2 * j + 1] += p * hi16(vv[j]); } }
    }
}
template <int DQK> __device__ __forceinline__ void nattn_item(Frame& F, int l, int mx, int h, int r0, bool is_ctx) {
    const int lane = F.lane;
    const bf16_t* PROJ = (const bf16_t*)(F.ws + WS_PROJ);
    const bf16_t *Q, *Kb, *Vb; int ldq, ldk, ldv;
    if (mx == 0) { Q = PROJ + C_AQ + h * 128; Kb = PROJ + C_AK + (h >> 1) * 128; Vb = PROJ + C_AV + (h >> 1) * 128; ldq = ldk = ldv = PP; }
    else if (mx == 1) { Q = (const bf16_t*)(F.ws + WS_MQ) + h * 192; Kb = (const bf16_t*)(F.ws + WS_MK) + h * 192; Vb = (const bf16_t*)(F.ws + WS_MKV) + h * 256 + 128; ldq = 768; ldk = 768; ldv = 1024; }
    else if (mx == 2) { Q = PROJ + C_WQ + h * 128; Kb = PROJ + C_WK + (h >> 1) * 128; Vb = PROJ + C_WV + (h >> 1) * 128; ldq = ldk = ldv = PP; }
    else { Q = PROJ + C_NQ + h * 128; Kb = PROJ + C_NK + h * 128; Vb = PROJ + C_NV + h * 128; ldq = ldk = ldv = PP; }
    const float scale = (DQK == 128) ? 0.08838834764831845f : 0.07216878364870323f;
    const int r = r0 + (lane & 31), half = lane >> 5;
    Vb += half * 64;
    LAS unsigned* qs = (LAS unsigned*)F.lds + (F.wave * 64 + lane) * QSTR;
    {
        const bf16_t* qp = Q + (size_t)r * ldq;
#pragma unroll
        for (int c = 0; c < DQK / 8; ++c) { const u32x4 v = *(const u32x4*)(qp + c * 8); qs[c * 4 + 0] = v.x; qs[c * 4 + 1] = v.y; qs[c * 4 + 2] = v.z; qs[c * 4 + 3] = v.w; }
    }
    float m = -1e30f, lsum = 0.f; float o[64];
#pragma unroll
    for (int d = 0; d < 64; ++d) o[d] = 0.f;
    const int b = is_ctx ? (r0 - TL) / NCTX : r0 / SEQ;
    for (int j = 0; j < NCTX; ++j) { const size_t kr = (size_t)(TL + b * NCTX + j);
        const float s = qk_dot<DQK>(qs, Kb + kr * ldk) * scale; attn_key(s, Vb + kr * ldv, m, lsum, o); }
    if (!is_ctx) {
        const int t = r - b * SEQ;
        if (mx <= 1) {
            for (int j = 0; j < SEQ; ++j) { const size_t kr = (size_t)(b * SEQ + j);
                const float s = qk_dot<DQK>(qs, Kb + kr * ldk) * scale; attn_key(s, Vb + kr * ldv, m, lsum, o); }
        } else if (mx == 2) {
            const int t0 = r0 - b * SEQ;
            for (int j = t0 - 128; j <= t0 + 31 + 128; ++j) {
                const int d = t - j;
                if (j >= 0 && j < SEQ && d <= 128 && d >= -128) { const size_t kr = (size_t)(b * SEQ + j);
                    const float s = qk_dot<DQK>(qs, Kb + kr * ldk) * scale; attn_key(s, Vb + kr * ldv, m, lsum, o); }
            }
        } else {
            const int rr = t / 64, cc = t % 64;
            const int rs = min(max(rr - 4, 0), 128 - 8), cs = min(max(cc - 8, 0), 64 - 16);
            const float* rpb = F.in(22) + (size_t)(l * 4 + h) * 15 * 31;
            for (int y = 0; y < 8; ++y)
                for (int kx = 0; kx < 16; ++kx) {
                    const size_t kr = (size_t)(b * SEQ + (rs + y) * 64 + cs + kx);
                    const int dy = rs + y - rr + 7, dx = cs + kx - cc + 15;
                    const float s = qk_dot<DQK>(qs, Kb + kr * ldk) * scale + rpb[dy * 31 + dx]; attn_key(s, Vb + kr * ldv, m, lsum, o); }
        }
    }
    if (mx == 2) attn_key(F.in(21)[l * 4 + h], nullptr, m, lsum, o);
    const float inv = 1.0f / lsum;
    bf16_t* op = (bf16_t*)(F.ws + WS_OUTS) + (size_t)r * DM + mx * 512 + h * 128 + half * 64;
#pragma unroll
    for (int c = 0; c < 8; ++c) { u32x4 w;
#pragma unroll
        for (int j = 0; j < 4; ++j) w[j] = pk2(o[c * 8 + 2 * j] * inv, o[c * 8 + 2 * j + 1] * inv);
        *(u32x4*)(op + c * 8) = w; }
}
__device__ __forceinline__ void ph_nattn(Frame& F, int l) {
    if (F.wave >= 4) return;
    const int slot = F.bid * 4 + F.wave, nslots = F.G * 4;
    const int total = 8192 + (l == 0 ? 256 : 0);
    for (int it = slot; it < total; it += nslots) {
        if (it < 8192) {
            const int grp = it >> 11, rem = it & 2047, h = rem >> 9, qi = rem & 511;
            const int mx = grp == 0 ? 1 : (grp == 1 ? 0 : grp);
            if (mx == 1) nattn_item<192>(F, l, 1, h, qi * 32, false); else nattn_item<128>(F, l, mx, h, qi * 32, false);
        } else {
            const int i2 = it - 8192, mx = i2 >> 6, h = (i2 >> 4) & 3, qi = i2 & 15;
            if (mx == 1) nattn_item<192>(F, l, 1, h, TL + qi * 32, true); else nattn_item<128>(F, l, mx, h, TL + qi * 32, true);
        }
    }
}

__device__ __forceinline__ void ph_nmerge(Frame& F, int l) {
    const int M = (l == 0) ? TT : TL, nn = DM / 64, ntiles = (M / 128) * nn;
    const int ty = F.tid >> 4, tx = F.tid & 15;
    const bf16_t* H = (const bf16_t*)(F.ws + WS_H); const bf16_t* OUTS = (const bf16_t*)(F.ws + WS_OUTS); bf16_t* ACC = (bf16_t*)(F.ws + WS_ACC);
    for (int t = F.bid; t < ntiles; t += F.G) {
        const int row0 = (t / nn) * 128, col0 = (t % nn) * 64;
        float tot[4][4]; ZERO44(tot);
        for (int i = 0; i < 4; ++i) {
            float ag[4][4], ab[4][4]; ZERO44(ag); ZERO44(ab);
            ngemm_tile(ag, H, DM, F.in(24) + (size_t)(l * 4 + i) * DM * DM, DM, DM, row0, col0, (LAS float*)F.lds, F.tid);
            ngemm_tile(ab, OUTS + i * 512, DM, F.in(23) + (size_t)(l * 4 + i) * 512 * DM, DM, 512, row0, col0, (LAS float*)F.lds, F.tid);
            const f32x4 bg = *(const f32x4*)(F.in(25) + (size_t)(l * 4 + i) * DM + col0 + tx * 4);
#pragma unroll
            for (int a = 0; a < 4; ++a)
#pragma unroll
                for (int b = 0; b < 4; ++b) tot[a][b] += sigmoidf_(ag[a][b] + bg[b]) * ab[a][b];
        }
#pragma unroll
        for (int a = 0; a < 4; ++a) { u32x2 w; w.x = pk2(tot[a][0], tot[a][1]); w.y = pk2(tot[a][2], tot[a][3]);
            *(u32x2*)(ACC + (size_t)(row0 + ty * 4 + a) * DM + col0 + tx * 4) = w; }
    }
}
__device__ __forceinline__ void ph_nout(Frame& F, int l) {
    const int M = (l == 0) ? TT : TL, nn = DM / 64, ntiles = (M / 128) * nn;
    const int ty = F.tid >> 4, tx = F.tid & 15;
    const bf16_t* ACC = (const bf16_t*)(F.ws + WS_ACC);
    for (int t = F.bid; t < ntiles; t += F.G) {
        const int row0 = (t / nn) * 128, col0 = (t % nn) * 64;
        float acc[4][4]; ZERO44(acc);
        ngemm_tile(acc, ACC, DM, F.in(26) + (size_t)l * DM * DM, DM, DM, row0, col0, (LAS float*)F.lds, F.tid);
#pragma unroll
        for (int a = 0; a < 4; ++a) { const int r = row0 + ty * 4 + a, c = col0 + tx * 4;
            const f32x4 xi = *(const f32x4*)(xin_row(F, l, r) + c), g1 = *(const f32x4*)(mod_vec(F, l, r, 2) + c);
            f32x4 o; o.x = xi.x + g1.x * acc[a][0]; o.y = xi.y + g1.y * acc[a][1]; o.z = xi.z + g1.z * acc[a][2]; o.w = xi.w + g1.w * acc[a][3];
            *(f32x4*)(xs_row(F, r) + c) = o; }
    }
}

__device__ __forceinline__ void ph_prep4(Frame& F, int l) {
    const int gw = F.bid * NWAVES + F.wave, NGW = F.G * NWAVES, lane = F.lane;
    const int nrows = (l == 0) ? TT : TL;
    bf16_t* H = (bf16_t*)(F.ws + WS_H);
    unsigned* ecnt = (unsigned*)(F.ws + WS_CTL) + CW_ECNT + l * 16;
    int* elist = (int*)(F.ws + WS_ELIST); float* elw = (float*)(F.ws + WS_ELW);
    LAS float* wrT = (LAS float*)F.lds;
    { const float* wr = F.in(27);
      for (int i = F.tid; i < DM * 4; i += NTHREADS) { const int k = i >> 2, e4 = i & 3; const f32x4 v = *(const f32x4*)(wr + (size_t)k * 16 + e4 * 4);
          wrT[(e4 * 4 + 0) * DM + k] = v.x; wrT[(e4 * 4 + 1) * DM + k] = v.y; wrT[(e4 * 4 + 2) * DM + k] = v.z; wrT[(e4 * 4 + 3) * DM + k] = v.w; }
      __syncthreads(); }
    const float* gn_ffn = F.in(7) + (size_t)l * DM; const float* rbias = F.in(28);
    constexpr int RPW = 12;
    LAS unsigned* lcnt = (LAS unsigned*)(F.lds + 131072 + 1024); LAS unsigned* lbase = lcnt + 16;
    LAS int* rt_e = (LAS int*)(lbase + 16); LAS int* rt_r = rt_e + NWAVES * RPW; LAS float* rt_w1 = (LAS float*)(rt_r + NWAVES * RPW); LAS float* rt_w2 = rt_w1 + NWAVES * RPW;
    if (F.tid < 16) lcnt[F.tid] = 0u;
    __syncthreads();
    int nloc = 0;
    f32x4 vn[8];
    if (gw < nrows) { const float* xr0 = xs_row(F, gw);
#pragma unroll
        for (int j = 0; j < 8; ++j) vn[j] = *(const f32x4*)(xr0 + j * 256 + lane * 4); }
    for (int r = gw; r < nrows; r += NGW) {
        f32x4 v[8];
        float ss = 0.f;
#pragma unroll
        for (int j = 0; j < 8; ++j) { v[j] = vn[j]; ss += v[j].x * v[j].x + v[j].y * v[j].y + v[j].z * v[j].z + v[j].w * v[j].w; }
        if (r + NGW < nrows) { const float* xr1 = xs_row(F, r + NGW);
#pragma unroll
            for (int j = 0; j < 8; ++j) vn[j] = *(const f32x4*)(xr1 + j * 256 + lane * 4); }
        const float rstd = rsqrtf(wave_sum(ss) * (1.0f / DM) + EPS);
        const float* gn = gn_ffn; const float* sh = mod_vec(F, l, r, 3); const float* sc = mod_vec(F, l, r, 4);
        float lg[16];
#pragma unroll
        for (int e = 0; e < 16; ++e) lg[e] = 0.f;
#pragma unroll
        for (int j = 0; j < 8; ++j) {
            const int c = j * 256 + lane * 4;
            const f32x4 g = *(const f32x4*)(gn + c), s1 = *(const f32x4*)(sc + c), s0 = *(const f32x4*)(sh + c);
            const f32x4 h = (v[j] * rstd * g) * (s1 + 1.0f) + s0;
            if (FAST_MASK & 16) { int w8 = 0; w8 = cvt8s(h.x, h.y, w8, false); w8 = cvt8s(h.z, h.w, w8, true);
                *(int*)(F.ws + WS_H8 + (size_t)r * DM + c) = w8; }
            else { u32x2 w; w.x = pk2(h.x, h.y); w.y = pk2(h.z, h.w); *(u32x2*)(H + (size_t)r * DM + c) = w; }
#pragma unroll
            for (int e = 0; e < 16; ++e) { const f32x4 wv = *(const LAS f32x4*)(wrT + e * DM + c); lg[e] += (h.x * wv.x + h.y * wv.y) + (h.z * wv.z + h.w * wv.w); }
        }
        float q8[8], q4[4], q2[2], q1;
        { const bool b5 = (lane & 32) != 0;
#pragma unroll
          for (int i = 0; i < 8; ++i) { const float keep = b5 ? lg[8 + i] : lg[i], send = b5 ? lg[i] : lg[8 + i]; q8[i] = keep + __shfl_xor(send, 32); }
          const bool b4 = (lane & 16) != 0;
#pragma unroll
          for (int i = 0; i < 4; ++i) { const float keep = b4 ? q8[4 + i] : q8[i], send = b4 ? q8[i] : q8[4 + i]; q4[i] = keep + __shfl_xor(send, 16); }
          const bool b3 = (lane & 8) != 0;
#pragma unroll
          for (int i = 0; i < 2; ++i) { const float keep = b3 ? q4[2 + i] : q4[i], send = b3 ? q4[i] : q4[2 + i]; q2[i] = keep + __shfl_xor(send, 8); }
          const bool b2 = (lane & 4) != 0;
          { const float keep = b2 ? q2[1] : q2[0], send = b2 ? q2[0] : q2[1]; q1 = keep + __shfl_xor(send, 4); }
          q1 += __shfl_xor(q1, 2); q1 += __shfl_xor(q1, 1); }
        float sc_[16], bs[16];
#pragma unroll
        for (int e = 0; e < 16; ++e) { const float z = __uint_as_float(__builtin_amdgcn_readlane(__float_as_uint(q1), 4 * e));
            sc_[e] = __builtin_amdgcn_rcpf(1.0f + __expf(-z)); bs[e] = sc_[e] + rbias[e]; }
        int bg = 0; float bgs;
#pragma unroll
        for (int g = 0; g < 4; ++g) {
            const float a0 = bs[g * 4], a1 = bs[g * 4 + 1], a2 = bs[g * 4 + 2], a3 = bs[g * 4 + 3];
            const float lo1 = fminf(a0, a1), hi1 = fmaxf(a0, a1), lo2 = fminf(a2, a3), hi2 = fmaxf(a2, a3);
            const float gs = fmaxf(hi1, hi2) + fmaxf(fminf(hi1, hi2), fmaxf(lo1, lo2));
            if (g == 0) bgs = gs; else { const bool t = gs > bgs; bgs = t ? gs : bgs; bg = t ? g : bg; }
        }
        float x[4], su[4];
#pragma unroll
        for (int q = 0; q < 4; ++q) { x[q] = bg == 0 ? bs[q] : (bg == 1 ? bs[4 + q] : (bg == 2 ? bs[8 + q] : bs[12 + q])); su[q] = bg == 0 ? sc_[q] : (bg == 1 ? sc_[4 + q] : (bg == 2 ? sc_[8 + q] : sc_[12 + q])); }
        int i1 = 0; float v1 = x[0], s1 = su[0];
#pragma unroll
        for (int q = 1; q < 4; ++q) { const bool t = x[q] > v1; v1 = t ? x[q] : v1; s1 = t ? su[q] : s1; i1 = t ? q : i1; }
        int i2 = -1; float v2 = -3.0e38f, s2 = 0.f;
#pragma unroll
        for (int q = 0; q < 4; ++q) { const bool t = (q != i1) && (x[q] > v2); v2 = t ? x[q] : v2; s2 = t ? su[q] : s2; i2 = t ? q : i2; }
        const int e1 = bg * 4 + i1, e2 = bg * 4 + i2;
        if (lane == 0) {
            const float inv = 1.0f / (s1 + s2); const int slot = F.wave * RPW + nloc;
            rt_e[slot] = e1 | (e2 << 8); rt_r[slot] = r; rt_w1[slot] = s1 * inv; rt_w2[slot] = s2 * inv;
            (void)__hip_atomic_fetch_add(&lcnt[e1], 1u, __ATOMIC_RELAXED, __HIP_MEMORY_SCOPE_WORKGROUP); (void)__hip_atomic_fetch_add(&lcnt[e2], 1u, __ATOMIC_RELAXED, __HIP_MEMORY_SCOPE_WORKGROUP);
        }
        ++nloc;
    }
    __syncthreads();
    if (F.tid < 16) { const unsigned n = lcnt[F.tid]; lbase[F.tid] = n ? atomicAdd(ecnt + F.tid, n) : 0u; lcnt[F.tid] = 0u; }
    __syncthreads();
    if (lane == 0) for (int i = 0; i < nloc; ++i) {
        const int slot = F.wave * RPW + i; const int e1 = rt_e[slot] & 255, e2 = rt_e[slot] >> 8, r = rt_r[slot];
        const unsigned p1 = lbase[e1] + __hip_atomic_fetch_add(&lcnt[e1], 1u, __ATOMIC_RELAXED, __HIP_MEMORY_SCOPE_WORKGROUP); elist[(size_t)e1 * TT + p1] = r * 2 + 0; elw[(size_t)e1 * TT + p1] = rt_w1[slot];
        const unsigned p2 = lbase[e2] + __hip_atomic_fetch_add(&lcnt[e2], 1u, __ATOMIC_RELAXED, __HIP_MEMORY_SCOPE_WORKGROUP); elist[(size_t)e2 * TT + p2] = r * 2 + 1; elw[(size_t)e2 * TT + p2] = rt_w2[slot];
    }
    __syncthreads();
}

__device__ __forceinline__ void ph_nmoe(Frame& F, int l) {
    const unsigned* ecnt = (const unsigned*)(F.ws + WS_CTL) + CW_ECNT + l * 16;
    const int* elist = (const int*)(F.ws + WS_ELIST); const float* elw = (const float*)(F.ws + WS_ELW);
    const bf16_t* H = (const bf16_t*)(F.ws + WS_H); bf16_t* Y = (bf16_t*)(F.ws + WS_PROJ);
    LAS float* hx = (LAS float*)F.lds;
    LAS float* hid = hx + 8 * DM;
    LAS int* ent = (LAS int*)(hid + 8 * DEXP);
    LAS float* entw = (LAS float*)(ent + 8);
    int total = 0;
    for (int e = 0; e < 16; ++e) total += ((int)ecnt[e] + 7) >> 3;
    const int tid = F.tid;
    for (int item = F.bid; item < total; item += F.G) {
        int e = 0, cbase = 0, acc = 0, cnt = 0;
        for (int i = 0; i < 16; ++i) { const int n = (int)ecnt[i], c = (n + 7) >> 3; if (item >= acc && item < acc + c) { e = i; cbase = acc; cnt = n; } acc += c; }
        const int p0 = (item - cbase) * 8, nv = min(8, cnt - p0);
        __syncthreads();
        if (tid < 8) { ent[tid] = tid < nv ? elist[(size_t)e * TT + p0 + tid] : -1; entw[tid] = tid < nv ? elw[(size_t)e * TT + p0 + tid] : 0.f; }
        __syncthreads();
        for (int i = tid; i < 8 * DM; i += NTHREADS) { const int t = i / DM, k = i % DM; const int en = ent[t]; hx[i] = en >= 0 ? bf2f(H[(size_t)(en >> 1) * DM + k]) : 0.f; }
        __syncthreads();
        {
            const float* w1 = F.in(29) + (size_t)(l * 16 + e) * DM * DEXP + tid; const float* w3 = F.in(30) + (size_t)(l * 16 + e) * DM * DEXP + tid;
            float a1[8], a3[8];
#pragma unroll
            for (int t = 0; t < 8; ++t) { a1[t] = 0.f; a3[t] = 0.f; }
#pragma unroll 4
            for (int d = 0; d < DM; ++d) { const float x1 = w1[(size_t)d * DEXP], x3 = w3[(size_t)d * DEXP];
#pragma unroll
                for (int t = 0; t < 8; ++t) { const float hv = hx[t * DM + d]; a1[t] += hv * x1; a3[t] += hv * x3; } }
#pragma unroll
            for (int t = 0; t < 8; ++t) hid[t * DEXP + tid] = siluf_(a1[t]) * a3[t];
        }
        __syncthreads();
        {
            const float* w2 = F.in(31) + (size_t)(l * 16 + e) * DEXP * DM + tid * 4;
            f32x4 a[8];
#pragma unroll
            for (int t = 0; t < 8; ++t) a[t] = (f32x4){0.f, 0.f, 0.f, 0.f};
#pragma unroll 4
            for (int j = 0; j < DEXP; ++j) { const f32x4 w = *(const f32x4*)(w2 + (size_t)j * DM);
#pragma unroll
                for (int t = 0; t < 8; ++t) a[t] += w * hid[t * DEXP + j]; }
#pragma unroll
            for (int t = 0; t < 8; ++t) { const int en = ent[t]; if (en >= 0) { const float w = entw[t];
                u32x2 o; o.x = pk2(a[t].x * w, a[t].y * w); o.y = pk2(a[t].z * w, a[t].w * w);
                *(u32x2*)(Y + (size_t)(en & 1) * TT * DM + (size_t)(en >> 1) * DM + tid * 4) = o; } }
        }
    }
    __syncthreads();
}


namespace pg8 {
typedef short bf16x8 __attribute__((ext_vector_type(8)));
typedef int v4i_t __attribute__((ext_vector_type(4)));
typedef int v8i_t __attribute__((ext_vector_type(8)));
constexpr int BM = 256, BK = 64, HALF = 128, HTB = HALF * BK * 2, STAGE_BYTES = 8 * HTB, NXCD = 8, WGM = 8;
__host__ __device__ __forceinline__ int lds_byte(int r, int c) { const int st = (r >> 4) * 2 + (c >> 5), rr = r & 15, cc = c & 31, ob = rr * 64 + cc * 2; return st * 1024 + (ob ^ (((ob >> 9) & 1) << 5)); }
__host__ __device__ __forceinline__ void stage_rc(int b, int& R, int& C) { const int st = b / 1024, sb = b % 1024, swz = sb ^ (((sb >> 9) & 1) << 5); R = (st >> 1) * 16 + swz / 64; C = (st & 1) * 32 + (swz % 64) / 2; }
__host__ __device__ __forceinline__ void stage_rc8(int b, int& R, int& C) { const int st = b / 1024, sb = b % 1024, r = sb / 64, j = ((sb % 64) / 16) ^ ((r >> 3) & 1); R = (st >> 1) * 16 + r; C = (st & 1) * 32 + j * 8; }
__host__ __device__ __forceinline__ int lds_byte8(int r, int fq, int half) { const int rr = r & 15; return ((r >> 4) * 2 + (fq >> 1)) * 1024 + rr * 64 + (((2 * (fq & 1) + half) ^ ((rr >> 3) & 1)) * 16); }
__host__ __device__ __forceinline__ int perm32(int rho) { const int n = rho >> 4, i = rho & 15; return 8 * (i >> 2) + 4 * n + (i & 3); }

struct Unit { int pm, pn; const char* A; const char* B; const int* list; int nrows; int aux; };

__device__ __forceinline__ void xcd_decode(int L, int nM, int nN, int& pm, int& pn) {
    const int nwg = nM * nN; int wgid = L;
    { const int q = nwg / NXCD, r = nwg % NXCD, xcd = wgid % NXCD, off = wgid / NXCD; wgid = (xcd < r ? xcd * (q + 1) : r * (q + 1) + (xcd - r) * q) + off; }
    const int nig = WGM * nN, gid = wgid / nig, fm = gid * WGM, gsz = (nM - fm) < WGM ? (nM - fm) : WGM;
    pm = fm + ((wgid % nig) % gsz); pn = (wgid % nig) / gsz;
}
struct SchedPlain {
    const char* A; const char* B; int lda, ldb, nM, nN, G, c, a_div, a_colbytes;
    unsigned* dq; int dstride, dbase;
    __device__ __forceinline__ bool next(int i, Unit& u) const { return at((long)i * G + c, u); }
    __device__ __forceinline__ bool at(const long L, Unit& u) const {
        if (L >= (long)nM * nN) return false;
        int pm, pn; xcd_decode((int)L, nM, nN, pm, pn);
        u.pm = pm; u.pn = pn; u.A = A + (size_t)pm * BM * lda * 2 + (size_t)(pn / a_div) * a_colbytes; u.B = B + (size_t)pn * BM * ldb * 2; u.list = nullptr; u.nrows = BM; u.aux = 0; return true;
    }
};

__device__ __forceinline__ unsigned cvt_pk_bf16(float lo, float hi) { unsigned r; asm volatile("v_cvt_pk_bf16_f32 %0, %1, %2" : "=v"(r) : "v"(lo), "v"(hi)); return r; }

struct EpiBf16 {
    static constexpr bool PERM = true;
    bf16_t* O; int ldc; float scale;
    __device__ __forceinline__ void operator()(const f32x4 (&acc)[2][2][4][2], const Unit& u, int wr, int wc, int fr, int fq) const {
        const int row0 = u.pm * BM + wr * 64 + fr, col0 = u.pn * BM + wc * 32 + 8 * fq;
#pragma unroll
        for (int ai = 0; ai < 2; ++ai)
#pragma unroll
            for (int m = 0; m < 4; ++m) { bf16_t* rowp = O + (size_t)(row0 + ai * HALF + m * 16) * ldc + col0;
#pragma unroll
                for (int bj = 0; bj < 2; ++bj) { const f32x4 v0 = acc[ai][bj][m][0] * scale, v1 = acc[ai][bj][m][1] * scale;
                    u32x4 w; w.x = cvt_pk_bf16(v0[0], v0[1]); w.y = cvt_pk_bf16(v0[2], v0[3]); w.z = cvt_pk_bf16(v1[0], v1[1]); w.w = cvt_pk_bf16(v1[2], v1[3]);
                    *(u32x4*)(rowp + bj * HALF) = w; } }
    }
};
struct EpiFp8 {
    static constexpr bool PERM = true;
    unsigned char* O; int ldc; float scale;
    __device__ __forceinline__ void operator()(const f32x4 (&acc)[2][2][4][2], const Unit& u, int wr, int wc, int fr, int fq) const {
        const int row0 = u.pm * BM + wr * 64 + fr, col0 = u.pn * BM + wc * 32 + 8 * fq;
#pragma unroll
        for (int ai = 0; ai < 2; ++ai)
#pragma unroll
            for (int m = 0; m < 4; ++m) { unsigned char* rowp = O + (size_t)(row0 + ai * HALF + m * 16) * ldc + col0;
#pragma unroll
                for (int bj = 0; bj < 2; ++bj) { const f32x4 v0 = acc[ai][bj][m][0] * scale, v1 = acc[ai][bj][m][1] * scale;
                    int a = 0, b = 0; a = cvt8s(v0[0], v0[1], a, false); a = cvt8s(v0[2], v0[3], a, true); b = cvt8s(v1[0], v1[1], b, false); b = cvt8s(v1[2], v1[3], b, true);
                    u32x2 w; w.x = (unsigned)a; w.y = (unsigned)b; *(u32x2*)(rowp + bj * HALF) = w; } }
    }
};
struct EpiResid {
    static constexpr bool PERM = true;
    const float* xin_lat; const float* xin_ctx; float* xs_lat; float* xs_ctx; const float* modbase; int which; float scale;
    __device__ __forceinline__ void operator()(const f32x4 (&acc)[2][2][4][2], const Unit& u, int wr, int wc, int fr, int fq) const {
        const bool lat = u.pm < TL / BM; const int s = lat ? (u.pm * BM) / SEQ : 2;
        const float* xi = lat ? xin_lat + (size_t)u.pm * BM * DM : xin_ctx + (size_t)(u.pm * BM - TL) * DM;
        float* xo = lat ? xs_lat + (size_t)u.pm * BM * DM : xs_ctx + (size_t)(u.pm * BM - TL) * DM;
        const float* g = modbase + (size_t)s * 6 * DM + which * DM;
        const int col0 = u.pn * BM + wc * 32 + 8 * fq;
        const size_t ro0 = (size_t)(wr * 64 + fr) * DM + col0;
#pragma unroll
        for (int bj = 0; bj < 2; ++bj) { const f32x4 g0 = *(const f32x4*)(g + col0 + bj * HALF) * scale, g1 = *(const f32x4*)(g + col0 + bj * HALF + 4) * scale;
#pragma unroll
            for (int ai = 0; ai < 2; ++ai) {
#pragma unroll
                for (int m = 0; m < 4; ++m) { const size_t ro = ro0 + (size_t)(ai * HALF + m * 16) * DM + bj * HALF;
                    const f32x4 x0 = *(const f32x4*)(xi + ro), x1 = *(const f32x4*)(xi + ro + 4);
                    *(f32x4*)(xo + ro) = x0 + g0 * acc[ai][bj][m][0]; *(f32x4*)(xo + ro + 4) = x1 + g1 * acc[ai][bj][m][1]; }
                asm volatile("" ::: "memory"); } }
    }
};

template <class Epi, class Sched, bool GATHER, bool FP8 = false, bool DYN = false>
__device__ __forceinline__ void gemm_phase(LAS unsigned char* lds, const int tid_in, const int lda, const int ldb, const int K, const Sched& S, const Epi& E) {
    const int wid = __builtin_amdgcn_readfirstlane(tid_in >> 6), lane = tid_in & 63, wr = wid >> 2, wc = wid & 3, fr = lane & 15, fq = lane >> 4;
    const int nt = K / BK;
#define tid (wid * 64 + lane)
    unsigned ao[2][2], voffA[2], voffB[2];
#pragma unroll
    for (int i = 0; i < 2; ++i) { int R, C; if constexpr (FP8) stage_rc8(tid * 16 + i * 8192, R, C); else stage_rc(tid * 16 + i * 8192, R, C); const int Rb = Epi::PERM ? ((R & ~31) + perm32(R & 31)) : R;
        voffB[i] = (unsigned)(Rb * ldb + C) * 2u; voffA[i] = (unsigned)(R * lda + C) * 2u;
        ao[0][i] = 0u; ao[1][i] = 0u; }
    const size_t kstep = (size_t)(BK * 2);
    const size_t hstepB = (size_t)HALF * ldb * 2, hstepA = (size_t)HALF * lda * 2;
    const unsigned ldsw = (unsigned)wid * 1024u;
    const int aoff = lds_byte(wr * 64 + fr, fq * 8), boff = lds_byte(wc * 32 + fr, fq * 8);
    const int aoff8 = lds_byte8(wr * 64 + fr, fq, 0), boff8 = lds_byte8(wc * 32 + fr, fq, 0), aoff8b = lds_byte8(wr * 64 + fr, fq, 1), boff8b = lds_byte8(wc * 32 + fr, fq, 1);
#define PG8_SA(b, h) (((b) * 2 + (h)) * HTB)
#define PG8_SB(b, h) ((4 + (b) * 2 + (h)) * HTB)
#define PG8_STAGE(bufoff, gbase, voff) do { _Pragma("unroll") for (int _i = 0; _i < 2; ++_i) \
        __builtin_amdgcn_global_load_lds((const unsigned*)((const char*)(gbase) + (voff)[_i]), (LAS unsigned*)(lds + (bufoff) + ldsw + _i * 8192), 16, 0, 0); } while (0)
#define PG8_STAGE_A(bufoff, gbase, h, nx) do { if constexpr (GATHER) { _Pragma("unroll") for (int _i = 0; _i < 2; ++_i) { const unsigned _o = ao[h][_i]; \
        __builtin_amdgcn_global_load_lds((const unsigned*)((const char*)(gbase) + _o), (LAS unsigned*)(lds + (bufoff) + ldsw + _i * 8192), 16, 0, 0); } } \
        else { PG8_STAGE(bufoff, (const char*)(gbase) + ((h) ? hstepA : (size_t)0), voffA); } } while (0)
#define PG8_LDA(dst, b, h) do { if constexpr (FP8) { _Pragma("unroll") for (int m = 0; m < 4; ++m) dst##8[m] = __builtin_shufflevector(*(const LAS v4i_t*)(lds + PG8_SA(b, h) + aoff8 + m * 2048), *(const LAS v4i_t*)(lds + PG8_SA(b, h) + aoff8b + m * 2048), 0, 1, 2, 3, 4, 5, 6, 7); } \
        else { _Pragma("unroll") for (int m = 0; m < 4; ++m) _Pragma("unroll") for (int k = 0; k < 2; ++k) dst[m][k] = *(const LAS bf16x8*)(lds + PG8_SA(b, h) + aoff + m * 2048 + k * 1024); } } while (0)
#define PG8_LDB(dst, b, h) do { if constexpr (FP8) { _Pragma("unroll") for (int n = 0; n < 2; ++n) dst##8[n] = __builtin_shufflevector(*(const LAS v4i_t*)(lds + PG8_SB(b, h) + boff8 + n * 2048), *(const LAS v4i_t*)(lds + PG8_SB(b, h) + boff8b + n * 2048), 0, 1, 2, 3, 4, 5, 6, 7); } \
        else { _Pragma("unroll") for (int n = 0; n < 2; ++n) _Pragma("unroll") for (int k = 0; k < 2; ++k) dst[n][k] = *(const LAS bf16x8*)(lds + PG8_SB(b, h) + boff + n * 2048 + k * 1024); } } while (0)
#define PG8_MMA(ai, bj, At, Bt) do { __builtin_amdgcn_s_setprio(1); if constexpr (FP8) { _Pragma("unroll") for (int m = 0; m < 4; ++m) _Pragma("unroll") for (int n = 0; n < 2; ++n) \
        asm volatile("v_mfma_scale_f32_16x16x128_f8f6f4 %0, %1, %2, %0, %3, %3 op_sel_hi:[0,0,0]" : "+v"(acc[ai][bj][m][n]) : "v"(Bt##8[n]), "v"(At##8[m]), "v"(sc1)); } \
        else { _Pragma("unroll") for (int m = 0; m < 4; ++m) _Pragma("unroll") for (int n = 0; n < 2; ++n) _Pragma("unroll") for (int k = 0; k < 2; ++k) \
        acc[ai][bj][m][n] = __builtin_amdgcn_mfma_f32_16x16x32_bf16(Bt[n][k], At[m][k], acc[ai][bj][m][n], 0, 0, 0); } __builtin_amdgcn_s_setprio(0); } while (0)
#define PG8_WAIT_V(n) asm volatile("s_waitcnt vmcnt(" #n ")" ::: "memory")
#define PG8_WAIT_L(n) asm volatile("s_waitcnt lgkmcnt(" #n ")" ::: "memory")
#define PG8_BAR __builtin_amdgcn_s_barrier()
#define PG8_SCHED __builtin_amdgcn_sched_barrier(0)
#define PG8_GOFF(dst, u) do { if constexpr (GATHER) { _Pragma("unroll") for (int _i = 0; _i < 2; ++_i) { int _R, _C; if constexpr (FP8) stage_rc8(tid * 16 + _i * 8192, _R, _C); else stage_rc(tid * 16 + _i * 8192, _R, _C); \
        _Pragma("unroll") for (int _h = 0; _h < 2; ++_h) { const int _r = _R + _h * HALF; \
        const int _e = (_r < (u).nrows) ? (u).list[_r] : (u).list[0]; dst[_h][_i] = (unsigned)(_e >> 1) * (unsigned)(lda * 2) + (unsigned)(_C * 2); } } } } while (0)
    Unit cur, nxt; int ui = 0;
    if (!S.next(0, cur)) return;
    volatile LAS unsigned* Qs = (volatile LAS unsigned*)(lds + 131072 + 320) + 24;
    unsigned pend = 0;
    if constexpr (DYN) {
        if (tid_in == 0) Qs[1] = __hip_atomic_fetch_add(S.dq, 1u, __ATOMIC_RELAXED, __HIP_MEMORY_SCOPE_AGENT);
        asm volatile("s_waitcnt lgkmcnt(0)" ::: "memory"); __builtin_amdgcn_s_barrier();
    }
    f32x4 acc[2][2][4][2];
#define PG8_ZERO_ACC() do { float _z = 0.f; asm volatile("" : "+v"(_z)); const f32x4 _zv = (f32x4){_z, _z, _z, _z}; \
    _Pragma("unroll") for (int a = 0; a < 2; ++a) _Pragma("unroll") for (int b = 0; b < 2; ++b) _Pragma("unroll") for (int m = 0; m < 4; ++m) _Pragma("unroll") for (int n = 0; n < 2; ++n) acc[a][b][m][n] = _zv; \
    if constexpr (FP8) asm volatile("s_nop 15" ::: "memory"); } while (0)
    PG8_ZERO_ACC();
    const int sc1 = 0x7f7f7f7f;
    bf16x8 At[4][2], B0[2][2], B1[2][2]; v8i_t At8[4], B08[2], B18[2];
    const char* cA = cur.A; const char* cB = cur.B;
    PG8_GOFF(ao, cur);
    PG8_STAGE(PG8_SB(0, 0), cB, voffB); PG8_STAGE(PG8_SB(0, 1), cB + hstepB, voffB); PG8_STAGE_A(PG8_SA(0, 0), cA, 0, false); PG8_STAGE_A(PG8_SA(0, 1), cA, 1, false);
    if (wr == 1) PG8_BAR;
    PG8_WAIT_V(2); PG8_BAR;
    PG8_STAGE(PG8_SB(1, 0), cB + kstep, voffB); PG8_STAGE_A(PG8_SA(1, 0), cA + kstep, 0, false); PG8_STAGE(PG8_SB(1, 1), cB + hstepB + kstep, voffB);
    PG8_WAIT_V(6); PG8_BAR;
    for (;;) {
        bool has_next;
        if constexpr (DYN) {
            const unsigned tk = (unsigned)__builtin_amdgcn_readfirstlane((int)Qs[(ui + 1) & 1]);
            has_next = S.at((long)S.G + (long)tk * S.dstride + S.dbase, nxt);
            if (tid_in == 0) asm volatile("global_atomic_add %0, %1, %2, off sc0" : "=v"(pend) : "v"(S.dq), "v"(1u) : "memory");
        } else has_next = S.next(ui + 1, nxt);
        const char* nA = has_next ? nxt.A : cA; const char* nB = has_next ? nxt.B : cB;
#if CLK_PROBE >= 3 && CLK_PROBE <= 5
        if (FP8 && (ui == 1 || ui == 2) && blockIdx.x == 0 && tid_in == 0 && ((volatile LAS unsigned*)(lds + 131072 + 320))[20] == 1u) { volatile LAS unsigned* M_ = (volatile LAS unsigned*)(lds + 131072 + 320);
            const unsigned now = (unsigned)__builtin_readcyclecounter();
            if (ui == 1) M_[16] = now; else { if (CLK_PROBE == 4) M_[18] = now - M_[17]; if (CLK_PROBE == 5) M_[18] = (now - M_[16]) / 2u; } }
#endif
        for (int t = 0; t < nt; t += 2) {
            const bool last = (t == nt - 2);
            const char* a1 = cA + (size_t)(t + 1) * kstep;
            const char* a2 = last ? nA : cA + (size_t)(t + 2) * kstep; const char* b2 = last ? nB : cB + (size_t)(t + 2) * kstep;
            const char* a3 = a2 + kstep; const char* b3 = b2 + kstep;
            const bool nx = GATHER && last;
            PG8_LDB(B0, 0, 0); PG8_LDB(B1, 0, 1); PG8_SCHED; PG8_LDA(At, 0, 0); PG8_STAGE_A(PG8_SA(1, 1), a1, 1, false);
            if constexpr (GATHER) { if (last && has_next) { PG8_GOFF(ao, nxt); } }
            PG8_WAIT_V(8); PG8_WAIT_L(0); PG8_BAR; PG8_MMA(0, 0, At, B0); PG8_MMA(0, 1, At, B1); PG8_BAR; PG8_SCHED;
            PG8_LDA(At, 0, 1); PG8_STAGE(PG8_SB(0, 0), b2, voffB); PG8_STAGE(PG8_SB(0, 1), b2 + hstepB, voffB); PG8_STAGE_A(PG8_SA(0, 0), a2, 0, nx);
            PG8_WAIT_V(8); PG8_WAIT_L(0); PG8_BAR; PG8_MMA(1, 0, At, B0); PG8_MMA(1, 1, At, B1); PG8_BAR; PG8_SCHED;
            PG8_LDB(B0, 1, 0); PG8_LDB(B1, 1, 1); PG8_SCHED; PG8_LDA(At, 1, 0); PG8_STAGE_A(PG8_SA(0, 1), a2, 1, nx);
            PG8_WAIT_V(8); PG8_WAIT_L(0); PG8_BAR; PG8_MMA(0, 0, At, B0); PG8_MMA(0, 1, At, B1); PG8_BAR; PG8_SCHED;
            PG8_LDA(At, 1, 1); PG8_STAGE(PG8_SB(1, 0), b3, voffB); PG8_STAGE(PG8_SB(1, 1), b3 + hstepB, voffB); PG8_STAGE_A(PG8_SA(1, 0), a3, 0, nx);
            PG8_WAIT_V(8); PG8_WAIT_L(0); PG8_BAR; PG8_MMA(1, 0, At, B0); PG8_MMA(1, 1, At, B1); PG8_BAR; PG8_SCHED;
        }
#if CLK_PROBE >= 3 && CLK_PROBE <= 5
        if (FP8 && ui == 1 && blockIdx.x == 0 && tid_in == 0 && ((volatile LAS unsigned*)(lds + 131072 + 320))[20] == 1u) { volatile LAS unsigned* M_ = (volatile LAS unsigned*)(lds + 131072 + 320);
            const unsigned now = (unsigned)__builtin_readcyclecounter(); M_[17] = now; if (CLK_PROBE == 3) M_[18] = (now - M_[16]) / (unsigned)nt * 10u; }
#endif
        if constexpr (DYN) { if (tid_in == 0) Qs[ui & 1] = pend; asm volatile("s_waitcnt lgkmcnt(0)" ::: "memory"); }
        if (wr == 0) PG8_BAR;
        if constexpr (FP8) asm volatile("s_nop 15\n\ts_nop 15" ::: "memory");
        { int ln = lane; asm volatile("" : "+v"(ln)); E(acc, cur, wr, wc, ln & 15, ln >> 4); }
        if (!has_next) break;
        PG8_ZERO_ACC();
        cur = nxt; cA = nA; cB = nB; ++ui;
        if (wr == 1) PG8_BAR;
    }
    PG8_WAIT_V(0);
    PG8_BAR;
#undef PG8_SA
#undef PG8_SB
#undef PG8_STAGE
#undef PG8_STAGE_A
#undef PG8_LDA
#undef PG8_LDB
#undef PG8_MMA
#undef PG8_WAIT_V
#undef PG8_WAIT_L
#undef PG8_BAR
#undef PG8_SCHED
#undef PG8_GOFF
#undef PG8_ZERO_ACC
#undef tid
}
}


struct MapPlain { __device__ __forceinline__ int operator()(int n) const { return n; } };
struct MapGate { int i; __device__ __forceinline__ int operator()(int ch) const { return (ch >> 6) * 256 + 128 * (i >> 1) + 32 * ((ch & 63) >> 4) + 16 * (i & 1) + (ch & 15); } };
struct MapW13 { int which; __device__ __forceinline__ int operator()(int j) const { return (j >> 7) * 256 + which * 128 + (j & 127); } };
template <class Map> __device__ __forceinline__ void cvt_item(const float* W, int N, int k0, int n0, bf16_t* WT, int ldk, const Map& map, LAS float* scr, int lane) {
#pragma unroll 8
    for (int i = 0; i < 32; ++i) { const int kk = 2 * i + (lane >> 5); scr[kk * 33 + (lane & 31)] = W[(size_t)(k0 + kk) * N + n0 + (lane & 31)]; }
    asm volatile("s_waitcnt lgkmcnt(0)" ::: "memory");
    const int c = lane & 7;
#pragma unroll
    for (int j = 0; j < 4; ++j) { const int n = (lane >> 3) + 8 * j; const LAS float* sp = scr + (8 * c) * 33 + n;
        u32x4 o; o.x = pk2(sp[0 * 33], sp[1 * 33]); o.y = pk2(sp[2 * 33], sp[3 * 33]); o.z = pk2(sp[4 * 33], sp[5 * 33]); o.w = pk2(sp[6 * 33], sp[7 * 33]);
        *(u32x4*)(WT + (size_t)map(n0 + n) * ldk + k0 + 8 * c) = o; }
    asm volatile("s_waitcnt lgkmcnt(0)" ::: "memory");
}
template <class Map> __device__ __forceinline__ void cvt_item8(const float* W, int N, int k0, int n0, unsigned char* WT, int ldk, const Map& map, float scale, LAS float* scr, int lane) {
#pragma unroll 8
    for (int i = 0; i < 32; ++i) { const int kk = 2 * i + (lane >> 5); scr[kk * 33 + (lane & 31)] = W[(size_t)(k0 + kk) * N + n0 + (lane & 31)]; }
    asm volatile("s_waitcnt lgkmcnt(0)" ::: "memory");
    const int c = lane & 7;
#pragma unroll
    for (int j = 0; j < 4; ++j) { const int n = (lane >> 3) + 8 * j; const LAS float* sp = scr + (8 * c) * 33 + n;
        int a = 0, b = 0;
        a = __builtin_amdgcn_cvt_pk_fp8_f32(sp[0 * 33] * scale, sp[1 * 33] * scale, a, false); a = __builtin_amdgcn_cvt_pk_fp8_f32(sp[2 * 33] * scale, sp[3 * 33] * scale, a, true);
        b = __builtin_amdgcn_cvt_pk_fp8_f32(sp[4 * 33] * scale, sp[5 * 33] * scale, b, false); b = __builtin_amdgcn_cvt_pk_fp8_f32(sp[6 * 33] * scale, sp[7 * 33] * scale, b, true);
        u32x2 o; o.x = (unsigned)a; o.y = (unsigned)b;
        *(u32x2*)(WT + (size_t)map(n0 + n) * ldk + k0 + 8 * c) = o; }
    asm volatile("s_waitcnt lgkmcnt(0)" ::: "memory");
}
template <class Map> __device__ __forceinline__ int cvt_matrix8(Frame& F, const float* W, int K, int N, unsigned char* WT, const Map& map, float scale, int run, int ldk = 0) {
    LAS float* scr = (LAS float*)(F.lds + F.wave * 8448);
    const int gw = F.bid * NWAVES + F.wave, NGW = F.G * NWAVES;
    const int nblk = N / 32, nitems = (K / 64) * nblk;
    int first = (gw - (run % NGW) + NGW) % NGW;
    for (int it = first; it < nitems; it += NGW) cvt_item8(W, N, (it / nblk) * 64, (it % nblk) * 32, WT, ldk ? ldk : K, map, scale, scr, F.lane);
    return run + nitems;
}
template <class Map> __device__ __forceinline__ int cvt_matrix(Frame& F, const float* W, int K, int N, bf16_t* WT, const Map& map, int run) {
    LAS float* scr = (LAS float*)(F.lds + F.wave * 8448);
    const int gw = F.bid * NWAVES + F.wave, NGW = F.G * NWAVES;
    const int nblk = N / 32, nitems = (K / 64) * nblk;
    int first = (gw - (run % NGW) + NGW) % NGW;
    for (int it = first; it < nitems; it += NGW) cvt_item(W, N, (it / nblk) * 64, (it % nblk) * 32, WT, K, map, scr, F.lane);
    return run + nitems;
}
__device__ __forceinline__ void ph_convert(Frame& F) {
    int run = 0;
    for (int l = 0; l < DEPTH; ++l) {
        unsigned char* wl = F.ws + WS_W + (size_t)l * WL_STRIDE;
        run = cvt_matrix8(F, F.in(8) + (size_t)l * DM * DIN, DM, DIN, (unsigned char*)(wl + WO_IN), MapPlain{}, GATE_WSCALE, run);
        {
            u32x4* z = (u32x4*)((unsigned char*)(wl + WO_IN) + (size_t)DIN * DM); const int n16 = (PP - DIN) * DM / 16;
            for (int i = F.bid * NTHREADS + F.tid; i < n16; i += F.G * NTHREADS) z[i] = (u32x4){0u, 0u, 0u, 0u};
        }
        run = cvt_matrix8(F, F.in(12) + (size_t)l * 256 * 1024, 256, 1024, (unsigned char*)(wl + WO_UQ), MapPlain{}, GATE_WSCALE, run, 512);
        run = cvt_matrix8(F, F.in(10) + (size_t)l * 384 * 768, 384, 768, (unsigned char*)(wl + WO_UQ) + 1024 * 512 + 128, MapPlain{}, GATE_WSCALE, run, 512);
        {
            unsigned char* wb = (unsigned char*)(wl + WO_UQ);
            for (int i = F.bid * NTHREADS + F.tid; i < 1024 * 16 + 768 * 8; i += F.G * NTHREADS) {
                u32x4* z = (i < 1024 * 16) ? (u32x4*)(wb + (size_t)(i >> 4) * 512 + 256 + (i & 15) * 16) : (u32x4*)(wb + (size_t)(1024 + ((i - 1024 * 16) >> 3)) * 512 + ((i - 1024 * 16) & 7) * 16);
                *z = (u32x4){0u, 0u, 0u, 0u};
            }
        }
        for (int i = 0; i < 4; ++i) run = cvt_matrix8(F, F.in(24) + (size_t)(l * 4 + i) * DM * DM, DM, DM, (unsigned char*)(wl + WO_G), MapGate{i}, GATE_WSCALE, run);
        for (int i = 0; i < 4; ++i) run = cvt_matrix8(F, F.in(23) + (size_t)(l * 4 + i) * 512 * DM, 512, DM, (unsigned char*)(wl + WO_B) + (size_t)i * DM * 512, MapPlain{}, GATE_WSCALE, run);
        run = cvt_matrix8(F, F.in(26) + (size_t)l * DM * DM, DM, DM, (unsigned char*)(wl + WO_O), MapPlain{}, GATE_WSCALE, run);
        for (int e = 0; e < NEXP; ++e) {
            run = cvt_matrix8(F, F.in(29) + (size_t)(l * NEXP + e) * DM * DEXP, DM, DEXP, (unsigned char*)(wl + WO_13) + (size_t)e * 1024 * DM, MapW13{0}, GATE_WSCALE, run);
            run = cvt_matrix8(F, F.in(30) + (size_t)(l * NEXP + e) * DM * DEXP, DM, DEXP, (unsigned char*)(wl + WO_13) + (size_t)e * 1024 * DM, MapW13{1}, GATE_WSCALE, run);
            run = cvt_matrix8(F, F.in(31) + (size_t)(l * NEXP + e) * DEXP * DM, DEXP, DM, (unsigned char*)(wl + WO_2) + (size_t)e * DM * DEXP, MapPlain{}, GATE_WSCALE, run);
        }
    }
}

namespace pg8 {
__device__ __forceinline__ float fsigmoid(float x) { return __builtin_amdgcn_rcpf(1.0f + __builtin_amdgcn_exp2f(-1.4426950408889634f * x)); }
struct EpiGate {
    static constexpr bool PERM = false;
    const unsigned char* BV; const float* bg; bf16_t* ACC;
    __device__ __forceinline__ void operator()(const f32x4 (&acc)[2][2][4][2], const Unit& u, int wr, int wc, int fr, int fq) const {
        const int ch0 = u.pn * 64 + wc * 16 + fq * 4;
        f32x4 b[4];
#pragma unroll
        for (int i = 0; i < 4; ++i) b[i] = *(const f32x4*)(bg + i * DM + ch0);
#pragma unroll
        for (int ai = 0; ai < 2; ++ai) {
            int v[4][4];
#pragma unroll
            for (int m = 0; m < 4; ++m) { const unsigned char* bv = BV + (size_t)(u.pm * BM + ai * HALF + wr * 64 + m * 16 + fr) * 8192 + ch0;
#pragma unroll
                for (int i = 0; i < 4; ++i) v[m][i] = *(const int*)(bv + i * DM); }
#pragma unroll
            for (int m = 0; m < 4; ++m) { const size_t row = (size_t)(u.pm * BM + ai * HALF + wr * 64 + m * 16 + fr);
                f32x4 tot = (f32x4){0.f, 0.f, 0.f, 0.f};
#pragma unroll
                for (int bj = 0; bj < 2; ++bj)
#pragma unroll
                    for (int n = 0; n < 2; ++n) { const int i = 2 * bj + n; const f32x4 a = acc[ai][bj][m][n] * (1.0f / GATE_WSCALE) + b[i];
                        tot.x += fsigmoid(a.x) * __builtin_amdgcn_cvt_f32_fp8(v[m][i], 0); tot.y += fsigmoid(a.y) * __builtin_amdgcn_cvt_f32_fp8(v[m][i], 1);
                        tot.z += fsigmoid(a.z) * __builtin_amdgcn_cvt_f32_fp8(v[m][i], 2); tot.w += fsigmoid(a.w) * __builtin_amdgcn_cvt_f32_fp8(v[m][i], 3); }
                const float os = ACC_SCALE / BV_SCALE;
                int o8 = 0; o8 = cvt8s(tot.x * os, tot.y * os, o8, false); o8 = cvt8s(tot.z * os, tot.w * os, o8, true);
                *(int*)((unsigned char*)ACC + row * DM + ch0) = o8; }
            asm volatile("" ::: "memory"); }
    }
};
struct SchedMoe {
    const unsigned* ecnt; const int* elist; const char* A; const char* W; int npn, G, c; size_t w_estride, w_pnstride, a_tstride; bool gather;
    unsigned* dq; int dstride, dbase;
    __device__ __forceinline__ bool next(int i, Unit& u) const { return at((long)i * G + c, u); }
    __device__ __forceinline__ bool at(const long L, Unit& u) const {
        int nt = 0;
        for (int e = 0; e < NEXP; ++e) nt += ((int)ecnt[e] + 255) >> 8;
        if (L >= (long)nt * npn) return false;
        const int ti = (int)(L / npn), pn = (int)(L % npn);
        int e = 0, tb = 0, cn = 0, run = 0;
        for (int q = 0; q < NEXP; ++q) { const int n = (int)ecnt[q], t = (n + 255) >> 8; if (ti >= run && ti < run + t) { e = q; tb = run; cn = n; } run += t; }
        u.pm = ti; u.pn = pn; u.A = gather ? A : A + (size_t)ti * a_tstride; u.B = W + (size_t)e * w_estride + (size_t)pn * w_pnstride;
        u.list = elist + (size_t)e * TT + (size_t)(ti - tb) * 256; u.nrows = min(256, cn - (ti - tb) * 256); u.aux = e; return true;
    }
};
__device__ __forceinline__ float fsilu(float x) { return x * fsigmoid(x); }
struct EpiSwiGLU {
    static constexpr bool PERM = true;
    unsigned char* HID;
    __device__ __forceinline__ void operator()(const f32x4 (&acc)[2][2][4][2], const Unit& u, int wr, int wc, int fr, int fq) const {
        const int col0 = u.pn * 128 + wc * 32 + 8 * fq; const float is = 1.0f / GATE_WSCALE;
#pragma unroll
        for (int ai = 0; ai < 2; ++ai)
#pragma unroll
            for (int m = 0; m < 4; ++m) { const size_t row = (size_t)(u.pm * BM + ai * HALF + wr * 64 + m * 16 + fr);
                const f32x4 a0 = acc[ai][0][m][0] * is, a1 = acc[ai][0][m][1] * is, c0 = acc[ai][1][m][0] * is, c1 = acc[ai][1][m][1] * is;
                int x = 0, y = 0;
                x = cvt8s(fsilu(a0.x) * c0.x, fsilu(a0.y) * c0.y, x, false); x = cvt8s(fsilu(a0.z) * c0.z, fsilu(a0.w) * c0.w, x, true);
                y = cvt8s(fsilu(a1.x) * c1.x, fsilu(a1.y) * c1.y, y, false); y = cvt8s(fsilu(a1.z) * c1.z, fsilu(a1.w) * c1.w, y, true);
                u32x2 w; w.x = (unsigned)x; w.y = (unsigned)y;
                *(u32x2*)(HID + row * DEXP + col0) = w; }
    }
};
struct EpiMoeDown {
    static constexpr bool PERM = true;
    bf16_t* Y;
    __device__ __forceinline__ void operator()(const f32x4 (&acc)[2][2][4][2], const Unit& u, int wr, int wc, int fr, int fq) const {
        const int col0 = u.pn * BM + wc * 32 + 8 * fq;
        const float* lw = (const float*)((const char*)u.list + (WS_ELW - WS_ELIST));
#pragma unroll
        for (int ai = 0; ai < 2; ++ai)
#pragma unroll
            for (int m = 0; m < 4; ++m) { const int r = ai * HALF + wr * 64 + m * 16 + fr;
                if (r < u.nrows) { const int en = u.list[r]; const float w = lw[r] * (1.0f / GATE_WSCALE);
                    bf16_t* rowp = Y + (size_t)(en & 1) * TT * DM + (size_t)(en >> 1) * DM + col0;
#pragma unroll
                    for (int bj = 0; bj < 2; ++bj) { const f32x4 v0 = acc[ai][bj][m][0] * w, v1 = acc[ai][bj][m][1] * w;
                        u32x4 o; o.x = cvt_pk_bf16(v0[0], v0[1]); o.y = cvt_pk_bf16(v0[2], v0[3]); o.z = cvt_pk_bf16(v1[0], v1[1]); o.w = cvt_pk_bf16(v1[2], v1[3]);
                        *(u32x4*)(rowp + bj * HALF) = o; } }
                asm volatile("" ::: "memory"); }
    }
};
}
__device__ __forceinline__ unsigned* dyn_q(Frame& F, int id, int xcd) { return (unsigned*)(F.ws + WS_CTL) + CW_Q + (id * 8 + xcd) * 32; }
#define DQ_PLAIN(id) dyn_q(F, (id), F.bid & 7), 8, F.bid & 7
#define DQ_FLAT(id) dyn_q(F, (id), 0), 1, 0
__device__ __forceinline__ void ph_fbranch(Frame& F, int l) {
    const int M = (l == 0) ? TT : TL;
    pg8::SchedPlain S{(const char*)(F.ws + WS_OUTS), (const char*)(F.ws + WS_W + (size_t)l * WL_STRIDE + WO_B), DM / 2, 256, M / 256, 32, F.G, F.bid, 8, 512, DQ_PLAIN(l * 8 + 2)};
    pg8::EpiFp8 E{F.ws + WS_BV, 8192, BV_SCALE / (OUT_SCALE * GATE_WSCALE)};
    pg8::gemm_phase<pg8::EpiFp8, pg8::SchedPlain, false, true, true>(F.lds, F.tid, DM / 2, 256, 256, S, E);
}
__device__ __forceinline__ void ph_fgate(Frame& F, int l) {
    const int M = (l == 0) ? TT : TL;
    pg8::SchedPlain S{(const char*)(F.ws + WS_H8), (const char*)(F.ws + WS_W + (size_t)l * WL_STRIDE + WO_G), DM / 2, DM / 2, M / 256, 32, F.G, F.bid, 1 << 30, 0, DQ_PLAIN(l * 8 + 3)};
    pg8::EpiGate E{F.ws + WS_BV, F.in(25) + (size_t)l * 4 * DM, (bf16_t*)(F.ws + WS_ACC)};
    pg8::gemm_phase<pg8::EpiGate, pg8::SchedPlain, false, true, true>(F.lds, F.tid, DM / 2, DM / 2, DM / 2, S, E);
}
__device__ __forceinline__ void ph_fmoe_up(Frame& F, int l) {
    pg8::SchedMoe S{(const unsigned*)(F.ws + WS_CTL) + CW_ECNT + l * 16, (const int*)(F.ws + WS_ELIST), (const char*)(F.ws + WS_H8), (const char*)(F.ws + WS_W + (size_t)l * WL_STRIDE + WO_13), 4, F.G, F.bid,
                    (size_t)1024 * DM, (size_t)256 * DM, 0, true, DQ_FLAT(l * 8 + 5)};
    pg8::EpiSwiGLU E{(unsigned char*)(F.ws + WS_HID)};
    pg8::gemm_phase<pg8::EpiSwiGLU, pg8::SchedMoe, true, true, true>(F.lds, F.tid, DM / 2, DM / 2, DM / 2, S, E);
}
__device__ __forceinline__ void ph_fmoe_down(Frame& F, int l) {
    pg8::SchedMoe S{(const unsigned*)(F.ws + WS_CTL) + CW_ECNT + l * 16, (const int*)(F.ws + WS_ELIST), (const char*)(F.ws + WS_HID), (const char*)(F.ws + WS_W + (size_t)l * WL_STRIDE + WO_2), 8, F.G, F.bid,
                    (size_t)DM * DEXP, (size_t)256 * DEXP, (size_t)256 * DEXP, false, DQ_FLAT(l * 8 + 6)};
    pg8::EpiMoeDown E{(bf16_t*)(F.ws + WS_PROJ)};
    pg8::gemm_phase<pg8::EpiMoeDown, pg8::SchedMoe, false, true, true>(F.lds, F.tid, DEXP / 2, DEXP / 2, DEXP / 2, S, E);
}

namespace fa {
using bf16x8 = __attribute__((ext_vector_type(8))) short;
using s16x4 = __attribute__((ext_vector_type(4))) short;
using f32x16 = __attribute__((ext_vector_type(16))) float;
constexpr int NW = 8, QBLK = 32, KVBLK = 64;
constexpr float THR = 8.f;
#define FA_SBAR() __builtin_amdgcn_sched_barrier(0)
__device__ __forceinline__ int crow(int r, int hi) { return (r & 3) + 8 * (r >> 2) + 4 * hi; }
__device__ __forceinline__ unsigned cvtpk(float lo, float hi) { unsigned r; asm volatile("v_cvt_pk_bf16_f32 %0, %1, %2" : "=v"(r) : "v"(lo), "v"(hi)); return r; }
template <int DQK> __device__ __forceinline__ int kswz(int row, int colB) { return row * (DQK * 2) + (colB ^ ((row & 7) << 4)); }
__device__ __forceinline__ int v_st(int k, int c) { const int kk = (k & ~0xC) | ((k & 4) << 1) | ((k & 8) >> 1); return ((kk >> 3) * 4 + (c >> 5)) * 512 + ((kk & 7) * 32 + (c & 31)) * 2; }
__device__ __forceinline__ int v_rd_base(int lane) { return ((lane & 3) << 3) | (((lane >> 2) & 3) << 6) | (((lane >> 4) & 1) << 5) | (((lane >> 5) & 1) << 8); }
constexpr int v_rd_off(int d0, int ks, int half) { return d0 * 512 + ks * 4096 + half * 2048; }
template <int OFF> __device__ __forceinline__ s16x4 tr_read(int vb) { s16x4 r; asm volatile("ds_read_b64_tr_b16 %0, %1 offset:%2" : "=&v"(r) : "v"(vb), "i"(OFF) : "memory"); return r; }
template <int D0> __device__ __forceinline__ void pv_one(f32x16& od, int vb, bf16x8 pa0, bf16x8 pa1, bf16x8 pa2, bf16x8 pa3) {
    const s16x4 l0 = tr_read<v_rd_off(D0, 0, 0)>(vb), h0 = tr_read<v_rd_off(D0, 0, 1)>(vb), l1 = tr_read<v_rd_off(D0, 1, 0)>(vb), h1 = tr_read<v_rd_off(D0, 1, 1)>(vb);
    const s16x4 l2 = tr_read<v_rd_off(D0, 2, 0)>(vb), h2 = tr_read<v_rd_off(D0, 2, 1)>(vb), l3 = tr_read<v_rd_off(D0, 3, 0)>(vb), h3 = tr_read<v_rd_off(D0, 3, 1)>(vb);
    asm volatile("s_waitcnt lgkmcnt(0)" ::: "memory"); FA_SBAR();
#define FA_PK(L, H) (bf16x8){L[0], L[1], L[2], L[3], H[0], H[1], H[2], H[3]}
    od = __builtin_amdgcn_mfma_f32_32x32x16_bf16(pa0, FA_PK(l0, h0), od, 0, 0, 0);
    od = __builtin_amdgcn_mfma_f32_32x32x16_bf16(pa1, FA_PK(l1, h1), od, 0, 0, 0);
    od = __builtin_amdgcn_mfma_f32_32x32x16_bf16(pa2, FA_PK(l2, h2), od, 0, 0, 0);
    od = __builtin_amdgcn_mfma_f32_32x32x16_bf16(pa3, FA_PK(l3, h3), od, 0, 0, 0);
#undef FA_PK
}
__device__ __forceinline__ void pv_d0(f32x16* o, int vb, bf16x8 pa0, bf16x8 pa1, bf16x8 pa2, bf16x8 pa3) {
    pv_one<0>(o[0], vb, pa0, pa1, pa2, pa3); pv_one<1>(o[1], vb, pa0, pa1, pa2, pa3); pv_one<2>(o[2], vb, pa0, pa1, pa2, pa3); pv_one<3>(o[3], vb, pa0, pa1, pa2, pa3);
}
__device__ __forceinline__ void partialSM(f32x16& p0, f32x16& p1, float& m_reg, float& mn, float& alpha, const float C, const float thr_raw) {
    float pmax = p0[0];
#pragma unroll
    for (int r = 1; r < 16; ++r) pmax = fmaxf(pmax, p0[r]);
#pragma unroll
    for (int r = 0; r < 16; ++r) pmax = fmaxf(pmax, p1[r]);
    { auto rr = __builtin_amdgcn_permlane32_swap(__float_as_uint(pmax), __float_as_uint(pmax), false, false); pmax = fmaxf(__uint_as_float(rr[0]), __uint_as_float(rr[1])); }
    if (__builtin_expect(__all(pmax - m_reg <= thr_raw), 1)) { mn = m_reg; alpha = 1.f; }
    else { mn = fmaxf(m_reg, pmax); alpha = __builtin_amdgcn_exp2f((m_reg - mn) * C); m_reg = mn; }
    const float mnC = -mn * C;
#pragma unroll
    for (int r = 0; r < 16; ++r) p0[r] = fmaf(p0[r], C, mnC);
#pragma unroll
    for (int r = 0; r < 16; ++r) p1[r] = fmaf(p1[r], C, mnC);
#pragma unroll
    for (int r = 0; r < 16; ++r) p0[r] = __builtin_amdgcn_exp2f(p0[r]);
}
__device__ __forceinline__ void finishSM(f32x16& p0, f32x16& p1, float alpha, float& l_reg, bf16x8& pa0, bf16x8& pa1, bf16x8& pa2, bf16x8& pa3) {
#pragma unroll
    for (int r = 0; r < 16; ++r) p1[r] = __builtin_amdgcn_exp2f(p1[r]);
    float ps = 0;
#pragma unroll
    for (int r = 0; r < 16; ++r) ps += p0[r];
#pragma unroll
    for (int r = 0; r < 16; ++r) ps += p1[r];
    { auto rr = __builtin_amdgcn_permlane32_swap(__float_as_uint(ps), __float_as_uint(ps), false, false); ps = __uint_as_float(rr[0]) + __uint_as_float(rr[1]); }
    l_reg = l_reg * alpha + ps;
#define FA_PK4(P, BASE, OUT) do { unsigned a0 = cvtpk(P[BASE + 0], P[BASE + 1]), a1 = cvtpk(P[BASE + 2], P[BASE + 3]);   \
    unsigned b0 = cvtpk(P[BASE + 4], P[BASE + 5]), b1 = cvtpk(P[BASE + 6], P[BASE + 7]);                              \
    auto r0 = __builtin_amdgcn_permlane32_swap(a0, b0, false, false); auto r1 = __builtin_amdgcn_permlane32_swap(a1, b1, false, false); \
    u32x4 w = {r0[0], r1[0], r0[1], r1[1]}; OUT = *reinterpret_cast<bf16x8*>(&w); } while (0)
    FA_PK4(p0, 0, pa0); FA_PK4(p0, 8, pa1); FA_PK4(p1, 0, pa2); FA_PK4(p1, 8, pa3);
#undef FA_PK4
}
template <int DQK> __device__ __forceinline__ void qkt(f32x16& p0, f32x16& p1, const char* Ks, const bf16x8* qr, const char* qx, int r32, int hi) {
    p0 = f32x16{}; p1 = f32x16{};
#pragma unroll
    for (int d0 = 0; d0 < DQK / 16; ++d0) { const int cb = (d0 * 16 + hi * 8) * 2;
        const bf16x8 b0 = *reinterpret_cast<const bf16x8*>(Ks + kswz<DQK>(r32, cb));
        const bf16x8 b1 = *reinterpret_cast<const bf16x8*>(Ks + kswz<DQK>(32 + r32, cb));
        const bf16x8 q = d0 < 8 ? qr[d0 < 8 ? d0 : 0] : *reinterpret_cast<const bf16x8*>(qx + (d0 - 8) * 1024);
        p0 = __builtin_amdgcn_mfma_f32_32x32x16_bf16(b0, q, p0, 0, 0, 0);
        p1 = __builtin_amdgcn_mfma_f32_32x32x16_bf16(b1, q, p1, 0, 0, 0);
        if (DQK == 192 && (d0 & 3) == 3) FA_SBAR(); }
}
struct Tiles {
    int nctx_t;
    int ctx_row0;
    int lat_row0;
    int NT;
    __device__ __forceinline__ int krow(int t) const { return t < nctx_t ? ctx_row0 + t * KVBLK : lat_row0 + (t - nctx_t) * KVBLK; }
};
constexpr float NEGM = -1e30f;
template <int MODE> __device__ __forceinline__ void mask_tile(f32x16& p0, f32x16& p1, int t, const Tiles& T, int q_a, int q_b, int k_a, int hi, const float* rpbL) {
    if (MODE == 0 || t < T.nctx_t) return;
    const int tl = t - T.nctx_t;
    if (MODE == 1) {
        const int kb = k_a + tl * KVBLK + 4 * hi - q_a;
#pragma unroll
        for (int r = 0; r < 16; ++r) { const int d0 = kb + (r & 3) + 8 * (r >> 2), d1 = d0 + 32;
            if (d0 > 128 || d0 < -128) p0[r] = NEGM; if (d1 > 128 || d1 < -128) p1[r] = NEGM; }
    } else {
        const int kr = k_a + tl;
        const int rs = min(max(q_a - 4, 0), 128 - 8), cs = min(max(q_b - 8, 0), 64 - 16);
        const bool rok = (kr >= rs) && (kr < rs + 8);
        const float* brow = rpbL + (kr - q_a + 7) * 31 + (15 - q_b);
#pragma unroll
        for (int r = 0; r < 16; ++r) { const int c0 = 4 * hi + (r & 3) + 8 * (r >> 2), c1 = c0 + 32;
            const bool ok0 = rok && c0 >= cs && c0 < cs + 16, ok1 = rok && c1 >= cs && c1 < cs + 16;
            p0[r] = ok0 ? p0[r] + brow[c0] : NEGM; p1[r] = ok1 ? p1[r] + brow[c1] : NEGM;
            if ((r & 3) == 3) asm volatile("" ::: "memory"); }
    }
}

template <int DQK, int SDEPTH, int MODE, int LDQ, int LDK, int LDV>
__device__ __forceinline__ void attn_unit(const bf16_t* __restrict__ Qb, const bf16_t* __restrict__ Kb, const bf16_t* __restrict__ Vb,
                                          bf16_t* __restrict__ Ob, const Tiles T, const float scale, const bool has_sink, const float sink,
                                          const int q_a0, const int k_a, const float* rpbL, char* lds, const int tid_in) {
    constexpr int LDO = DM;
    int tid = tid_in; asm volatile("" : "+v"(tid));
    constexpr int SHM_V = KVBLK * 128 * 2, SHM_K = KVBLK * DQK * 2;
    constexpr int KCH = DQK / 8 * KVBLK / 512;
    const int wid = tid >> 6, lane = tid & 63, r32 = lane & 31, hi = lane >> 5;
    char* V_lds = lds; char* K_lds = lds + 2 * SHM_V;
    float* ws = (float*)(lds + 2 * SHM_V + 2 * SHM_K) + wid * 64; float* li_l = ws; float* al_l = ws + 32;
    const float C = scale * 1.4426950408889634f, thr_raw = THR / scale;
    float m_reg = -1e30f, l_reg = 0; f32x16 o[4] = {}; bf16x8 qr[8];
    const bf16_t* Qw = Qb + (size_t)(wid * QBLK + r32) * LDQ + hi * 8;
#pragma unroll
    for (int d0 = 0; d0 < 8; ++d0) qr[d0] = *reinterpret_cast<const bf16x8*>(Qw + d0 * 16);
    char* qx = lds + 2 * SHM_V + 2 * SHM_K + NW * 256 + wid * 4096 + lane * 16;
    if constexpr (DQK == 192) {
#pragma unroll
        for (int d0 = 8; d0 < 12; ++d0) *(bf16x8*)(qx + (d0 - 8) * 1024) = *reinterpret_cast<const bf16x8*>(Qw + d0 * 16);
    }
    const int sr = tid >> 4, sc = (tid & 15) * 8, vst0 = v_st(sr, sc), vst1 = v_st(32 + sr, sc);
    int krw[KCH], kcb[KCH];
#pragma unroll
    for (int i = 0; i < KCH; ++i) { const int id = tid + 512 * i; krw[i] = id / (DQK / 8); kcb[i] = (id % (DQK / 8)) * 16; }
    const int vb0 = (int)(uintptr_t)V_lds + v_rd_base(lane);
    struct { bf16x8 vs0, vs1, ks[KCH]; } sr_[SDEPTH];
    const char* Vp = (const char*)(Vb + (size_t)sr * LDV + sc);
    const char* Kp[KCH];
#pragma unroll
    for (int c_ = 0; c_ < KCH; ++c_) Kp[c_] = (const char*)Kb + (size_t)krw[c_] * LDK * 2 + kcb[c_];
#define FA_SLOAD(i, t) do { const size_t kr_ = (size_t)T.krow(t); sr_[i].vs0 = *reinterpret_cast<const bf16x8*>(Vp + kr_ * (LDV * 2)); sr_[i].vs1 = *reinterpret_cast<const bf16x8*>(Vp + (kr_ + 32) * (LDV * 2)); \
    _Pragma("unroll") for (int c_ = 0; c_ < KCH; ++c_) sr_[i].ks[c_] = *reinterpret_cast<const bf16x8*>(Kp[c_] + kr_ * (LDK * 2)); } while (0)
#define FA_SWRITE(b, i) do { *(bf16x8*)(V_lds + (b) * SHM_V + vst0) = sr_[i].vs0; *(bf16x8*)(V_lds + (b) * SHM_V + vst1) = sr_[i].vs1; \
    _Pragma("unroll") for (int c_ = 0; c_ < KCH; ++c_) *(bf16x8*)(K_lds + (b) * SHM_K + kswz<DQK>(krw[c_], kcb[c_])) = sr_[i].ks[c_]; } while (0)
#define FA_SWAIT() do { if constexpr (SDEPTH == 2) { if constexpr (KCH == 2) asm volatile("s_waitcnt vmcnt(4)" ::: "memory"); else asm volatile("s_waitcnt vmcnt(5)" ::: "memory"); } else asm volatile("s_waitcnt vmcnt(0)" ::: "memory"); } while (0)
#define FA_RESC(a) do { if (__any((a) < 1.f)) { if (hi == 0) al_l[r32] = (a); asm volatile("s_waitcnt lgkmcnt(0)" ::: "memory"); \
    _Pragma("unroll") for (int d = 0; d < 4; ++d) _Pragma("unroll") for (int r = 0; r < 16; ++r) o[d][r] *= al_l[crow(r, hi)]; } } while (0)
    const int q_a = (MODE == 1) ? q_a0 + wid * QBLK + r32 : q_a0 + ((wid * QBLK + r32) >> 6), q_b = (wid * QBLK + r32) & 63;
#define FA_MASK(P0, P1, t) mask_tile<MODE>(P0, P1, t, T, q_a, q_b, k_a, hi, rpbL)
    f32x16 pA0, pA1, pB0, pB1; float mnA, mnB, alA, alB; bf16x8 pa0, pa1, pa2, pa3; const int NT = T.NT;
    constexpr int SE = 0, SO = SDEPTH - 1;
    FA_SLOAD(SE, 0); asm volatile("s_waitcnt vmcnt(0)" ::: "memory"); FA_SWRITE(0, SE); __syncthreads();
    qkt<DQK>(pA0, pA1, K_lds, qr, qx, r32, hi); FA_MASK(pA0, pA1, 0); partialSM(pA0, pA1, m_reg, mnA, alA, C, thr_raw);
    FA_SLOAD(SO, 1); if constexpr (SDEPTH == 2) { if (2 < NT) FA_SLOAD(SE, 2); }
    FA_SWAIT(); FA_SWRITE(1, SO); __syncthreads();
    for (int j = 1; j + 1 < NT; j += 2) {
        FA_SBAR(); qkt<DQK>(pB0, pB1, K_lds + SHM_K, qr, qx, r32, hi); FA_MASK(pB0, pB1, j);
        finishSM(pA0, pA1, alA, l_reg, pa0, pa1, pa2, pa3); FA_SBAR();
        FA_SLOAD(SO, j + SDEPTH); FA_SBAR();
        pv_d0(o, vb0, pa0, pa1, pa2, pa3); partialSM(pB0, pB1, m_reg, mnB, alB, C, thr_raw);
        __syncthreads(); FA_SWAIT(); FA_SWRITE(0, SE);
        FA_RESC(alB); __syncthreads();
        FA_SBAR(); qkt<DQK>(pA0, pA1, K_lds, qr, qx, r32, hi); FA_MASK(pA0, pA1, j + 1);
        finishSM(pB0, pB1, alB, l_reg, pa0, pa1, pa2, pa3); FA_SBAR();
        if (SDEPTH == 1 || j + 3 < NT) FA_SLOAD(SE, j + 1 + SDEPTH); FA_SBAR();
        pv_d0(o, vb0 + SHM_V, pa0, pa1, pa2, pa3); partialSM(pA0, pA1, m_reg, mnA, alA, C, thr_raw);
        __syncthreads(); FA_SWAIT(); FA_SWRITE(1, SO);
        FA_RESC(alA); __syncthreads();
    }
    FA_SBAR(); qkt<DQK>(pB0, pB1, K_lds + SHM_K, qr, qx, r32, hi); FA_MASK(pB0, pB1, NT - 1);
    finishSM(pA0, pA1, alA, l_reg, pa0, pa1, pa2, pa3); FA_SBAR();
    pv_d0(o, vb0, pa0, pa1, pa2, pa3); partialSM(pB0, pB1, m_reg, mnB, alB, C, thr_raw);
    __syncthreads(); FA_RESC(alB);
    finishSM(pB0, pB1, alB, l_reg, pa0, pa1, pa2, pa3); FA_SBAR();
    pv_d0(o, vb0 + SHM_V, pa0, pa1, pa2, pa3);
    if (has_sink) l_reg += __builtin_amdgcn_exp2f(sink * 1.4426950408889634f - m_reg * C);
    if (hi == 0) li_l[r32] = l_reg; asm volatile("s_waitcnt lgkmcnt(0)" ::: "memory");
    float rli[16];
#pragma unroll
    for (int r = 0; r < 16; ++r) rli[r] = __builtin_amdgcn_rcpf(li_l[crow(r, hi)]);
    __syncthreads();
    int tid2 = tid_in; asm volatile("" : "+v"(tid2));
    const int lane2 = tid2 & 63, wid2 = tid2 >> 6;
    bf16_t* stg = (bf16_t*)(lds + wid2 * (32 * 272));
#pragma unroll
    for (int r = 0; r < 16; ++r) { const int orow = crow(r, hi);
#pragma unroll
        for (int d0 = 0; d0 < 4; ++d0) stg[orow * 136 + d0 * 32 + r32] = (bf16_t)f2bf(o[d0][r] * rli[r]); }
    asm volatile("s_waitcnt lgkmcnt(0)" ::: "memory");
    bf16_t* Ow = Ob + (size_t)(wid2 * QBLK) * LDO;
#pragma unroll
    for (int i = 0; i < 8; ++i) { const int row = i * 4 + (lane2 >> 4), ch = lane2 & 15; const u32x4 v = *(const u32x4*)(stg + row * 136 + ch * 8); *(u32x4*)(Ow + (size_t)row * LDO + ch * 8) = v; }
    __syncthreads();
#undef FA_SLOAD
#undef FA_SWRITE
#undef FA_SWAIT
#undef FA_RESC
#undef FA_MASK
}

template <int LDQ, int LDK, int LDV>
__device__ __forceinline__ void attn_unit_sp192(const bf16_t* __restrict__ Qb, const bf16_t* __restrict__ Kb, const bf16_t* __restrict__ Vb, bf16_t* __restrict__ Ob, const Tiles T, const float scale, char* lds, const int tid_in) {
    constexpr int DQK = 192, LDO = DM, SHM_V = KVBLK * 128 * 2, SHM_K = KVBLK * DQK * 2, KCH = 3;
    int tid = tid_in; asm volatile("" : "+v"(tid));
    const int wid = tid >> 6, lane = tid & 63, r32 = lane & 31, hi = lane >> 5;
    char* V_lds = lds; char* K_lds = lds + 2 * SHM_V;
    float* ws = (float*)(lds + 2 * SHM_V + 2 * SHM_K) + wid * 64; float* li_l = ws; float* al_l = ws + 32;
    const float C = scale * 1.4426950408889634f, thr_raw = THR / scale;
    float m_reg = -1e30f, l_reg = 0; f32x16 o[4] = {}; bf16x8 qr[12];
    const bf16_t* Qw = Qb + (size_t)(wid * QBLK + r32) * LDQ + hi * 8;
#pragma unroll
    for (int d0 = 0; d0 < 12; ++d0) qr[d0] = *reinterpret_cast<const bf16x8*>(Qw + d0 * 16);
    const int sr = tid >> 4, sc = (tid & 15) * 8, vst0 = v_st(sr, sc), vst1 = v_st(32 + sr, sc);
    int krw[KCH], kcb[KCH];
#pragma unroll
    for (int i = 0; i < KCH; ++i) { const int id = tid + 512 * i; krw[i] = id / 24; kcb[i] = (id % 24) * 16; }
    const int vb0 = (int)(uintptr_t)V_lds + v_rd_base(lane);
    const char* Vp = (const char*)(Vb + (size_t)sr * LDV + sc);
    const char* Kp[KCH];
#pragma unroll
    for (int c_ = 0; c_ < KCH; ++c_) Kp[c_] = (const char*)Kb + (size_t)krw[c_] * LDK * 2 + kcb[c_];
    bf16x8 vs0, vs1, ks[KCH];
#define FB_SLOAD(t) do { const size_t kr_ = (size_t)T.krow(t); vs0 = *reinterpret_cast<const bf16x8*>(Vp + kr_ * (LDV * 2)); vs1 = *reinterpret_cast<const bf16x8*>(Vp + (kr_ + 32) * (LDV * 2)); \
    _Pragma("unroll") for (int c_ = 0; c_ < KCH; ++c_) ks[c_] = *reinterpret_cast<const bf16x8*>(Kp[c_] + kr_ * (LDK * 2)); } while (0)
#define FB_SWRITE(b) do { *(bf16x8*)(V_lds + (b) * SHM_V + vst0) = vs0; *(bf16x8*)(V_lds + (b) * SHM_V + vst1) = vs1; \
    _Pragma("unroll") for (int c_ = 0; c_ < KCH; ++c_) *(bf16x8*)(K_lds + (b) * SHM_K + kswz<DQK>(krw[c_], kcb[c_])) = ks[c_]; } while (0)
    const int NT = T.NT;
    FB_SLOAD(0); asm volatile("s_waitcnt vmcnt(0)" ::: "memory"); FB_SWRITE(0); __syncthreads();
    for (int j = 0; j < NT; ++j) {
        const int b = j & 1;
        if (j + 1 < NT) FB_SLOAD(j + 1);
        __builtin_amdgcn_sched_barrier(0);
        f32x16 p0 = f32x16{}, p1 = f32x16{};
        { const char* Ks = K_lds + b * SHM_K;
#pragma unroll
          for (int d0 = 0; d0 < 12; ++d0) { const int cb = (d0 * 16 + hi * 8) * 2;
              const bf16x8 b0 = *reinterpret_cast<const bf16x8*>(Ks + kswz<DQK>(r32, cb));
              const bf16x8 b1 = *reinterpret_cast<const bf16x8*>(Ks + kswz<DQK>(32 + r32, cb));
              p0 = __builtin_amdgcn_mfma_f32_32x32x16_bf16(b0, qr[d0], p0, 0, 0, 0);
              p1 = __builtin_amdgcn_mfma_f32_32x32x16_bf16(b1, qr[d0], p1, 0, 0, 0); } }
        float mn, al; bf16x8 pa0, pa1, pa2, pa3;
        partialSM(p0, p1, m_reg, mn, al, C, thr_raw);
        if (__any(al < 1.f)) { if (hi == 0) al_l[r32] = al; asm volatile("s_waitcnt lgkmcnt(0)" ::: "memory");
#pragma unroll
            for (int d = 0; d < 4; ++d)
#pragma unroll
                for (int r = 0; r < 16; ++r) o[d][r] *= al_l[crow(r, hi)]; }
        finishSM(p0, p1, al, l_reg, pa0, pa1, pa2, pa3);
        __builtin_amdgcn_sched_barrier(0);
        pv_d0(o, vb0 + b * SHM_V, pa0, pa1, pa2, pa3);
        if (j + 1 < NT) { asm volatile("s_waitcnt vmcnt(0)" ::: "memory"); FB_SWRITE(b ^ 1); }
        __syncthreads();
    }
    if (hi == 0) li_l[r32] = l_reg; asm volatile("s_waitcnt lgkmcnt(0)" ::: "memory");
    float rli[16];
#pragma unroll
    for (int r = 0; r < 16; ++r) rli[r] = __builtin_amdgcn_rcpf(li_l[crow(r, hi)]);
    __syncthreads();
    int tid2 = tid_in; asm volatile("" : "+v"(tid2));
    const int lane2 = tid2 & 63, wid2 = tid2 >> 6;
    bf16_t* stg = (bf16_t*)(lds + wid2 * (32 * 272));
#pragma unroll
    for (int r = 0; r < 16; ++r) { const int orow = crow(r, hi);
#pragma unroll
        for (int d0 = 0; d0 < 4; ++d0) stg[orow * 136 + d0 * 32 + r32] = (bf16_t)f2bf(o[d0][r] * rli[r]); }
    asm volatile("s_waitcnt lgkmcnt(0)" ::: "memory");
    bf16_t* Ow = Ob + (size_t)(wid2 * QBLK) * LDO;
#pragma unroll
    for (int i = 0; i < 8; ++i) { const int row = i * 4 + (lane2 >> 4), ch = lane2 & 15; const u32x4 v = *(const u32x4*)(stg + row * 136 + ch * 8); *(u32x4*)(Ow + (size_t)row * LDO + ch * 8) = v; }
    __syncthreads();
#undef FB_SLOAD
#undef FB_SWRITE
}
#undef FA_SBAR
}

namespace fa8 {
typedef int v8i_t __attribute__((ext_vector_type(8)));
typedef int v4i_t __attribute__((ext_vector_type(4)));
using fa::f32x16; using fa::crow;
constexpr int VP = 80;
constexpr float THR8 = 3.f, POFF = 4.f;
struct Tiles8 {
    int nctx_t, ctx_row0, lat_row0, NT, vk_lat0;
    __device__ __forceinline__ int krow(int t) const { return t < nctx_t ? ctx_row0 + t * 64 : lat_row0 + (t - nctx_t) * 64; }
    __device__ __forceinline__ int vkey(int t) const { return t < nctx_t ? t * 64 : vk_lat0 + (t - nctx_t) * 64; }
};
#define FA8_SBAR() __builtin_amdgcn_sched_barrier(0)
#define FA8_MFMA(a, b, c) __builtin_amdgcn_mfma_scale_f32_32x32x64_f8f6f4(a, b, c, 0, 0, 0, 0x7f7f7f7f, 0, 0x7f7f7f7f)
#define FA8_LD32(p) __builtin_shufflevector(*(const v4i_t*)(p), *(const v4i_t*)((p) + 16), 0, 1, 2, 3, 4, 5, 6, 7)
#define FA8_MX3(a, b, c) __builtin_fmaxf(__builtin_fmaxf((a), (b)), (c))
typedef short v2s_t __attribute__((ext_vector_type(2)));
template <bool FIRST>
__device__ __forceinline__ void partialSM8(f32x16& p0, f32x16& p1, float& m_reg, float& alpha, float& scl, const float thr2) {
    float pa_ = FA8_MX3(p0[0], p0[1], p1[0]), pb_ = FA8_MX3(p0[2], p0[3], p1[1]); pa_ = FA8_MX3(pa_, p1[2], p1[3]);
#pragma unroll
    for (int r = 4; r < 16; r += 4) { pa_ = FA8_MX3(pa_, p0[r], p0[r + 1]); pb_ = FA8_MX3(pb_, p0[r + 2], p0[r + 3]); pa_ = FA8_MX3(pa_, p1[r], p1[r + 1]); pb_ = FA8_MX3(pb_, p1[r + 2], p1[r + 3]); }
    float pmax = __builtin_fmaxf(pa_, pb_);
    { auto rr = __builtin_amdgcn_permlane32_swap(__float_as_uint(pmax), __float_as_uint(pmax), false, false); pmax = fmaxf(__uint_as_float(rr[0]), __uint_as_float(rr[1])); }
    if (!FIRST && __builtin_expect(__all(pmax - m_reg <= thr2), 1)) { alpha = 1.f; }
    else {
        const float mn = (FIRST || pmax - m_reg > thr2) ? __builtin_ceilf(pmax) : m_reg;
        alpha = FIRST ? 0.f : __builtin_ldexpf(1.0f, (int)(m_reg - mn));
        m_reg = mn;
        scl = __builtin_ldexpf(1.0f, SCL_DIV ? (int)(mn - POFF) : (int)(POFF - mn));
    }
#if VALU_PROBE
#pragma unroll
    for (int r = 0; r < 16; ++r) { asm volatile("v_mul_f32 %0, 1.0, %0" : "+v"(p0[r])); asm volatile("v_mul_f32 %0, 1.0, %0" : "+v"(p1[r])); }
#endif
#pragma unroll
    for (int r = 0; r < 16; ++r) p0[r] = __builtin_amdgcn_exp2f(p0[r]);
}
__device__ __forceinline__ void finishSM8(f32x16& p0, f32x16& p1, float& l_reg, v8i_t& pa, const float scl) {
#pragma unroll
    for (int r = 0; r < 16; ++r) p1[r] = __builtin_amdgcn_exp2f(p1[r]);
    float ps = 0;
#pragma unroll
    for (int r = 0; r < 16; ++r) ps += p0[r];
#pragma unroll
    for (int r = 0; r < 16; ++r) ps += p1[r];
    { auto rr = __builtin_amdgcn_permlane32_swap(__float_as_uint(ps), __float_as_uint(ps), false, false); ps = __uint_as_float(rr[0]) + __uint_as_float(rr[1]); }
    l_reg += ps;
#pragma unroll
    for (int k = 0; k < 4; ++k) { v2s_t w = __builtin_bit_cast(v2s_t, p0[4 * k]);
        w = __builtin_amdgcn_cvt_scalef32_pk_fp8_f32(w, p0[4 * k], p0[4 * k + 1], scl, false); w = __builtin_amdgcn_cvt_scalef32_pk_fp8_f32(w, p0[4 * k + 2], p0[4 * k + 3], scl, true); pa[k] = __builtin_bit_cast(int, w); }
#pragma unroll
    for (int k = 0; k < 4; ++k) { v2s_t w = __builtin_bit_cast(v2s_t, p1[4 * k]);
        w = __builtin_amdgcn_cvt_scalef32_pk_fp8_f32(w, p1[4 * k], p1[4 * k + 1], scl, false); w = __builtin_amdgcn_cvt_scalef32_pk_fp8_f32(w, p1[4 * k + 2], p1[4 * k + 3], scl, true); pa[4 + k] = __builtin_bit_cast(int, w); }
}
template <int DQK> __device__ __forceinline__ void qkt8(f32x16& p0, f32x16& p1, const char* Ks, const v8i_t* qf, int r32, int hi) {
    constexpr int KP = DQK + 16;
    p0 = f32x16{}; p1 = f32x16{};
#pragma unroll
    for (int c = 0; c < DQK / 64; ++c) {
        const v8i_t a0 = FA8_LD32(Ks + r32 * KP + c * 64 + hi * 32);
        const v8i_t a1 = FA8_LD32(Ks + (32 + r32) * KP + c * 64 + hi * 32);
        p0 = FA8_MFMA(a0, qf[c], p0);
        p1 = FA8_MFMA(a1, qf[c], p1); }
}
__device__ __forceinline__ void pv8(f32x16* o, const char* Vs, const v8i_t pa, int r32, int hi) {
#pragma unroll
    for (int n = 0; n < 4; ++n) { const v8i_t b = FA8_LD32(Vs + (32 * n + r32) * VP + hi * 32); o[n] = FA8_MFMA(pa, b, o[n]); }
}

template <int DQK, int SDEPTH, int MODE>
__device__ __forceinline__ void attn_unit8(const unsigned char* __restrict__ Qb, const unsigned char* __restrict__ Kb, const unsigned char* __restrict__ Vt, bf16_t* __restrict__ Ob,
                                           const Tiles8 T, const float scale, const bool has_sink, const float sink, const int q_a0, const int k_a, const float* rpbL, char* lds, const int tid_in) {
    constexpr int LDO = DM, KP = DQK + 16, SHM_K = 64 * KP, SHM_V = 128 * VP;
    int tid = tid_in; asm volatile("" : "+v"(tid));
    const int wid = tid >> 6, lane = tid & 63, r32 = lane & 31, hi = lane >> 5;
    char* K_lds = lds; char* V_lds = lds + 3 * SHM_K;
    float* ws = (float*)(lds + 3 * SHM_K + 3 * SHM_V) + wid * 64; float* li_l = ws; float* al_l = ws + 32;
    const float thr2 = THR8 * 1.4426950408889634f;
    float m_reg = 0.f, l_reg = 0, scl = 1.f; f32x16 o[4] = {}; v8i_t qf[DQK / 64];
    { const unsigned char* Qw = Qb + (size_t)(wid * 32 + r32) * Q8P + hi * 32;
#pragma unroll
      for (int c = 0; c < DQK / 64; ++c) qf[c] = FA8_LD32(Qw + c * 64); }
    constexpr int PS = (DQK == 128) ? 16 : 8, PPR = DQK / PS, KCH = 64 * PPR / 512;
    typedef unsigned kpiece_t __attribute__((ext_vector_type(PS / 4)));
    const int krow_ = (tid * KCH) / PPR, kpc_ = (tid * KCH) % PPR; const int kdst0 = krow_ * KP + kpc_ * PS; const unsigned char* Kp0 = Kb + (size_t)krow_ * K8P + kpc_ * PS;
    const int vdst = (tid >> 2) * VP + (tid & 3) * 16; const unsigned char* Vp = Vt + (size_t)(tid >> 2) * VTP + (tid & 3) * 16;
    struct { kpiece_t ks[KCH]; u32x4 vs; } sr_[SDEPTH];
#define FA8_SLOAD(i, t) do { const size_t kr_ = (size_t)T.krow(t); const int vk_ = T.vkey(t); sr_[i].vs = *(const u32x4*)(Vp + vk_); \
    _Pragma("unroll") for (int c_ = 0; c_ < KCH; ++c_) sr_[i].ks[c_] = *(const kpiece_t*)(Kp0 + kr_ * K8P + c_ * PS); } while (0)
#define FA8_SWRITE(b, i) do { *(u32x4*)(V_lds + (b) * SHM_V + vdst) = sr_[i].vs; \
    _Pragma("unroll") for (int c_ = 0; c_ < KCH; ++c_) *(kpiece_t*)(K_lds + (b) * SHM_K + kdst0 + c_ * PS) = sr_[i].ks[c_]; } while (0)
#define FA8_SWAIT() do { if constexpr (KCH == 1) asm volatile("s_waitcnt vmcnt(2)" ::: "memory"); else asm volatile("s_waitcnt vmcnt(4)" ::: "memory"); } while (0)
#define FA8_RESC(a) do { if (__any((a) < 1.f)) { if (hi == 0) al_l[r32] = (a); asm volatile("s_waitcnt lgkmcnt(0)" ::: "memory"); \
    _Pragma("unroll") for (int d = 0; d < 4; ++d) _Pragma("unroll") for (int r = 0; r < 16; ++r) o[d][r] *= al_l[crow(r, hi)]; } } while (0)
    const int q_a = (MODE == 1) ? q_a0 + wid * 32 + r32 : q_a0 + ((wid * 32 + r32) >> 6), q_b = (wid * 32 + r32) & 63;
    const fa::Tiles TM{T.nctx_t, 0, 0, T.NT};
#define FA8_MASK(P0, P1, t) fa::mask_tile<MODE>(P0, P1, t, TM, q_a, q_b, k_a, hi, rpbL)
    f32x16 pA0, pA1, pB0, pB1; float alA, alB; v8i_t pa; const int NT = T.NT;
    constexpr int SE = 0, SO = SDEPTH - 1;
    static_assert(SDEPTH == 2, "the three-slot ring is written for two-deep register staging");
    FA8_SLOAD(SE, 0); asm volatile("s_waitcnt vmcnt(0)" ::: "memory"); FA8_SWRITE(0, SE); __syncthreads();
    qkt8<DQK>(pA0, pA1, K_lds, qf, r32, hi); FA8_MASK(pA0, pA1, 0); partialSM8<true>(pA0, pA1, m_reg, alA, scl, thr2);
    FA8_SLOAD(SO, 1); if (2 < NT) FA8_SLOAD(SE, 2);
    FA8_SWAIT(); FA8_SWRITE(1, SO); __syncthreads();
    int s_m = 0, s_c = 1, s_p = 2;
    for (int j = 1; j + 1 < NT; j += 2) {
        FA8_SBAR(); qkt8<DQK>(pB0, pB1, K_lds + s_c * SHM_K, qf, r32, hi); FA8_MASK(pB0, pB1, j);
        finishSM8(pA0, pA1, l_reg, pa, scl); FA8_SBAR();
        FA8_SLOAD(SO, j + 2); FA8_SBAR();
        pv8(o, V_lds + s_m * SHM_V, pa, r32, hi); partialSM8<false>(pB0, pB1, m_reg, alB, scl, thr2);
        FA8_SWAIT(); FA8_SWRITE(s_p, SE);
        FA8_RESC(alB); __syncthreads();
        FA8_SBAR(); qkt8<DQK>(pA0, pA1, K_lds + s_p * SHM_K, qf, r32, hi); FA8_MASK(pA0, pA1, j + 1);
        finishSM8(pB0, pB1, l_reg, pa, scl); FA8_SBAR();
        if (j + 3 < NT) FA8_SLOAD(SE, j + 3); FA8_SBAR();
        pv8(o, V_lds + s_c * SHM_V, pa, r32, hi); partialSM8<false>(pA0, pA1, m_reg, alA, scl, thr2);
        FA8_SWAIT(); FA8_SWRITE(s_m, SO);
        FA8_RESC(alA); __syncthreads();
        { const int t0 = s_m; s_m = s_p; s_p = s_c; s_c = t0; }
    }
    FA8_SBAR(); qkt8<DQK>(pB0, pB1, K_lds + s_c * SHM_K, qf, r32, hi); FA8_MASK(pB0, pB1, NT - 1);
    finishSM8(pA0, pA1, l_reg, pa, scl); FA8_SBAR();
    pv8(o, V_lds + s_m * SHM_V, pa, r32, hi); partialSM8<false>(pB0, pB1, m_reg, alB, scl, thr2);
    FA8_RESC(alB);
    finishSM8(pB0, pB1, l_reg, pa, scl); FA8_SBAR();
    pv8(o, V_lds + s_c * SHM_V, pa, r32, hi);
    if (has_sink) l_reg += __builtin_amdgcn_exp2f(sink * 1.4426950408889634f);
    l_reg = SCL_DIV ? l_reg * __builtin_amdgcn_rcpf(scl) : l_reg * scl;
    if (hi == 0) li_l[r32] = l_reg; asm volatile("s_waitcnt lgkmcnt(0)" ::: "memory");
    float rli[16];
#pragma unroll
    for (int r = 0; r < 16; ++r) rli[r] = __builtin_amdgcn_rcpf(li_l[crow(r, hi)]);
    __syncthreads();
    int tid2 = tid_in; asm volatile("" : "+v"(tid2));
    const int lane2 = tid2 & 63, wid2 = tid2 >> 6;
    unsigned char* stg = (unsigned char*)(lds + wid2 * (32 * 144));
#pragma unroll
    for (int r = 0; r < 16; ++r) { const int orow = crow(r, hi); const float sc_ = rli[r] * OUT_SCALE;
#pragma unroll
        for (int d0 = 0; d0 < 4; d0 += 2) { int w = 0; w = cvt8s(o[d0][r] * sc_, o[d0 + 1][r] * sc_, w, false);
            stg[orow * 144 + d0 * 32 + r32] = (unsigned char)w; stg[orow * 144 + (d0 + 1) * 32 + r32] = (unsigned char)(w >> 8); } }
    asm volatile("s_waitcnt lgkmcnt(0)" ::: "memory");
    unsigned char* Ow = (unsigned char*)Ob + (size_t)(wid2 * 32) * LDO;
#pragma unroll
    for (int i = 0; i < 4; ++i) { const int row = i * 8 + (lane2 >> 3), ch = lane2 & 7; const u32x4 v = *(const u32x4*)(stg + row * 144 + ch * 16); *(u32x4*)(Ow + (size_t)row * LDO + ch * 16) = v; }
    __syncthreads();
#undef FA8_SLOAD
#undef FA8_SWRITE
#undef FA8_SWAIT
#undef FA8_RESC
#undef FA8_MASK
}
#undef FA8_SBAR
}

#define XCDU(u) ((((u) & 7) << 5) | (((u) >> 3) & 31))
__device__ __forceinline__ void ph_fattn8(Frame& F, int l) {
    unsigned char* OUTS = F.ws + WS_OUTS;
    const unsigned char* Q8 = F.ws + WS_Q8; const unsigned char* K8 = F.ws + WS_K8; const unsigned char* V8T = F.ws + WS_V8T;
    char* lds = (char*)(unsigned char*)F.lds;
    float* rpbL = (float*)(lds + 120 * 1024);
    {
        const float* rpb = F.in(22) + (size_t)l * 4 * 15 * 31;
        for (int i = F.tid; i < 4 * 15 * 31; i += NTHREADS) rpbL[i] = rpb[i] * 1.4426950408889634f;
        __syncthreads();
    }
    const float sc128 = 0.08838834764831845f, sc192 = 0.07216878364870323f;
    const int nctxu = (l == 0) ? 8 : 0;
    if (FA_SEL & 1) for (int u = F.bid; u < 256 + nctxu; u += F.G) {
        launder(F);
        const bool cq = u >= 256; const int v = cq ? u - 256 : XCDU(u), b = cq ? (v >> 2) : (v >> 7), h = cq ? (v & 3) : ((v >> 5) & 3), r0 = cq ? TL + b * NCTX : b * SEQ + (v & 31) * 256;
        fa8::Tiles8 T{4, TL + b * NCTX, b * SEQ, cq ? 4 : 132, 256};
        fa8::attn_unit8<192, 2, 0>(Q8 + (size_t)r0 * Q8P + Q8_M + h * 192, K8 + K8_M + h * 192, V8T + (size_t)((8 + h) * 2 + b) * 128 * VTP, (bf16_t*)(OUTS + (size_t)r0 * DM + 512 + h * 128), T, sc192,
                                   false, 0.f, 0, 0, nullptr, lds, F.tid);
    }
    if (FA_SEL & 2) for (int u = F.bid; u < 256 + 3 * nctxu; u += F.G) {
        launder(F);
        const bool cq = u >= 256; const int v = cq ? u - 256 : XCDU(u);
        const int mx = cq ? ((v >> 3) == 0 ? 0 : (v >> 3) + 1) : 0, b = cq ? ((v >> 2) & 1) : (v >> 7), h = cq ? (v & 3) : ((v >> 5) & 3), r0 = cq ? TL + b * NCTX : b * SEQ + (v & 31) * 256;
        const int qo = mx == 0 ? Q8_A : (mx == 2 ? Q8_W : Q8_N), ko = mx == 0 ? K8_A : (mx == 2 ? K8_W : K8_N), kvh = (mx == 3) ? h : (h >> 1), hidx = (mx == 0 ? 0 : (mx == 2 ? 2 : 4)) + kvh;
        fa8::Tiles8 T{4, TL + b * NCTX, b * SEQ, cq ? 4 : 132, 256};
        fa8::attn_unit8<128, 2, 0>(Q8 + (size_t)r0 * Q8P + qo + h * 128, K8 + ko + kvh * 128, V8T + (size_t)(hidx * 2 + b) * 128 * VTP, (bf16_t*)(OUTS + (size_t)r0 * DM + mx * 512 + h * 128), T, sc128,
                                   mx == 2, F.in(21)[l * 4 + h], 0, 0, nullptr, lds, F.tid);
    }
    if (FA_SEL & 4) for (int u = F.bid; u < 256; u += F.G) {
        launder(F);
        const int uu = XCDU(u), b = uu >> 7, h = (uu >> 5) & 3, qb = uu & 31, r0 = b * SEQ + qb * 256;
        const int q0 = qb * 256, k0 = max(q0 - 128, 0), k1 = min(q0 + 384, SEQ);
        fa8::Tiles8 T{4, TL + b * NCTX, b * SEQ + k0, 4 + (k1 - k0) / 64, 256 + k0};
        fa8::attn_unit8<128, 2, 1>(Q8 + (size_t)r0 * Q8P + Q8_W + h * 128, K8 + K8_W + (h >> 1) * 128, V8T + (size_t)((2 + (h >> 1)) * 2 + b) * 128 * VTP, (bf16_t*)(OUTS + (size_t)r0 * DM + 2 * 512 + h * 128), T, sc128,
                                   true, F.in(21)[l * 4 + h], q0, k0, nullptr, lds, F.tid);
    }
    if (FA_SEL & 8) for (int u = F.bid; u < 256; u += F.G) {
        launder(F);
        const int uu = XCDU(u), b = uu >> 7, h = (uu >> 5) & 3, qb = uu & 31, r0 = b * SEQ + qb * 256;
        const int g0 = qb * 4, ks = min(max(g0 - 4, 0), 120), ke = min(max(g0 + 3 - 4, 0), 120) + 8;
        int nt = ke - ks; nt += (nt & 1);
        const int ks2 = (ks + nt > 128) ? 128 - nt : ks;
        fa8::Tiles8 T{4, TL + b * NCTX, b * SEQ + ks2 * 64, 4 + nt, 256 + ks2 * 64};
        fa8::attn_unit8<128, 2, 2>(Q8 + (size_t)r0 * Q8P + Q8_N + h * 128, K8 + K8_N + h * 128, V8T + (size_t)((4 + h) * 2 + b) * 128 * VTP, (bf16_t*)(OUTS + (size_t)r0 * DM + 3 * 512 + h * 128), T, sc128,
                                   false, 0.f, g0, ks2, rpbL + h * 465, lds, F.tid);
    }
}

__device__ __forceinline__ void ph_fattn(Frame& F, int l) {
    const bf16_t* PROJ = (const bf16_t*)(F.ws + WS_PROJ);
    bf16_t* OUTS = (bf16_t*)(F.ws + WS_OUTS);
    char* lds = (char*)(unsigned char*)F.lds;
    float* rpbL = (float*)(lds + 120 * 1024);
    {
        const float* rpb = F.in(22) + (size_t)l * 4 * 15 * 31;
        for (int i = F.tid; i < 4 * 15 * 31; i += NTHREADS) rpbL[i] = rpb[i] * 11.313708498984761f;
        __syncthreads();
    }
    const float sc128 = 0.08838834764831845f, sc192 = 0.07216878364870323f;
    const int nctxu = (l == 0) ? 8 : 0;
    if (FA_SEL & 1) for (int u = F.bid; u < 256 + nctxu; u += F.G) {
        launder(F);
        const bool cq = u >= 256; const int v = cq ? u - 256 : u, b = cq ? (v >> 2) : (v >> 7), h = cq ? (v & 3) : ((v >> 5) & 3), r0 = cq ? TL + b * NCTX : b * SEQ + (v & 31) * 256;
        fa::Tiles T{4, TL + b * NCTX, b * SEQ, cq ? 4 : 132};
        fa::attn_unit_sp192<768, 768, 1024>((const bf16_t*)(F.ws + WS_MQ) + (size_t)r0 * 768 + h * 192, (const bf16_t*)(F.ws + WS_MK) + h * 192, (const bf16_t*)(F.ws + WS_MKV) + h * 256 + 128,
                                            OUTS + (size_t)r0 * DM + 512 + h * 128, T, sc192, lds, F.tid);
    }
    if (FA_SEL & 2) for (int u = F.bid; u < 256 + 3 * nctxu; u += F.G) {
        launder(F);
        const bool cq = u >= 256; const int v = cq ? u - 256 : u;
        const int mx = cq ? ((v >> 3) == 0 ? 0 : (v >> 3) + 1) : 0, b = cq ? ((v >> 2) & 1) : (v >> 7), h = cq ? (v & 3) : ((v >> 5) & 3), r0 = cq ? TL + b * NCTX : b * SEQ + (v & 31) * 256;
        const int cqo = mx == 0 ? C_AQ : (mx == 2 ? C_WQ : C_NQ), cko = mx == 0 ? C_AK : (mx == 2 ? C_WK : C_NK), cvo = mx == 0 ? C_AV : (mx == 2 ? C_WV : C_NV), kvh = (mx == 3) ? h : (h >> 1);
        fa::Tiles T{4, TL + b * NCTX, b * SEQ, cq ? 4 : 132};
        fa::attn_unit<128, 1, 0, PP, PP, PP>(PROJ + (size_t)r0 * PP + cqo + h * 128, PROJ + cko + kvh * 128, PROJ + cvo + kvh * 128, OUTS + (size_t)r0 * DM + mx * 512 + h * 128, T, sc128,
                                             mx == 2, F.in(21)[l * 4 + h], 0, 0, nullptr, lds, F.tid);
    }
    if (FA_SEL & 4) for (int u = F.bid; u < 256; u += F.G) {
        launder(F);
        const int uu = XCDU(u), b = uu >> 7, h = (uu >> 5) & 3, qb = uu & 31, r0 = b * SEQ + qb * 256;
        const int q0 = qb * 256, k0 = max(q0 - 128, 0), k1 = min(q0 + 384, SEQ);
        fa::Tiles T{4, TL + b * NCTX, b * SEQ + k0, 4 + (k1 - k0) / 64};
        fa::attn_unit<128, 1, 1, PP, PP, PP>(PROJ + (size_t)r0 * PP + C_WQ + h * 128, PROJ + C_WK + (h >> 1) * 128, PROJ + C_WV + (h >> 1) * 128, OUTS + (size_t)r0 * DM + 2 * 512 + h * 128, T, sc128,
                                             true, F.in(21)[l * 4 + h], q0, k0, nullptr, lds, F.tid);
    }
    if (FA_SEL & 8) for (int u = F.bid; u < 256; u += F.G) {
        launder(F);
        const int b = u >> 7, h = (u >> 5) & 3, qb = u & 31, r0 = b * SEQ + qb * 256;
        const int g0 = qb * 4, ks = min(max(g0 - 4, 0), 120), ke = min(max(g0 + 3 - 4, 0), 120) + 8;
        int nt = ke - ks; nt += (nt & 1);
        const int ks2 = (ks + nt > 128) ? 128 - nt : ks;
        fa::Tiles T{4, TL + b * NCTX, b * SEQ + ks2 * 64, 4 + nt};
        fa::attn_unit<128, 1, 2, PP, PP, PP>(PROJ + (size_t)r0 * PP + C_NQ + h * 128, PROJ + C_NK + h * 128, PROJ + C_NV + h * 128, OUTS + (size_t)r0 * DM + 3 * 512 + h * 128, T, sc128,
                                             false, 0.f, g0, ks2, rpbL + h * 465, lds, F.tid);
    }
}

__device__ __forceinline__ void ph_fgemm_bf16(Frame& F, const bf16_t* A, int lda, const bf16_t* Bt, int K, int M, int N, bf16_t* C, int ldc) {
    pg8::SchedPlain S{(const char*)A, (const char*)Bt, lda, K, M / 256, N / 256, F.G, F.bid, 1 << 30, 0};
    pg8::EpiBf16 E{C, ldc, 1.0f};
    pg8::gemm_phase<pg8::EpiBf16, pg8::SchedPlain, false>(F.lds, F.tid, lda, K, K, S, E);
}
__device__ __forceinline__ void ph_fg1_fp8(Frame& F, int l) {
    pg8::SchedPlain S{(const char*)(F.ws + WS_H8), (const char*)(F.ws + WS_W + (size_t)l * WL_STRIDE + WO_IN), DM / 2, DM / 2, TT / 256, PP / 256, F.G, F.bid, 1 << 30, 0, DQ_PLAIN(l * 8 + 0)};
    pg8::EpiBf16 E{(bf16_t*)(F.ws + WS_PROJ), PP, 1.0f / GATE_WSCALE};
    pg8::gemm_phase<pg8::EpiBf16, pg8::SchedPlain, false, true, true>(F.lds, F.tid, DM / 2, DM / 2, DM / 2, S, E);
}
__device__ __forceinline__ void ph_fmla_up(Frame& F, int l) {
    pg8::SchedPlain S{(const char*)(F.ws + WS_MK), (const char*)(F.ws + WS_W + (size_t)l * WL_STRIDE + WO_UQ), MCP / 2, 256, TT / 256, MQP / 256, F.G, F.bid, 4, 128, DQ_PLAIN(l * 8 + 1)};
    pg8::EpiBf16 E{(bf16_t*)(F.ws + WS_MQ), MQP, 1.0f / GATE_WSCALE};
    pg8::gemm_phase<pg8::EpiBf16, pg8::SchedPlain, false, true, true>(F.lds, F.tid, MCP / 2, 256, 256, S, E);
}
__device__ __forceinline__ void ph_fout(Frame& F, int l) {
    const int M = (l == 0) ? TT : TL;
    const unsigned char* Wt = F.ws + WS_W + (size_t)l * WL_STRIDE + WO_O;
    pg8::SchedPlain S{(const char*)(F.ws + WS_ACC), (const char*)Wt, DM / 2, DM / 2, M / 256, DM / 256, F.G, F.bid, 1 << 30, 0, DQ_PLAIN(l * 8 + 4)};
    pg8::EpiResid E{l == 0 ? F.in(0) : F.out, l == 0 ? F.in(2) : (const float*)(F.ws + WS_XC), F.out, (float*)(F.ws + WS_XC), (const float*)(F.ws + WS_MOD) + (size_t)l * 3 * 6 * DM, 2, 1.0f / (ACC_SCALE * GATE_WSCALE)};
    pg8::gemm_phase<pg8::EpiResid, pg8::SchedPlain, false, true, true>(F.lds, F.tid, DM / 2, DM / 2, DM / 2, S, E);
}

constexpr int LDS_BYTES = 147456;
constexpr int MISC_OFF = 131072 + 320;
constexpr int N_PHASES = 1 + 12 * DEPTH + 1;

__global__ void __launch_bounds__(NTHREADS, 2) mega(Args args) {
    extern __shared__ __attribute__((aligned(16))) unsigned char lds[];
    Frame F;
    F.lds = (LAS unsigned char*)lds; F.out = args.out; F.ws = args.ws;
    F.tid = threadIdx.x; F.lane = F.tid & 63; F.wave = __builtin_amdgcn_readfirstlane(F.tid >> 6); F.G = gridDim.x; F.bid = blockIdx.x;
    volatile LAS unsigned* MISC = (volatile LAS unsigned*)(F.lds + MISC_OFF);
    if (F.tid < 32) MISC[F.tid] = 0u;
    __syncthreads();
    XcdBarrier bar; bar.bar = (unsigned*)(F.ws + WS_CTL) + CW_BAR; bar.x = 0; bar.st = nullptr;
    if (args.ph_hi - args.ph_lo > 1) bar = xcd_barrier_post((unsigned*)(F.ws + WS_CTL) + CW_BAR, MISC + 8, F.tid);
#if CLK_PROBE == 6
    if (F.bid == 0 && F.tid == 0) MISC[17] = (unsigned)__builtin_amdgcn_s_memrealtime();
#endif
#define IN(k) (launder(F), lo <= (k) && (k) < hi)
#if CLK_PROBE == 6
#define SEAM(k) do { if (IN(k) && IN((k) + 1)) xcd_barrier(bar, F.tid); if (F.bid == 0 && F.tid == 0) { const unsigned now_ = (unsigned)__builtin_amdgcn_s_memrealtime(); \
        if ((k) == PROBE_PH || (k) == PROBE_PH + 12) MISC[19] += now_ - MISC[17]; MISC[17] = now_; } } while (0)
#else
#define SEAM(k) do { if (IN(k) && IN((k) + 1)) xcd_barrier(bar, F.tid); } while (0)
#endif
#if CLK_PROBE >= 3 && CLK_PROBE <= 5
#define CLKP_BEGIN(l) do { if ((l) == 0 && F.bid == 0 && F.tid == 0) { MISC[20] = 1u; } } while (0)
#define CLKP_END(l) do { if ((l) == 0 && F.bid == 0 && F.tid == 0) { MISC[20] = 0u; } } while (0)
#elif CLK_PROBE && CLK_PROBE != 6
#define CLKP_BEGIN(l) do { if ((l) == 0 && F.bid == 0 && F.tid == 0) { MISC[16] = (unsigned)__builtin_readcyclecounter(); MISC[17] = (unsigned)__builtin_amdgcn_s_memrealtime(); } } while (0)
#define CLKP_END(l) do { if ((l) == 0 && F.bid == 0 && F.tid == 0) { MISC[18] = (unsigned)__builtin_readcyclecounter() - MISC[16]; MISC[19] = (unsigned)__builtin_amdgcn_s_memrealtime() - MISC[17]; } } while (0)
#else
#define CLKP_BEGIN(l) do { } while (0)
#define CLKP_END(l) do { } while (0)
#endif
#define LAYER(l) do { \
        const int pb = 1 + 12 * l; \
        if (IN(pb + 0)) { ph_prep1(F, l); } SEAM(pb + 0); \
        unsigned char* wl = F.ws + WS_W + (size_t)l * WL_STRIDE; \
        if (IN(pb + 1)) { \
            if (FAST_MASK & 1) { CLKP_BEGIN(l); for (int rep = 0; rep < REP_GEMM; ++rep) ph_fg1_fp8(F, l); CLKP_END(l); } \
            else ph_ngemm_bf16(F, (const bf16_t*)(F.ws + WS_H), DM, F.in(8) + (size_t)l * DM * DIN, DIN, DM, TT, DIN, (bf16_t*)(F.ws + WS_PROJ), PP); \
        } SEAM(pb + 1); \
        if (IN(pb + 2)) { if (FAST_MASK & 64) ph_prep2_fast(F, l); else ph_prep2(F, l); } SEAM(pb + 2); \
        if (IN(pb + 3)) { \
            if (FAST_MASK & 2) { \
                ph_fmla_up(F, l); \
            } else { \
                ph_ngemm_bf16(F, (const bf16_t*)(F.ws + WS_PROJ) + C_MCQ, PP, F.in(10) + (size_t)l * 384 * 768, 768, 384, TT, 768, (bf16_t*)(F.ws + WS_MQ), 768); \
                ph_ngemm_bf16(F, (const bf16_t*)(F.ws + WS_PROJ) + C_MCKV, PP, F.in(12) + (size_t)l * 256 * 1024, 1024, 256, TT, 1024, (bf16_t*)(F.ws + WS_MKV), 1024); \
            } \
        } SEAM(pb + 3); \
        if (IN(pb + 4)) { if (FAST_MASK & 64) ph_prep3_fast(F, l); else ph_prep3(F, l); } SEAM(pb + 4); \
        if (IN(pb + 5)) { if (FAST_MASK & 32) { for (int rep = 0; rep < REP_ATT; ++rep) ph_fattn8(F, l); } else ph_nattn(F, l); } SEAM(pb + 5); \
        if (IN(pb + 6)) { if (FAST_MASK & 8) { for (int rep = 0; rep < REP_GEMM; ++rep) ph_fbranch(F, l); } } SEAM(pb + 6); \
        if (IN(pb + 7)) { if (FAST_MASK & 8) { for (int rep = 0; rep < REP_GEMM; ++rep) ph_fgate(F, l); } else ph_nmerge(F, l); } SEAM(pb + 7); \
        if (IN(pb + 8)) { if (FAST_MASK & 4) ph_fout(F, l); else ph_nout(F, l); } SEAM(pb + 8); \
        if (IN(pb + 9)) { ph_prep4(F, l); } SEAM(pb + 9); \
        if (IN(pb + 10)) { if (FAST_MASK & 16) { for (int rep = 0; rep < REP_MOE; ++rep) ph_fmoe_up(F, l); } else ph_nmoe(F, l); } SEAM(pb + 10); \
        if (IN(pb + 11)) { if (FAST_MASK & 16) { for (int rep = 0; rep < REP_MOE; ++rep) ph_fmoe_down(F, l); } } SEAM(pb + 11); \
    } while (0)
#if PREFIX_K > 0
    {
        const int lo = 0, hi = PREFIX_K;
        if (IN(0)) { ph_mod(F); if (FAST_MASK) { rope_tables_build(F); ph_convert(F); } } SEAM(0);
        LAYER(0);
        xcd_barrier(bar, F.tid);
        if (F.bid == 0 && F.tid < 32) ((unsigned*)(F.ws + WS_CTL))[CW_ECNT + F.tid] = 0u;
        xcd_barrier(bar, F.tid);
    }
#endif
    const int lo = args.ph_lo, hi = args.ph_hi;
    if (IN(0)) { for (int rep = 0; rep < REP_PRO; ++rep) { ph_mod(F); if (FAST_MASK) { rope_tables_build(F); ph_convert(F); } } } SEAM(0);
    LAYER(0);
    LAYER(1);
#undef LAYER
    if (IN(N_PHASES - 1)) { ph_prep1(F, DEPTH); }
#if CLK_PROBE
    if (F.bid == 0 && F.tid == 0) {
        const unsigned dc = MISC[18], dw = MISC[19];
        const unsigned long long spin = CLK_PROBE == 1 ? (unsigned long long)dc * 3000ull / (dw ? dw : 1u) : ((CLK_PROBE == 2 || CLK_PROBE == 6) ? (unsigned long long)dw * 2ull : (unsigned long long)dc);
        const unsigned long long t0 = __builtin_amdgcn_s_memrealtime();
        while (__builtin_amdgcn_s_memrealtime() - t0 < spin) __builtin_amdgcn_s_sleep(8);
    }
#endif
#undef IN
#undef SEAM
}

extern "C" void kernel_launch(void* const* d_in, const int* in_sizes, int n_in, void* d_out, int out_size, void* d_ws, size_t ws_size, hipStream_t stream) {
    static int grid = 0;
    if (grid == 0) {
        if (n_in != 32 || in_sizes[0] != TL * DM || out_size != TL * DM || ws_size < WS_END) {
            fprintf(stderr, "kernel_launch: shape mismatch n_in %d in0 %d out %d ws %zu (need %zu)\n", n_in, n_in > 0 ? in_sizes[0] : -1, out_size, ws_size, (size_t)WS_END); grid = -1; return; }
        int dev = 0, cus = 0, per_cu = 0;
        if (hipGetDevice(&dev) != hipSuccess || hipDeviceGetAttribute(&cus, hipDeviceAttributeMultiprocessorCount, dev) != hipSuccess) { grid = -1; return; }
        if (hipFuncSetAttribute((const void*)mega, hipFuncAttributeMaxDynamicSharedMemorySize, LDS_BYTES) != hipSuccess) { fprintf(stderr, "kernel_launch: hipFuncSetAttribute failed\n"); grid = -1; return; }
        if (hipOccupancyMaxActiveBlocksPerMultiprocessor(&per_cu, (const void*)mega, NTHREADS, LDS_BYTES) != hipSuccess || per_cu < 1) { fprintf(stderr, "kernel_launch: occupancy query says %d\n", per_cu); }
        (void)hipGetLastError();
        grid = cus & ~7;
    }
    if (grid < 0) return;
    if (hipMemsetAsync((char*)d_ws + WS_CTL, 0, CTL_ZERO_BYTES, stream) != hipSuccess) return;
    Args a{};
    for (int i = 0; i < 32; ++i) a.in[i] = (const float*)d_in[i];
    a.out = (float*)d_out; a.ws = (unsigned char*)d_ws;
#if MK_N_LAUNCHES == 1
    a.ph_lo = 0; a.ph_hi = N_PHASES;
    hipLaunchKernelGGL(mega, dim3(grid), dim3(NTHREADS), LDS_BYTES, stream, a);
#else
    for (int p = 0; p < N_PHASES; ++p) { a.ph_lo = p; a.ph_hi = p + 1; hipLaunchKernelGGL(mega, dim3(grid), dim3(NTHREADS), LDS_BYTES, stream, a); }
#endif
    const hipError_t le = hipPeekAtLastError();
    if (le != hipSuccess) fprintf(stderr, "kernel_launch: launch failed: %s\n", hipGetErrorName(le));
}
```

```cpp
#include <hip/hip_runtime.h>
#include <cstdio>
#include <cstdint>

#ifndef FAST_MASK
#define FAST_MASK 127
#endif
#ifndef REP_PRO
#define REP_PRO 1
#endif
#ifndef REP_ATT
#define REP_ATT 1
#endif
#ifndef REP_GEMM
#define REP_GEMM 1
#endif
#ifndef REP_MOE
#define REP_MOE 1
#endif
#ifndef PREFIX_K
#define PREFIX_K 0
#define CLK_PROBE 0
#define VALU_PROBE 0
#define DYNQ false
#define SCL_DIV 1
#define PROBE_PH 13
#endif
#ifndef FA_SEL
#define FA_SEL 31
#endif
#ifndef MK_N_LAUNCHES
#define MK_N_LAUNCHES 1
#endif

constexpr int DM = 2048, NB = 2, SEQ = 8192, NCTX = 256, TL = NB * SEQ, TC = NB * NCTX, TT = TL + TC, DEPTH = 2;
constexpr int DIN = 4288, PP = 4352;
constexpr int C_AQ = 0, C_AK = 512, C_AV = 768, C_MCQ = 1024, C_MCKV = 1408, C_MKR = 1664, C_WQ = 1728, C_WK = 2240, C_WV = 2496, C_NQ = 2752, C_NK = 3264, C_NV = 3776;
constexpr int NEXP = 16, DEXP = 512;
constexpr float EPS = 1e-6f;
constexpr float BV_SCALE = 64.0f;
constexpr float ACC_SCALE = 64.0f;
constexpr float OUT_SCALE = 32.0f;
constexpr float GATE_WSCALE = 32.0f;
constexpr int NWAVES = 8, NTHREADS = 512;

constexpr size_t MiB = 1u << 20;
constexpr size_t WS_CTL = 0, CTL_ZERO_BYTES = 1 * MiB;
constexpr size_t WS_MOD = 1 * MiB;
constexpr size_t WS_ROPE = 1 * MiB + 512 * 1024;
constexpr size_t WS_XC = 2 * MiB;
constexpr size_t WS_ELIST = 7 * MiB;
constexpr size_t WS_ELW = 9 * MiB;
constexpr size_t WS_H = 16 * MiB;
constexpr size_t WS_PROJ = 82 * MiB;
constexpr size_t WS_MQ = 223 * MiB;
constexpr size_t WS_MKV = 248 * MiB;
constexpr size_t WS_MK = 281 * MiB;
constexpr int MCP = 640, MQP = 1792;
constexpr size_t WS_HID = 306 * MiB;
constexpr size_t WS_BV = 82 * MiB;
constexpr size_t WS_OUTS = 346 * MiB;
constexpr size_t WS_ACC = 412 * MiB;
constexpr size_t WS_W = 478 * MiB;
constexpr size_t WL_STRIDE = 163 * MiB;
constexpr size_t WO_IN = 0, WO_UQ = 17 * MiB, WO_UKV = 18 * MiB, WO_G = 19 * MiB, WO_B = 51 * MiB, WO_O = 59 * MiB, WO_13 = 67 * MiB, WO_2 = 131 * MiB;
constexpr size_t WS_H8 = 804 * MiB;
constexpr size_t WS_Q8 = 838 * MiB;
constexpr size_t WS_K8 = 876 * MiB;
constexpr size_t WS_V8T = 905 * MiB;
constexpr size_t WS_END = 930 * MiB;
constexpr int Q8P = 2304, K8P = 1792, VTP = 8448;
constexpr int Q8_A = 0, Q8_W = 512, Q8_N = 1024, Q8_M = 1536, K8_A = 0, K8_W = 256, K8_N = 512, K8_M = 1024;
static_assert(WS_BV + (size_t)TT * 8192 * 2 <= WS_OUTS && WS_HID + (size_t)148 * 256 * 512 * 2 <= WS_OUTS && WS_W + 2 * WL_STRIDE <= WS_END, "d_ws map");
constexpr int CW_ECNT = 64;
constexpr float Y_SCALE = 16.0f;
constexpr int CW_BAR = 4096;
constexpr int CW_Q = 8192;

typedef unsigned short bf16_t;
#define LAS __attribute__((address_space(3)))
#define GAS __attribute__((address_space(1)))
typedef float f32x4 __attribute__((ext_vector_type(4)));
typedef unsigned u32x4 __attribute__((ext_vector_type(4)));
typedef unsigned u32x2 __attribute__((ext_vector_type(2)));
typedef float f32x2v __attribute__((ext_vector_type(2)));

__device__ __forceinline__ float bf2f(unsigned v) { return __uint_as_float(v << 16); }
__device__ __forceinline__ unsigned f2bf(float f) { unsigned u = __float_as_uint(f); return (u + 0x7fffu + ((u >> 16) & 1u)) >> 16; }
__device__ __forceinline__ unsigned pk2(float lo, float hi) { return f2bf(lo) | (f2bf(hi) << 16); }
__device__ __forceinline__ float lo16(unsigned w) { return __uint_as_float(w << 16); }
__device__ __forceinline__ float hi16(unsigned w) { return __uint_as_float(w & 0xffff0000u); }
__device__ __forceinline__ int cvt8s(float a, float b, int old, bool hi) {
    a = __builtin_amdgcn_fmed3f(a, -448.f, 448.f); b = __builtin_amdgcn_fmed3f(b, -448.f, 448.f);
    return hi ? __builtin_amdgcn_cvt_pk_fp8_f32(a, b, old, true) : __builtin_amdgcn_cvt_pk_fp8_f32(a, b, old, false);
}
__device__ __forceinline__ float wave_sum(float v) {
#pragma unroll
    for (int o = 1; o < 64; o <<= 1) v += __shfl_xor(v, o);
    return v;
}
__device__ __forceinline__ float sigmoidf_(float x) { return 1.0f / (1.0f + __expf(-x)); }
__device__ __forceinline__ float siluf_(float x) { return x / (1.0f + __expf(-x)); }

#define XB_TMO      128
#define XB_XCNT(j)  (256  + 64 * (j))
#define XB_XSUB(j)  (1280 + 64 * (j))
#define XB_XGEN(j)  (2304 + 64 * (j))
#define XB_TOP      3328
#define XB_TOPGEN   3392
#define XCD_BAR_WORDS 3456
#define XB_SPIN_CAP (1u << 22)

__device__ __forceinline__ unsigned xb_ld(unsigned* p)              { return __hip_atomic_load(p, __ATOMIC_RELAXED, __HIP_MEMORY_SCOPE_AGENT); }
__device__ __forceinline__ unsigned xb_add(unsigned* p, unsigned v) { return __hip_atomic_fetch_add(p, v, __ATOMIC_RELAXED, __HIP_MEMORY_SCOPE_AGENT); }
__device__ __forceinline__ unsigned xb_xcc_id() { return (unsigned)__builtin_amdgcn_s_getreg((3 << 11) | 20) & 0xFu; }
#define XB_SPIN(cond, bar) do { unsigned _sp = 0; while (cond) { __builtin_amdgcn_s_sleep(1); \
    if ((++_sp & 255u) == 0u) { if (xb_ld(&(bar)[XB_TMO])) break; if (_sp > XB_SPIN_CAP) { atomicAdd(&(bar)[XB_TMO], 1u); break; } } } } while (0)

struct XcdBarrier { unsigned* bar; unsigned x; volatile LAS unsigned* st; };

__device__ __forceinline__ XcdBarrier xcd_barrier_post(unsigned* bar, volatile LAS unsigned* st, int tid) {
    XcdBarrier b; b.bar = bar; b.x = xb_xcc_id(); b.st = st;
    if (tid == 0) (void)xb_add(&bar[XB_XCNT(b.x)], 1u);
    return b;
}
__device__ __forceinline__ void xcd_barrier_complete(unsigned* bar, unsigned x, unsigned& nloc, unsigned& nx) {
    const unsigned G = gridDim.x * gridDim.y * gridDim.z;
    unsigned sum, cnt, mine, sp = 0u;
    for (;;) {
        sum = 0u; cnt = 0u; mine = 0u;
#pragma unroll
        for (unsigned j = 0; j < 16; ++j) { const unsigned c = xb_ld(&bar[XB_XCNT(j)]); sum += c; cnt += (c > 0u) ? 1u : 0u; mine = (j == x) ? c : mine; }
        if (sum == G) break;
        __builtin_amdgcn_s_sleep(1);
        if ((++sp & 255u) == 0u) { if (xb_ld(&bar[XB_TMO])) break; if (sp > XB_SPIN_CAP) { atomicAdd(&bar[XB_TMO], 1u); break; } }
    }
    nloc = mine > 0u ? mine : 1u; nx = cnt > 0u ? cnt : 1u;
}
__device__ __forceinline__ void xcd_barrier(const XcdBarrier& b, int tid) {
    asm volatile("s_waitcnt vmcnt(0)" ::: "memory");
    __syncthreads();
    if (tid == 0) {
        unsigned* bar = b.bar;
        __builtin_amdgcn_s_waitcnt(0);
        unsigned nloc = b.st[0], nx = b.st[1];
        if (nloc == 0u) { xcd_barrier_complete(bar, b.x, nloc, nx); b.st[0] = nloc; b.st[1] = nx; }
        const unsigned old = xb_add(&bar[XB_XSUB(b.x)], 1u);
        const unsigned gen = old / nloc;
        if (old + 1u == (gen + 1u) * nloc) {
            __builtin_amdgcn_fence(__ATOMIC_RELEASE, "agent");
            asm volatile("s_waitcnt vmcnt(0)" ::: "memory");
            const unsigned og = xb_add(&bar[XB_TOP], 1u);
            const unsigned tg = og / nx;
            if (og + 1u == (tg + 1u) * nx) xb_add(&bar[XB_TOPGEN], 1u);
            else XB_SPIN(xb_ld(&bar[XB_TOPGEN]) == tg, bar);
            __builtin_amdgcn_fence(__ATOMIC_ACQUIRE, "agent");
            xb_add(&bar[XB_XGEN(b.x)], 1u);
            asm volatile("s_waitcnt vmcnt(0)" ::: "memory");
        } else {
            XB_SPIN(xb_ld(&bar[XB_XGEN(b.x)]) == gen, bar);
            __builtin_amdgcn_fence(__ATOMIC_ACQUIRE, "agent");
            asm volatile("s_waitcnt vmcnt(0)" ::: "memory");
        }
    }
    __syncthreads();
}

struct Args { const float* in[32]; float* out; unsigned char* ws; int ph_lo, ph_hi; };

struct Frame {
    LAS unsigned char* lds;
    float* out; unsigned char* ws;
    int tid, lane, wave, G, bid;
    __device__ __forceinline__ const float* in(int k) const {
        const __attribute__((address_space(4))) char* ka = (const __attribute__((address_space(4))) char*)__builtin_amdgcn_kernarg_segment_ptr();
        int z = 0; asm volatile("" : "+v"(z)); z = __builtin_amdgcn_readfirstlane(z);
        return *(const float* const __attribute__((address_space(4)))*)(ka + k * 8 + z);
    }
};
__device__ __forceinline__ float* xs_row(const Frame& F, int r) { return r < TL ? F.out + (size_t)r * DM : (float*)(F.ws + WS_XC) + (size_t)(r - TL) * DM; }
__device__ __forceinline__ const float* xin_row(const Frame& F, int l, int r) {
    if (l == 0) return r < TL ? F.in(0) + (size_t)r * DM : F.in(2) + (size_t)(r - TL) * DM;
    return xs_row(F, r);
}
__device__ __forceinline__ const float* mod_vec(const Frame& F, int l, int r, int which) {
    const int s = r < TL ? (r / SEQ) : 2;
    return (const float*)(F.ws + WS_MOD) + (size_t)(l * 3 + s) * 6 * DM + which * DM;
}

__device__ __forceinline__ void launder(Frame& F) {
    asm volatile("" : "+s"(F.wave), "+s"(F.bid), "+s"(F.G));
    int z = 0; asm volatile("" : "+v"(z));
    F.lane = (int)__builtin_amdgcn_mbcnt_hi(~0u, __builtin_amdgcn_mbcnt_lo(~0u, (unsigned)z)); F.tid = F.wave * 64 + F.lane;
}

__device__ __forceinline__ void ph_mod(Frame& F) {
    LAS float* sv = (LAS float*)F.lds;
    LAS float* red = sv + 3 * DM;
    for (int i = F.tid; i < 3 * DM; i += NTHREADS) { const int s = i / DM, k = i % DM; const float v = s < 2 ? F.in(1)[s * DM + k] : F.in(3)[k]; sv[i] = siluf_(v); }
    __syncthreads();
    for (int item = F.bid; item < DEPTH * 128; item += F.G) {
        const int l = item / 128, ch = item % 128, col = ch * 96 + (F.lane < 48 ? F.lane : 0) * 2;
        const float* W = F.in(4) + (size_t)l * DM * 6 * DM + col;
        float a[3][2] = {{0.f, 0.f}, {0.f, 0.f}, {0.f, 0.f}};
        const int k0 = F.wave * 256;
        if (F.lane < 48) {
#pragma unroll 8
            for (int k = 0; k < 256; ++k) {
                const float2 w = *(const float2*)(W + (size_t)(k0 + k) * 6 * DM);
#pragma unroll
                for (int s = 0; s < 3; ++s) { const float x = sv[s * DM + k0 + k]; a[s][0] += x * w.x; a[s][1] += x * w.y; }
            }
        }
#pragma unroll
        for (int s = 0; s < 3; ++s) { red[(F.wave * 3 + s) * 128 + F.lane * 2] = a[s][0]; red[(F.wave * 3 + s) * 128 + F.lane * 2 + 1] = a[s][1]; }
        __syncthreads();
        if (F.tid < 288) {
            const int s = F.tid / 96, c = F.tid % 96; float t = 0.f;
#pragma unroll
            for (int w = 0; w < 8; ++w) t += red[(w * 3 + s) * 128 + c];
            const int j = ch * 96 + c;
            ((float*)(F.ws + WS_MOD))[(size_t)(l * 3 + s) * 6 * DM + j] = t + F.in(5)[(size_t)l * 6 * DM + j];
        }
        __syncthreads();
    }
}

__device__ __forceinline__ void ph_prep1(Frame& F, int l) {
    const int gw = F.bid * NWAVES + F.wave, NGW = F.G * NWAVES;
    const int nrows = (l == DEPTH) ? TL : TT;
    const unsigned char* Y = (const unsigned char*)(F.ws + WS_PROJ);
    bf16_t* H = (bf16_t*)(F.ws + WS_H);
    const float* gn_mix = F.in(6) + (size_t)(l < DEPTH ? l : 0) * DM;
    bf16_t* XB = (bf16_t*)(F.ws + WS_H);
    for (int r = gw; r < nrows; r += NGW) {
        f32x4 v[8];
        if (l == 0) { const float* xr = xin_row(F, 0, r);
#pragma unroll
            for (int j = 0; j < 8; ++j) v[j] = *(const f32x4*)(xr + j * 256 + F.lane * 4); }
        else { const bf16_t* xr = XB + (size_t)r * DM;
#pragma unroll
            for (int j = 0; j < 8; ++j) { const u32x2 t = *(const u32x2*)(xr + j * 256 + F.lane * 4); v[j] = (f32x4){lo16(t.x), hi16(t.x), lo16(t.y), hi16(t.y)}; } }
        if (l > 0) {
            const bool has_moe = (l == 1) || (r < TL);
            if (has_moe) {
                const float* g2 = mod_vec(F, l - 1, r, 5);
                const unsigned char* y0 = Y + (size_t)r * DM, *y1 = Y + (size_t)TT * DM + (size_t)r * DM;
#pragma unroll
                for (int j = 0; j < 8; ++j) {
                    const int c = j * 256 + F.lane * 4;
                    const int a = *(const int*)(y0 + c), b = *(const int*)(y1 + c); const f32x4 g = *(const f32x4*)(g2 + c) * (1.0f / Y_SCALE);
                    v[j].x += g.x * (__builtin_amdgcn_cvt_f32_fp8(a, 0) + __builtin_amdgcn_cvt_f32_fp8(b, 0)); v[j].y += g.y * (__builtin_amdgcn_cvt_f32_fp8(a, 1) + __builtin_amdgcn_cvt_f32_fp8(b, 1));
                    v[j].z += g.z * (__builtin_amdgcn_cvt_f32_fp8(a, 2) + __builtin_amdgcn_cvt_f32_fp8(b, 2)); v[j].w += g.w * (__builtin_amdgcn_cvt_f32_fp8(a, 3) + __builtin_amdgcn_cvt_f32_fp8(b, 3));
                }
                if (l < DEPTH) { bf16_t* xo = XB + (size_t)r * DM;
#pragma unroll
                    for (int j = 0; j < 8; ++j) { u32x2 w; w.x = pk2(v[j].x, v[j].y); w.y = pk2(v[j].z, v[j].w); *(u32x2*)(xo + j * 256 + F.lane * 4) = w; } }
            }
            if (l == DEPTH) { float* xo = F.out + (size_t)r * DM;
#pragma unroll
                for (int j = 0; j < 8; ++j) *(f32x4*)(xo + j * 256 + F.lane * 4) = v[j]; }
        }
        if (l == DEPTH) continue;
        float ss = 0.f;
#pragma unroll
        for (int j = 0; j < 8; ++j) ss += v[j].x * v[j].x + v[j].y * v[j].y + v[j].z * v[j].z + v[j].w * v[j].w;
        const float rstd = rsqrtf(wave_sum(ss) * (1.0f / DM) + EPS);
        const float* gn = gn_mix; const float* sh = mod_vec(F, l, r, 0); const float* sc = mod_vec(F, l, r, 1);
#pragma unroll
        for (int j = 0; j < 8; ++j) {
            const int c = j * 256 + F.lane * 4;
            const f32x4 g = *(const f32x4*)(gn + c), s1 = *(const f32x4*)(sc + c), s0 = *(const f32x4*)(sh + c);
            const f32x4 h = (v[j] * rstd * g) * (s1 + 1.0f) + s0;
            if (!(FAST_MASK & 1)) { u32x2 w; w.x = pk2(h.x, h.y); w.y = pk2(h.z, h.w); *(u32x2*)(H + (size_t)r * DM + c) = w; }
            int w8 = 0; w8 = cvt8s(h.x, h.y, w8, false); w8 = cvt8s(h.z, h.w, w8, true);
            *(int*)(F.ws + WS_H8 + (size_t)r * DM + c) = w8;
        }
    }
}

__device__ __forceinline__ void ngemm_tile(float (&acc)[4][4], const bf16_t* A, int lda, const float* B, int ldb, int K, int row0, int col0, LAS float* lds, int tid) {
    LAS float* As = lds;
    LAS float* Bs = lds + 16 * 132;
    const int ty = tid >> 4, tx = tid & 15;
    const int ar = tid >> 2, ak = (tid & 3) * 4;
    const int bk = (tid & 255) >> 4, bc = (tid & 15) * 4;
    for (int k0 = 0; k0 < K; k0 += 16) {
        const u32x2 av = *(const u32x2*)(A + (size_t)(row0 + ar) * lda + k0 + ak);
        f32x4 bv = (f32x4){0.f, 0.f, 0.f, 0.f};
        if (tid < 256) bv = *(const f32x4*)(B + (size_t)(k0 + bk) * ldb + col0 + bc);
        __syncthreads();
        As[(ak + 0) * 132 + ar] = lo16(av.x); As[(ak + 1) * 132 + ar] = hi16(av.x); As[(ak + 2) * 132 + ar] = lo16(av.y); As[(ak + 3) * 132 + ar] = hi16(av.y);
        if (tid < 256) *(LAS f32x4*)(Bs + bk * 64 + bc) = bv;
        __syncthreads();
#pragma unroll
        for (int kk = 0; kk < 16; ++kk) {
            const f32x4 a = *(const LAS f32x4*)(As + kk * 132 + ty * 4);
            const f32x4 b = *(const LAS f32x4*)(Bs + kk * 64 + tx * 4);
#pragma unroll
            for (int i = 0; i < 4; ++i)
#pragma unroll
                for (int j = 0; j < 4; ++j) acc[i][j] += a[i] * b[j];
        }
    }
    __syncthreads();
}
#define ZERO44(a) do { _Pragma("unroll") for (int i_ = 0; i_ < 4; ++i_) _Pragma("unroll") for (int j_ = 0; j_ < 4; ++j_) a[i_][j_] = 0.f; } while (0)

__device__ __forceinline__ void ph_ngemm_bf16(Frame& F, const bf16_t* A, int lda, const float* B, int ldb, int K, int M, int N, bf16_t* C, int ldc) {
    const int nn = N / 64, ntiles = (M / 128) * nn;
    const int ty = F.tid >> 4, tx = F.tid & 15;
    for (int t = F.bid; t < ntiles; t += F.G) {
        const int row0 = (t / nn) * 128, col0 = (t % nn) * 64;
        float acc[4][4]; ZERO44(acc);
        ngemm_tile(acc, A, lda, B, ldb, K, row0, col0, (LAS float*)F.lds, F.tid);
#pragma unroll
        for (int i = 0; i < 4; ++i) { u32x2 w; w.x = pk2(acc[i][0], acc[i][1]); w.y = pk2(acc[i][2], acc[i][3]);
            *(u32x2*)(C + (size_t)(row0 + ty * 4 + i) * ldc + col0 + tx * 4) = w; }
    }
}

__device__ __forceinline__ float rope_freq(int i, int n) { return exp2f(-(float)i * (13.287712379549449f / (float)n)); }
__device__ __forceinline__ void head128(bf16_t* p, const float* g, bool rope, int prow, int pcol, int lane) {
    float e0 = bf2f(p[lane]), e1 = bf2f(p[lane + 64]);
    const float rstd = rsqrtf(wave_sum(e0 * e0 + e1 * e1) * (1.0f / 128.0f) + EPS);
    e0 = e0 * rstd * g[lane]; e1 = e1 * rstd * g[lane + 64];
    if (rope) {
        const float fr = rope_freq(lane & 31, 32);
        float s0, c0, s1, c1; sincosf((float)prow * fr, &s0, &c0); sincosf((float)pcol * fr, &s1, &c1);
        const float p0 = __shfl_xor(e0, 32), p1 = __shfl_xor(e1, 32);
        if (lane < 32) { e0 = e0 * c0 - p0 * s0; e1 = e1 * c1 - p1 * s1; }
        else { e0 = p0 * s0 + e0 * c0; e1 = p1 * s1 + e1 * c1; }
    }
    p[lane] = (bf16_t)f2bf(e0); p[lane + 64] = (bf16_t)f2bf(e1);
}
__device__ __forceinline__ void ph_prep2(Frame& F, int l) {
    const int gw = F.bid * NWAVES + F.wave, NGW = F.G * NWAVES, lane = F.lane;
    bf16_t* PROJ = (bf16_t*)(F.ws + WS_PROJ);
    for (int r = gw; r < TT; r += NGW) {
        bf16_t* p = PROJ + (size_t)r * PP;
        const bool lat = r < TL; const int t = r % SEQ, prow = t / 64, pcol = t % 64;
        for (int h = 0; h < 4; ++h) head128(p + C_AQ + h * 128, F.in(13) + l * 128, lat, prow, pcol, lane);
        for (int h = 0; h < 2; ++h) head128(p + C_AK + h * 128, F.in(14) + l * 128, lat, prow, pcol, lane);
        for (int h = 0; h < 4; ++h) head128(p + C_WQ + h * 128, F.in(17) + l * 128, lat, prow, pcol, lane);
        for (int h = 0; h < 2; ++h) head128(p + C_WK + h * 128, F.in(18) + l * 128, lat, prow, pcol, lane);
        for (int h = 0; h < 4; ++h) head128(p + C_NQ + h * 128, F.in(19) + l * 128, false, 0, 0, lane);
        for (int h = 0; h < 4; ++h) head128(p + C_NK + h * 128, F.in(20) + l * 128, false, 0, 0, lane);
        {
            float e[6]; float ss = 0.f;
#pragma unroll
            for (int j = 0; j < 6; ++j) { e[j] = bf2f(p[C_MCQ + j * 64 + lane]); ss += e[j] * e[j]; }
            const float rstd = rsqrtf(wave_sum(ss) * (1.0f / 384.0f) + EPS);
#pragma unroll
            for (int j = 0; j < 6; ++j) p[C_MCQ + j * 64 + lane] = (bf16_t)f2bf(e[j] * rstd * F.in(9)[l * 384 + j * 64 + lane]);
        }
        {
            float e[4]; float ss = 0.f;
#pragma unroll
            for (int j = 0; j < 4; ++j) { e[j] = bf2f(p[C_MCKV + j * 64 + lane]); ss += e[j] * e[j]; }
            const float rstd = rsqrtf(wave_sum(ss) * (1.0f / 256.0f) + EPS);
#pragma unroll
            for (int j = 0; j < 4; ++j) p[C_MCKV + j * 64 + lane] = (bf16_t)f2bf(e[j] * rstd * F.in(11)[l * 256 + j * 64 + lane]);
        }
    }
}

__device__ __forceinline__ void mla_head(float e0, float e1, float e2, const float* g, bool rope, int prow, int pcol, int lane, bf16_t* dst) {
    const float rstd = rsqrtf(wave_sum(e0 * e0 + e1 * e1 + e2 * e2) * (1.0f / 192.0f) + EPS);
    e0 = e0 * rstd * g[lane]; e1 = e1 * rstd * g[64 + lane]; e2 = e2 * rstd * g[128 + lane];
    if (rope) {
        const float fr = rope_freq(lane & 15, 16); const int pos = (lane < 32) ? prow : pcol;
        float s, c; sincosf((float)pos * fr, &s, &c);
        const float pr = __shfl_xor(e2, 16);
        e2 = ((lane & 31) < 16) ? (e2 * c - pr * s) : (pr * s + e2 * c);
    }
    dst[lane] = (bf16_t)f2bf(e0); dst[64 + lane] = (bf16_t)f2bf(e1); dst[128 + lane] = (bf16_t)f2bf(e2);
}
__device__ __forceinline__ void ph_prep3(Frame& F, int l) {
    const int gw = F.bid * NWAVES + F.wave, NGW = F.G * NWAVES, lane = F.lane;
    const bf16_t* PROJ = (const bf16_t*)(F.ws + WS_PROJ); bf16_t* MQ = (bf16_t*)(F.ws + WS_MQ); const bf16_t* MKV = (const bf16_t*)(F.ws + WS_MKV); bf16_t* MK = (bf16_t*)(F.ws + WS_MK);
    for (int r = gw; r < TT; r += NGW) {
        const bool lat = r < TL; const int t = r % SEQ, prow = t / 64, pcol = t % 64;
        const float kr = bf2f(PROJ[(size_t)r * PP + C_MKR + lane]);
        for (int h = 0; h < 4; ++h) {
            bf16_t* q = MQ + (size_t)r * 768 + h * 192;
            mla_head(bf2f(q[lane]), bf2f(q[64 + lane]), bf2f(q[128 + lane]), F.in(15) + l * 192, lat, prow, pcol, lane, q);
            const bf16_t* kv = MKV + (size_t)r * 1024 + h * 256;
            mla_head(bf2f(kv[lane]), bf2f(kv[64 + lane]), kr, F.in(16) + l * 192, lat, prow, pcol, lane, MK + (size_t)r * 768 + h * 192);
        }
    }
}

constexpr int RT_ROW128 = 0, RT_COL128 = 128 * 32, RT_ROW64 = RT_COL128 + 64 * 32, RT_COL64 = RT_ROW64 + 128 * 16, RT_N = RT_COL64 + 64 * 16;
__device__ __forceinline__ void rope_tables_build(Frame& F) {
    f32x2v* tab = (f32x2v*)(F.ws + WS_ROPE);
    for (int i = F.bid * NTHREADS + F.tid; i < RT_N; i += F.G * NTHREADS) {
        int pos, fi, n;
        if (i < RT_COL128) { pos = i >> 5; fi = i & 31; n = 32; } else if (i < RT_ROW64) { pos = (i - RT_COL128) >> 5; fi = i & 31; n = 32; }
        else if (i < RT_COL64) { pos = (i - RT_ROW64) >> 4; fi = i & 15; n = 16; } else { pos = (i - RT_COL64) >> 4; fi = i & 15; n = 16; }
        float sn, cs; sincosf((float)pos * rope_freq(fi, n), &sn, &cs); tab[i] = (f32x2v){cs, sn};
    }
}
__device__ __forceinline__ void rope_tables(Frame& F, LAS f32x2v* tab) {
    const u32x4* src = (const u32x4*)(F.ws + WS_ROPE);
    for (int i = F.tid; i < RT_N / 2; i += NTHREADS) ((LAS u32x4*)tab)[i] = src[i];
    __syncthreads();
}
__device__ __forceinline__ void unpack8(const u32x4 w, float (&e)[8]) { e[0] = lo16(w.x); e[1] = hi16(w.x); e[2] = lo16(w.y); e[3] = hi16(w.y); e[4] = lo16(w.z); e[5] = hi16(w.z); e[6] = lo16(w.w); e[7] = hi16(w.w); }
__device__ __forceinline__ u32x4 pack8(const float (&e)[8]) { u32x4 w; w.x = pk2(e[0], e[1]); w.y = pk2(e[2], e[3]); w.z = pk2(e[4], e[5]); w.w = pk2(e[6], e[7]); return w; }
__device__ __forceinline__ u32x2 pack8_fp8(const float (&e)[8]) { int a = 0, b = 0;
    a = cvt8s(e[0], e[1], a, false); a = cvt8s(e[2], e[3], a, true);
    b = cvt8s(e[4], e[5], b, false); b = cvt8s(e[6], e[7], b, true);
    u32x2 o; o.x = (unsigned)a; o.y = (unsigned)b; return o; }
__device__ __forceinline__ void vtrans_item(const bf16_t* src, int pitch, int b, int tb, unsigned char* dst  , LAS unsigned char* scr, int lane) {
    const int krow = tb < 4 ? TL + b * NCTX + tb * 64 + lane : b * SEQ + (tb - 4) * 64 + lane;
    const bf16_t* p = src + (size_t)krow * pitch;
    u32x4 w[8];
#pragma unroll
    for (int i = 0; i < 8; ++i) w[i] = *(const u32x4*)(p + i * 8);
    const int pos = 32 * ((lane >> 2) & 1) + (lane & 3) + 4 * ((lane >> 3) & 3) + 16 * (lane >> 5);
#pragma unroll
    for (int i = 0; i < 8; ++i) { float e[8]; unpack8(w[i], e); const u32x2 q = pack8_fp8(e);
#pragma unroll
        for (int j = 0; j < 4; ++j) { scr[(i * 8 + j) * 80 + pos] = (unsigned char)(q.x >> (8 * j)); scr[(i * 8 + 4 + j) * 80 + pos] = (unsigned char)(q.y >> (8 * j)); } }
    asm volatile("s_waitcnt lgkmcnt(0)" ::: "memory");
    unsigned char* o = dst + (size_t)lane * VTP + tb * 64;
#pragma unroll
    for (int c = 0; c < 4; ++c) *(u32x4*)(o + c * 16) = *(const LAS u32x4*)(scr + lane * 80 + c * 16);
    asm volatile("s_waitcnt lgkmcnt(0)" ::: "memory");
}
__device__ __forceinline__ float ssq8(const float (&e)[8]) { float s = 0.f;
#pragma unroll
    for (int i = 0; i < 8; ++i) s += e[i] * e[i]; return s; }
__device__ __forceinline__ float group16_sum(float v) { v += __shfl_xor(v, 1); v += __shfl_xor(v, 2); v += __shfl_xor(v, 4); v += __shfl_xor(v, 8); return v; }
constexpr float QS128 = 0.12751743082459871f, QS192 = 0.10411832783838018f;
__device__ __forceinline__ u32x2 head128_w(const u32x4 w, const float* g, bool rope, int prow, int pcol, int j, const LAS f32x2v* tab, const float osc = 1.0f) {
    float e[8]; unpack8(w, e);
    const float rstd = rsqrtf(group16_sum(ssq8(e)) * (1.0f / 128.0f) + EPS) * osc;
    const f32x4 g0 = *(const f32x4*)(g + 8 * j), g1 = *(const f32x4*)(g + 8 * j + 4);
    e[0] *= rstd * g0.x; e[1] *= rstd * g0.y; e[2] *= rstd * g0.z; e[3] *= rstd * g0.w; e[4] *= rstd * g1.x; e[5] *= rstd * g1.y; e[6] *= rstd * g1.z; e[7] *= rstd * g1.w;
    if (rope) {
        const int d = 8 * j, fi = d & 31; const bool first = (d & 32) == 0;
        const LAS f32x2v* t = tab + ((d < 64) ? RT_ROW128 + prow * 32 : RT_COL128 + pcol * 32) + fi;
#pragma unroll
        for (int i = 0; i < 8; ++i) { const float p = __shfl_xor(e[i], 4); const f32x2v cs = t[i]; e[i] = first ? e[i] * cs.x - p * cs.y : p * cs.y + e[i] * cs.x; }
    }
    return pack8_fp8(e);
}
__device__ __forceinline__ void ph_prep2_fast(Frame& F, int l) {
    LAS f32x2v* tab = (LAS f32x2v*)F.lds;
    rope_tables(F, tab);
    const int gw = F.bid * NWAVES + F.wave, NGW = F.G * NWAVES, lane = F.lane, j = lane & 15, hd = lane >> 4;
    bf16_t* PROJ = (bf16_t*)(F.ws + WS_PROJ);
    const float* qn_att = F.in(13) + l * 128; const float* kn_att = F.in(14) + l * 128; const float* qn_win = F.in(17) + l * 128; const float* kn_win = F.in(18) + l * 128;
    const float* qn_na = F.in(19) + l * 128; const float* kn_na = F.in(20) + l * 128; const float* qa_n = F.in(9) + l * 384; const float* kva_n = F.in(11) + l * 256;
    for (int r = gw; r < TT; r += NGW) {
        bf16_t* p = PROJ + (size_t)r * PP;
        const bool lat = r < TL; const int t = r % SEQ, prow = t / 64, pcol = t % 64;
        bf16_t* a0 = p + C_AQ + lane * 8;
        bf16_t* a1 = p + (hd < 2 ? C_AK : C_WK - 256) + lane * 8;
        bf16_t* a2 = p + C_WQ + lane * 8;
        bf16_t* a3 = p + C_NQ + lane * 8;
        bf16_t* a4 = p + C_NK + lane * 8;
        bf16_t* a5 = p + C_MCQ + (lane < 48 ? lane : 0) * 8;
        bf16_t* a6 = p + C_MCKV + (lane & 31) * 8;
        const u32x4 w0 = *(const u32x4*)a0, w1 = *(const u32x4*)a1, w2 = *(const u32x4*)a2, w3 = *(const u32x4*)a3, w4 = *(const u32x4*)a4, w5 = *(const u32x4*)a5, w6 = *(const u32x4*)a6;
        unsigned char* q8 = F.ws + WS_Q8 + (size_t)r * Q8P; unsigned char* k8 = F.ws + WS_K8 + (size_t)r * K8P;
        *(u32x2*)(q8 + Q8_A + lane * 8) = head128_w(w0, qn_att, lat, prow, pcol, j, tab, QS128);
        *(u32x2*)(k8 + (hd < 2 ? K8_A : K8_W - 256) + lane * 8) = head128_w(w1, hd < 2 ? kn_att : kn_win, lat, prow, pcol, j, tab);
        *(u32x2*)(q8 + Q8_W + lane * 8) = head128_w(w2, qn_win, lat, prow, pcol, j, tab, QS128);
        *(u32x2*)(q8 + Q8_N + lane * 8) = head128_w(w3, qn_na, false, 0, 0, j, tab, QS128);
        *(u32x2*)(k8 + K8_N + lane * 8) = head128_w(w4, kn_na, false, 0, 0, j, tab);
        float e5[8], e6[8]; unpack8(w5, e5); unpack8(w6, e6);
        const float r5 = rsqrtf(wave_sum(lane < 48 ? ssq8(e5) : 0.f) * (1.0f / 384.0f) + EPS);
        const float r6 = rsqrtf(wave_sum(lane < 32 ? ssq8(e6) : 0.f) * (1.0f / 256.0f) + EPS);
        {
            const float* g5 = qa_n + (lane < 48 ? lane : 0) * 8; const float* g6 = kva_n + (lane & 31) * 8;
            const f32x4 ga = *(const f32x4*)g5, gb = *(const f32x4*)(g5 + 4), gc = *(const f32x4*)g6, gd = *(const f32x4*)(g6 + 4);
            e5[0] *= r5 * ga.x; e5[1] *= r5 * ga.y; e5[2] *= r5 * ga.z; e5[3] *= r5 * ga.w; e5[4] *= r5 * gb.x; e5[5] *= r5 * gb.y; e5[6] *= r5 * gb.z; e5[7] *= r5 * gb.w;
            e6[0] *= r6 * gc.x; e6[1] *= r6 * gc.y; e6[2] *= r6 * gc.z; e6[3] *= r6 * gc.w; e6[4] *= r6 * gd.x; e6[5] *= r6 * gd.y; e6[6] *= r6 * gd.z; e6[7] *= r6 * gd.w;
        }
        unsigned char* mc8 = F.ws + WS_MK + (size_t)r * MCP;
        if (lane < 48) *(u32x2*)(mc8 + 256 + lane * 8) = pack8_fp8(e5);
        if (lane < 32) *(u32x2*)(mc8 + lane * 8) = pack8_fp8(e6);
    }
    __syncthreads();
    {
        LAS unsigned char* scr = F.lds + F.wave * 5120;
        for (int it = gw; it < 2 * 132 * 16; it += NGW) {
            const int g = it & 15, tb = (it >> 4) % 132, b = (it >> 4) / 132;
            const int hidx = g >> 1, half = g & 1;
            const int col = (hidx < 2 ? C_AV + hidx * 128 : (hidx < 4 ? C_WV + (hidx - 2) * 128 : C_NV + (hidx - 4) * 128)) + half * 64;
            vtrans_item(PROJ + col, PP, b, tb, F.ws + WS_V8T + ((size_t)(hidx * 2 + b) * 128 + half * 64) * VTP, scr, lane);
        }
        __syncthreads();
    }
}
__device__ __forceinline__ void mla_rope8(float (&e)[8], int rp  , int prow, int pcol, const LAS f32x2v* tab, int delta_lane) {
    const int blk = rp >> 2, pp = rp & 3; const bool first = pp < 2;
    const LAS f32x2v* t = tab + (blk == 0 ? RT_ROW64 + prow * 16 : RT_COL64 + pcol * 16) + 8 * (pp & 1);
#pragma unroll
    for (int i = 0; i < 8; ++i) { const float p = __shfl_xor(e[i], delta_lane); const f32x2v cs = t[i]; e[i] = first ? e[i] * cs.x - p * cs.y : p * cs.y + e[i] * cs.x; }
}
__device__ __forceinline__ void scale8(float (&e)[8], float rstd, const float* g) { const f32x4 a = *(const f32x4*)g, b = *(const f32x4*)(g + 4);
    e[0] *= rstd * a.x; e[1] *= rstd * a.y; e[2] *= rstd * a.z; e[3] *= rstd * a.w; e[4] *= rstd * b.x; e[5] *= rstd * b.y; e[6] *= rstd * b.z; e[7] *= rstd * b.w; }
__device__ __forceinline__ void ph_prep3_fast(Frame& F, int l) {
    LAS f32x2v* tab = (LAS f32x2v*)F.lds;
    rope_tables(F, tab);
    const int gw = F.bid * NWAVES + F.wave, NGW = F.G * NWAVES, lane = F.lane;
    const bf16_t* PROJ = (const bf16_t*)(F.ws + WS_PROJ); const bf16_t* MKV = (const bf16_t*)(F.ws + WS_MQ); const bf16_t* MQ = MKV + 1024;
    const float* qn = F.in(15) + l * 192; const float* kn = F.in(16) + l * 192;
    const int hA = lane / 24, wA = lane % 24, cB = 64 + (lane & 31), hB = cB / 24, wB = cB % 24;
    for (int r = gw; r < TT; r += NGW) {
        const bool lat = r < TL; const int t = r % SEQ, prow = t / 64, pcol = t % 64;
        const bf16_t* q = MQ + (size_t)r * MQP;
        const u32x4 qa = *(const u32x4*)(q + lane * 8), qb = *(const u32x4*)(q + cB * 8);
        const u32x4 kw = *(const u32x4*)(MKV + (size_t)r * MQP + (lane >> 4) * 256 + (lane & 15) * 8);
        const u32x4 rw = *(const u32x4*)(PROJ + (size_t)r * PP + C_MKR + (lane & 7) * 8);
        float ea[8], eb[8], ek[8], er[8]; unpack8(qa, ea); unpack8(qb, eb); unpack8(kw, ek); unpack8(rw, er);
        const float sA = ssq8(ea), sB = (lane < 32) ? ssq8(eb) : 0.f;
        float rq[4];
#pragma unroll
        for (int h = 0; h < 4; ++h) rq[h] = rsqrtf(wave_sum((hA == h ? sA : 0.f) + (hB == h ? sB : 0.f)) * (1.0f / 192.0f) + EPS);
        const float rA = hA == 0 ? rq[0] : (hA == 1 ? rq[1] : rq[2]), rB = hB == 2 ? rq[2] : rq[3];
        scale8(ea, rA * QS192, qn + wA * 8); scale8(eb, rB * QS192, qn + wB * 8);
        if (lat) {
            float ta[8], tb[8];
#pragma unroll
            for (int i = 0; i < 8; ++i) { ta[i] = ea[i]; tb[i] = eb[i]; }
            mla_rope8(ta, (wA - 16) & 7, prow, pcol, tab, 2); mla_rope8(tb, (wB - 16) & 7, prow, pcol, tab, 2);
#pragma unroll
            for (int i = 0; i < 8; ++i) { if (wA >= 16) ea[i] = ta[i]; if (wB >= 16) eb[i] = tb[i]; }
        }
        unsigned char* q8 = F.ws + WS_Q8 + (size_t)r * Q8P + Q8_M; unsigned char* k8 = F.ws + WS_K8 + (size_t)r * K8P + K8_M;
        *(u32x2*)(q8 + lane * 8) = pack8_fp8(ea);
        if (lane < 32) *(u32x2*)(q8 + cB * 8) = pack8_fp8(eb);
        const float srope = wave_sum(lane < 8 ? ssq8(er) : 0.f);
        const float rk = rsqrtf((group16_sum(ssq8(ek)) + srope) * (1.0f / 192.0f) + EPS);
        scale8(ek, rk, kn + (lane & 15) * 8);
        *(u32x2*)(k8 + (lane >> 4) * 192 + (lane & 15) * 8) = pack8_fp8(ek);
        const float rkh = __shfl(rk, ((lane >> 3) & 3) * 16);
        scale8(er, rkh, kn + 128 + (lane & 7) * 8);
        if (lat) mla_rope8(er, lane & 7, prow, pcol, tab, 2);
        if (lane < 32) *(u32x2*)(k8 + (lane >> 3) * 192 + 128 + (lane & 7) * 8) = pack8_fp8(er);
    }
    __syncthreads();
    {
        LAS unsigned char* scr = F.lds + F.wave * 5120;
        for (int it = gw; it < 2 * 132 * 8; it += NGW) {
            const int g = it & 7, tb = (it >> 3) % 132, b = (it >> 3) / 132, h = g >> 1, half = g & 1;
            vtrans_item(MKV + h * 256 + 128 + half * 64, MQP, b, tb, F.ws + WS_V8T + ((size_t)((8 + h) * 2 + b) * 128 + half * 64) * VTP, scr, lane);
        }
        __syncthreads();
    }
}

#define QSTR 97
template <int DQK> __device__ __forceinline__ float qk_dot(const LAS unsigned* q, const bf16_t* k) {
    float s = 0.f;
#pragma unroll 4
    for (int c = 0; c < DQK / 8; ++c) {
        const u32x4 kv = *(const u32x4*)(k + c * 8);
#pragma unroll
        for (int j = 0; j < 4; ++j) { const unsigned qw = q[c * 4 + j]; s += lo16(qw) * lo16(kv[j]); s += hi16(qw) * hi16(kv[j]); }
    }
    return s;
}
__device__ __forceinline__ void attn_key(float s, const bf16_t* v, float& m, float& l, float (&o)[64]) {
    if (s > m) { const float al = __expf(m - s); l *= al;
#pragma unroll
        for (int d = 0; d < 64; ++d) o[d] *= al;
        m = s; }
    const float p = __expf(s - m); l += p;
    if (v) {
#pragma unroll
        for (int c = 0; c < 8; ++c) { const u32x4 vv = *(const u32x4*)(v + c * 8);
#pragma unroll
            for (int j = 0; j < 4; ++j) { o[c * 8 + 2 * j] += p * lo16(vv[j]); o[c * 8 + 2 * j + 1] += p * hi16(vv[j]); } }
    }
}
template <int DQK> __device__ __forceinline__ void nattn_item(Frame& F, int l, int mx, int h, int r0, bool is_ctx) {
    const int lane = F.lane;
    const bf16_t* PROJ = (const bf16_t*)(F.ws + WS_PROJ);
    const bf16_t *Q, *Kb, *Vb; int ldq, ldk, ldv;
    if (mx == 0) { Q = PROJ + C_AQ + h * 128; Kb = PROJ + C_AK + (h >> 1) * 128; Vb = PROJ + C_AV + (h >> 1) * 128; ldq = ldk = ldv = PP; }
    else if (mx == 1) { Q = (const bf16_t*)(F.ws + WS_MQ) + h * 192; Kb = (const bf16_t*)(F.ws + WS_MK) + h * 192; Vb = (const bf16_t*)(F.ws + WS_MKV) + h * 256 + 128; ldq = 768; ldk = 768; ldv = 1024; }
    else if (mx == 2) { Q = PROJ + C_WQ + h * 128; Kb = PROJ + C_WK + (h >> 1) * 128; Vb = PROJ + C_WV + (h >> 1) * 128; ldq = ldk = ldv = PP; }
    else { Q = PROJ + C_NQ + h * 128; Kb = PROJ + C_NK + h * 128; Vb = PROJ + C_NV + h * 128; ldq = ldk = ldv = PP; }
    const float scale = (DQK == 128) ? 0.08838834764831845f : 0.07216878364870323f;
    const int r = r0 + (lane & 31), half = lane >> 5;
    Vb += half * 64;
    LAS unsigned* qs = (LAS unsigned*)F.lds + (F.wave * 64 + lane) * QSTR;
    {
        const bf16_t* qp = Q + (size_t)r * ldq;
#pragma unroll
        for (int c = 0; c < DQK / 8; ++c) { const u32x4 v = *(const u32x4*)(qp + c * 8); qs[c * 4 + 0] = v.x; qs[c * 4 + 1] = v.y; qs[c * 4 + 2] = v.z; qs[c * 4 + 3] = v.w; }
    }
    float m = -1e30f, lsum = 0.f; float o[64];
#pragma unroll
    for (int d = 0; d < 64; ++d) o[d] = 0.f;
    const int b = is_ctx ? (r0 - TL) / NCTX : r0 / SEQ;
    for (int j = 0; j < NCTX; ++j) { const size_t kr = (size_t)(TL + b * NCTX + j);
        const float s = qk_dot<DQK>(qs, Kb + kr * ldk) * scale; attn_key(s, Vb + kr * ldv, m, lsum, o); }
    if (!is_ctx) {
        const int t = r - b * SEQ;
        if (mx <= 1) {
            for (int j = 0; j < SEQ; ++j) { const size_t kr = (size_t)(b * SEQ + j);
                const float s = qk_dot<DQK>(qs, Kb + kr * ldk) * scale; attn_key(s, Vb + kr * ldv, m, lsum, o); }
        } else if (mx == 2) {
            const int t0 = r0 - b * SEQ;
            for (int j = t0 - 128; j <= t0 + 31 + 128; ++j) {
                const int d = t - j;
                if (j >= 0 && j < SEQ && d <= 128 && d >= -128) { const size_t kr = (size_t)(b * SEQ + j);
                    const float s = qk_dot<DQK>(qs, Kb + kr * ldk) * scale; attn_key(s, Vb + kr * ldv, m, lsum, o); }
            }
        } else {
            const int rr = t / 64, cc = t % 64;
            const int rs = min(max(rr - 4, 0), 128 - 8), cs = min(max(cc - 8, 0), 64 - 16);
            const float* rpb = F.in(22) + (size_t)(l * 4 + h) * 15 * 31;
            for (int y = 0; y < 8; ++y)
                for (int kx = 0; kx < 16; ++kx) {
                    const size_t kr = (size_t)(b * SEQ + (rs + y) * 64 + cs + kx);
                    const int dy = rs + y - rr + 7, dx = cs + kx - cc + 15;
                    const float s = qk_dot<DQK>(qs, Kb + kr * ldk) * scale + rpb[dy * 31 + dx]; attn_key(s, Vb + kr * ldv, m, lsum, o); }
        }
    }
    if (mx == 2) attn_key(F.in(21)[l * 4 + h], nullptr, m, lsum, o);
    const float inv = 1.0f / lsum;
    bf16_t* op = (bf16_t*)(F.ws + WS_OUTS) + (size_t)r * DM + mx * 512 + h * 128 + half * 64;
#pragma unroll
    for (int c = 0; c < 8; ++c) { u32x4 w;
#pragma unroll
        for (int j = 0; j < 4; ++j) w[j] = pk2(o[c * 8 + 2 * j] * inv, o[c * 8 + 2 * j + 1] * inv);
        *(u32x4*)(op + c * 8) = w; }
}
__device__ __forceinline__ void ph_nattn(Frame& F, int l) {
    if (F.wave >= 4) return;
    const int slot = F.bid * 4 + F.wave, nslots = F.G * 4;
    const int total = 8192 + (l == 0 ? 256 : 0);
    for (int it = slot; it < total; it += nslots) {
        if (it < 8192) {
            const int grp = it >> 11, rem = it & 2047, h = rem >> 9, qi = rem & 511;
            const int mx = grp == 0 ? 1 : (grp == 1 ? 0 : grp);
            if (mx == 1) nattn_item<192>(F, l, 1, h, qi * 32, false); else nattn_item<128>(F, l, mx, h, qi * 32, false);
        } else {
            const int i2 = it - 8192, mx = i2 >> 6, h = (i2 >> 4) & 3, qi = i2 & 15;
            if (mx == 1) nattn_item<192>(F, l, 1, h, TL + qi * 32, true); else nattn_item<128>(F, l, mx, h, TL + qi * 32, true);
        }
    }
}

__device__ __forceinline__ void ph_nmerge(Frame& F, int l) {
    const int M = (l == 0) ? TT : TL, nn = DM / 64, ntiles = (M / 128) * nn;
    const int ty = F.tid >> 4, tx = F.tid & 15;
    const bf16_t* H = (const bf16_t*)(F.ws + WS_H); const bf16_t* OUTS = (const bf16_t*)(F.ws + WS_OUTS); bf16_t* ACC = (bf16_t*)(F.ws + WS_ACC);
    for (int t = F.bid; t < ntiles; t += F.G) {
        const int row0 = (t / nn) * 128, col0 = (t % nn) * 64;
        float tot[4][4]; ZERO44(tot);
        for (int i = 0; i < 4; ++i) {
            float ag[4][4], ab[4][4]; ZERO44(ag); ZERO44(ab);
            ngemm_tile(ag, H, DM, F.in(24) + (size_t)(l * 4 + i) * DM * DM, DM, DM, row0, col0, (LAS float*)F.lds, F.tid);
            ngemm_tile(ab, OUTS + i * 512, DM, F.in(23) + (size_t)(l * 4 + i) * 512 * DM, DM, 512, row0, col0, (LAS float*)F.lds, F.tid);
            const f32x4 bg = *(const f32x4*)(F.in(25) + (size_t)(l * 4 + i) * DM + col0 + tx * 4);
#pragma unroll
            for (int a = 0; a < 4; ++a)
#pragma unroll
                for (int b = 0; b < 4; ++b) tot[a][b] += sigmoidf_(ag[a][b] + bg[b]) * ab[a][b];
        }
#pragma unroll
        for (int a = 0; a < 4; ++a) { u32x2 w; w.x = pk2(tot[a][0], tot[a][1]); w.y = pk2(tot[a][2], tot[a][3]);
            *(u32x2*)(ACC + (size_t)(row0 + ty * 4 + a) * DM + col0 + tx * 4) = w; }
    }
}
__device__ __forceinline__ void ph_nout(Frame& F, int l) {
    const int M = (l == 0) ? TT : TL, nn = DM / 64, ntiles = (M / 128) * nn;
    const int ty = F.tid >> 4, tx = F.tid & 15;
    const bf16_t* ACC = (const bf16_t*)(F.ws + WS_ACC);
    for (int t = F.bid; t < ntiles; t += F.G) {
        const int row0 = (t / nn) * 128, col0 = (t % nn) * 64;
        float acc[4][4]; ZERO44(acc);
        ngemm_tile(acc, ACC, DM, F.in(26) + (size_t)l * DM * DM, DM, DM, row0, col0, (LAS float*)F.lds, F.tid);
#pragma unroll
        for (int a = 0; a < 4; ++a) { const int r = row0 + ty * 4 + a, c = col0 + tx * 4;
            const f32x4 xi = *(const f32x4*)(xin_row(F, l, r) + c), g1 = *(const f32x4*)(mod_vec(F, l, r, 2) + c);
            f32x4 o; o.x = xi.x + g1.x * acc[a][0]; o.y = xi.y + g1.y * acc[a][1]; o.z = xi.z + g1.z * acc[a][2]; o.w = xi.w + g1.w * acc[a][3];
            *(f32x4*)(xs_row(F, r) + c) = o; }
    }
}

__device__ __forceinline__ void ph_prep4(Frame& F, int l) {
    const int gw = F.bid * NWAVES + F.wave, NGW = F.G * NWAVES, lane = F.lane;
    const int nrows = (l == 0) ? TT : TL;
    bf16_t* H = (bf16_t*)(F.ws + WS_H);
    unsigned* ecnt = (unsigned*)(F.ws + WS_CTL) + CW_ECNT + l * 16;
    int* elist = (int*)(F.ws + WS_ELIST); float* elw = (float*)(F.ws + WS_ELW);
    LAS float* wrT = (LAS float*)F.lds;
    { const float* wr = F.in(27);
      for (int i = F.tid; i < DM * 4; i += NTHREADS) { const int k = i >> 2, e4 = i & 3; const f32x4 v = *(const f32x4*)(wr + (size_t)k * 16 + e4 * 4);
          wrT[(e4 * 4 + 0) * DM + k] = v.x; wrT[(e4 * 4 + 1) * DM + k] = v.y; wrT[(e4 * 4 + 2) * DM + k] = v.z; wrT[(e4 * 4 + 3) * DM + k] = v.w; }
      __syncthreads(); }
    const float* gn_ffn = F.in(7) + (size_t)l * DM; const float* rbias = F.in(28);
    constexpr int RPW = 12;
    LAS unsigned* lcnt = (LAS unsigned*)(F.lds + 131072 + 1024); LAS unsigned* lbase = lcnt + 16;
    LAS int* rt_e = (LAS int*)(lbase + 16); LAS int* rt_r = rt_e + NWAVES * RPW; LAS float* rt_w1 = (LAS float*)(rt_r + NWAVES * RPW); LAS float* rt_w2 = rt_w1 + NWAVES * RPW;
    LAS float* lgs = (LAS float*)(F.lds + 131072 + 4096) + F.wave * (RPW * 16);
    if (F.tid < 16) lcnt[F.tid] = 0u;
    __syncthreads();
    int nloc = 0;
    const bf16_t* XB = (const bf16_t*)(F.ws + WS_H);
    u32x2 vn[8];
    if (gw < nrows) { const bf16_t* xr0 = XB + (size_t)gw * DM;
#pragma unroll
        for (int j = 0; j < 8; ++j) vn[j] = *(const u32x2*)(xr0 + j * 256 + lane * 4); }
    for (int r = gw; r < nrows; r += NGW) {
        f32x4 v[8];
        float ss = 0.f;
#pragma unroll
        for (int j = 0; j < 8; ++j) { v[j] = (f32x4){lo16(vn[j].x), hi16(vn[j].x), lo16(vn[j].y), hi16(vn[j].y)}; ss += v[j].x * v[j].x + v[j].y * v[j].y + v[j].z * v[j].z + v[j].w * v[j].w; }
        if (r + NGW < nrows) { const bf16_t* xr1 = XB + (size_t)(r + NGW) * DM;
#pragma unroll
            for (int j = 0; j < 8; ++j) vn[j] = *(const u32x2*)(xr1 + j * 256 + lane * 4); }
        const float rstd = rsqrtf(wave_sum(ss) * (1.0f / DM) + EPS);
        const float* gn = gn_ffn; const float* sh = mod_vec(F, l, r, 3); const float* sc = mod_vec(F, l, r, 4);
        float lg[16];
#pragma unroll
        for (int e = 0; e < 16; ++e) lg[e] = 0.f;
#pragma unroll
        for (int j = 0; j < 8; ++j) {
            const int c = j * 256 + lane * 4;
            const f32x4 g = *(const f32x4*)(gn + c), s1 = *(const f32x4*)(sc + c), s0 = *(const f32x4*)(sh + c);
            const f32x4 h = (v[j] * rstd * g) * (s1 + 1.0f) + s0;
            if (FAST_MASK & 16) { int w8 = 0; w8 = cvt8s(h.x, h.y, w8, false); w8 = cvt8s(h.z, h.w, w8, true);
                *(int*)(F.ws + WS_H8 + (size_t)r * DM + c) = w8; }
            else { u32x2 w; w.x = pk2(h.x, h.y); w.y = pk2(h.z, h.w); *(u32x2*)(H + (size_t)r * DM + c) = w; }
#pragma unroll
            for (int e = 0; e < 16; ++e) { const f32x4 wv = *(const LAS f32x4*)(wrT + e * DM + c); lg[e] += (h.x * wv.x + h.y * wv.y) + (h.z * wv.z + h.w * wv.w); }
        }
        float q8[8], q4[4], q2[2], q1;
        { const bool b5 = (lane & 32) != 0;
#pragma unroll
          for (int i = 0; i < 8; ++i) { const float keep = b5 ? lg[8 + i] : lg[i], send = b5 ? lg[i] : lg[8 + i]; q8[i] = keep + __shfl_xor(send, 32); }
          const bool b4 = (lane & 16) != 0;
#pragma unroll
          for (int i = 0; i < 4; ++i) { const float keep = b4 ? q8[4 + i] : q8[i], send = b4 ? q8[i] : q8[4 + i]; q4[i] = keep + __shfl_xor(send, 16); }
          const bool b3 = (lane & 8) != 0;
#pragma unroll
          for (int i = 0; i < 2; ++i) { const float keep = b3 ? q4[2 + i] : q4[i], send = b3 ? q4[i] : q4[2 + i]; q2[i] = keep + __shfl_xor(send, 8); }
          const bool b2 = (lane & 4) != 0;
          { const float keep = b2 ? q2[1] : q2[0], send = b2 ? q2[0] : q2[1]; q1 = keep + __shfl_xor(send, 4); }
          q1 += __shfl_xor(q1, 2); q1 += __shfl_xor(q1, 1); }
        if ((lane & 3) == 0) lgs[nloc * 16 + (lane >> 2)] = q1;
        ++nloc;
    }
    asm volatile("s_waitcnt lgkmcnt(0)" ::: "memory");
    if (lane < nloc) {
        float zz[16];
#pragma unroll
        for (int e4 = 0; e4 < 4; ++e4) { const f32x4 t = *(const LAS f32x4*)(lgs + lane * 16 + e4 * 4); zz[e4 * 4] = t.x; zz[e4 * 4 + 1] = t.y; zz[e4 * 4 + 2] = t.z; zz[e4 * 4 + 3] = t.w; }
            float sc_[16], bs[16];
    #pragma unroll
            for (int e = 0; e < 16; ++e) { const float z = zz[e];
                sc_[e] = __builtin_amdgcn_rcpf(1.0f + __expf(-z)); bs[e] = sc_[e] + rbias[e]; }
            int bg = 0; float bgs;
    #pragma unroll
            for (int g = 0; g < 4; ++g) {
                const float a0 = bs[g * 4], a1 = bs[g * 4 + 1], a2 = bs[g * 4 + 2], a3 = bs[g * 4 + 3];
                const float lo1 = fminf(a0, a1), hi1 = fmaxf(a0, a1), lo2 = fminf(a2, a3), hi2 = fmaxf(a2, a3);
                const float gs = fmaxf(hi1, hi2) + fmaxf(fminf(hi1, hi2), fmaxf(lo1, lo2));
                if (g == 0) bgs = gs; else { const bool t = gs > bgs; bgs = t ? gs : bgs; bg = t ? g : bg; }
            }
            float x[4], su[4];
    #pragma unroll
            for (int q = 0; q < 4; ++q) { x[q] = bg == 0 ? bs[q] : (bg == 1 ? bs[4 + q] : (bg == 2 ? bs[8 + q] : bs[12 + q])); su[q] = bg == 0 ? sc_[q] : (bg == 1 ? sc_[4 + q] : (bg == 2 ? sc_[8 + q] : sc_[12 + q])); }
            int i1 = 0; float v1 = x[0], s1 = su[0];
    #pragma unroll
            for (int q = 1; q < 4; ++q) { const bool t = x[q] > v1; v1 = t ? x[q] : v1; s1 = t ? su[q] : s1; i1 = t ? q : i1; }
            int i2 = -1; float v2 = -3.0e38f, s2 = 0.f;
    #pragma unroll
            for (int q = 0; q < 4; ++q) { const bool t = (q != i1) && (x[q] > v2); v2 = t ? x[q] : v2; s2 = t ? su[q] : s2; i2 = t ? q : i2; }
            const int e1 = bg * 4 + i1, e2 = bg * 4 + i2;
            {
                const float inv = 1.0f / (s1 + s2); const int slot = F.wave * RPW + lane;
                rt_e[slot] = e1 | (e2 << 8); rt_r[slot] = gw + lane * NGW; rt_w1[slot] = s1 * inv; rt_w2[slot] = s2 * inv;
                (void)__hip_atomic_fetch_add(&lcnt[e1], 1u, __ATOMIC_RELAXED, __HIP_MEMORY_SCOPE_WORKGROUP); (void)__hip_atomic_fetch_add(&lcnt[e2], 1u, __ATOMIC_RELAXED, __HIP_MEMORY_SCOPE_WORKGROUP);
            }
    }
    __syncthreads();
    if (F.tid < 16) { const unsigned n = lcnt[F.tid]; lbase[F.tid] = n ? atomicAdd(ecnt + F.tid, n) : 0u; lcnt[F.tid] = 0u; }
    __syncthreads();
    if (lane < nloc) {
        const int slot = F.wave * RPW + lane; const int e1 = rt_e[slot] & 255, e2 = rt_e[slot] >> 8, r = rt_r[slot];
        const unsigned p1 = lbase[e1] + __hip_atomic_fetch_add(&lcnt[e1], 1u, __ATOMIC_RELAXED, __HIP_MEMORY_SCOPE_WORKGROUP); elist[(size_t)e1 * TT + p1] = r * 2 + 0; elw[(size_t)e1 * TT + p1] = rt_w1[slot];
        const unsigned p2 = lbase[e2] + __hip_atomic_fetch_add(&lcnt[e2], 1u, __ATOMIC_RELAXED, __HIP_MEMORY_SCOPE_WORKGROUP); elist[(size_t)e2 * TT + p2] = r * 2 + 1; elw[(size_t)e2 * TT + p2] = rt_w2[slot];
    }
    __syncthreads();
}

__device__ __forceinline__ void ph_nmoe(Frame& F, int l) {
    const unsigned* ecnt = (const unsigned*)(F.ws + WS_CTL) + CW_ECNT + l * 16;
    const int* elist = (const int*)(F.ws + WS_ELIST); const float* elw = (const float*)(F.ws + WS_ELW);
    const bf16_t* H = (const bf16_t*)(F.ws + WS_H); bf16_t* Y = (bf16_t*)(F.ws + WS_PROJ);
    LAS float* hx = (LAS float*)F.lds;
    LAS float* hid = hx + 8 * DM;
    LAS int* ent = (LAS int*)(hid + 8 * DEXP);
    LAS float* entw = (LAS float*)(ent + 8);
    int total = 0;
    for (int e = 0; e < 16; ++e) total += ((int)ecnt[e] + 7) >> 3;
    const int tid = F.tid;
    for (int item = F.bid; item < total; item += F.G) {
        int e = 0, cbase = 0, acc = 0, cnt = 0;
        for (int i = 0; i < 16; ++i) { const int n = (int)ecnt[i], c = (n + 7) >> 3; if (item >= acc && item < acc + c) { e = i; cbase = acc; cnt = n; } acc += c; }
        const int p0 = (item - cbase) * 8, nv = min(8, cnt - p0);
        __syncthreads();
        if (tid < 8) { ent[tid] = tid < nv ? elist[(size_t)e * TT + p0 + tid] : -1; entw[tid] = tid < nv ? elw[(size_t)e * TT + p0 + tid] : 0.f; }
        __syncthreads();
        for (int i = tid; i < 8 * DM; i += NTHREADS) { const int t = i / DM, k = i % DM; const int en = ent[t]; hx[i] = en >= 0 ? bf2f(H[(size_t)(en >> 1) * DM + k]) : 0.f; }
        __syncthreads();
        {
            const float* w1 = F.in(29) + (size_t)(l * 16 + e) * DM * DEXP + tid; const float* w3 = F.in(30) + (size_t)(l * 16 + e) * DM * DEXP + tid;
            float a1[8], a3[8];
#pragma unroll
            for (int t = 0; t < 8; ++t) { a1[t] = 0.f; a3[t] = 0.f; }
#pragma unroll 4
            for (int d = 0; d < DM; ++d) { const float x1 = w1[(size_t)d * DEXP], x3 = w3[(size_t)d * DEXP];
#pragma unroll
                for (int t = 0; t < 8; ++t) { const float hv = hx[t * DM + d]; a1[t] += hv * x1; a3[t] += hv * x3; } }
#pragma unroll
            for (int t = 0; t < 8; ++t) hid[t * DEXP + tid] = siluf_(a1[t]) * a3[t];
        }
        __syncthreads();
        {
            const float* w2 = F.in(31) + (size_t)(l * 16 + e) * DEXP * DM + tid * 4;
            f32x4 a[8];
#pragma unroll
            for (int t = 0; t < 8; ++t) a[t] = (f32x4){0.f, 0.f, 0.f, 0.f};
#pragma unroll 4
            for (int j = 0; j < DEXP; ++j) { const f32x4 w = *(const f32x4*)(w2 + (size_t)j * DM);
#pragma unroll
                for (int t = 0; t < 8; ++t) a[t] += w * hid[t * DEXP + j]; }
#pragma unroll
            for (int t = 0; t < 8; ++t) { const int en = ent[t]; if (en >= 0) { const float w = entw[t];
                u32x2 o; o.x = pk2(a[t].x * w, a[t].y * w); o.y = pk2(a[t].z * w, a[t].w * w);
                *(u32x2*)(Y + (size_t)(en & 1) * TT * DM + (size_t)(en >> 1) * DM + tid * 4) = o; } }
        }
    }
    __syncthreads();
}


namespace pg8 {
typedef short bf16x8 __attribute__((ext_vector_type(8)));
typedef int v4i_t __attribute__((ext_vector_type(4)));
typedef int v8i_t __attribute__((ext_vector_type(8)));
constexpr int BM = 256, BK = 64, HALF = 128, HTB = HALF * BK * 2, STAGE_BYTES = 8 * HTB, NXCD = 8, WGM = 8;
__host__ __device__ __forceinline__ int lds_byte(int r, int c) { const int st = (r >> 4) * 2 + (c >> 5), rr = r & 15, cc = c & 31, ob = rr * 64 + cc * 2; return st * 1024 + (ob ^ (((ob >> 9) & 1) << 5)); }
__host__ __device__ __forceinline__ void stage_rc(int b, int& R, int& C) { const int st = b / 1024, sb = b % 1024, swz = sb ^ (((sb >> 9) & 1) << 5); R = (st >> 1) * 16 + swz / 64; C = (st & 1) * 32 + (swz % 64) / 2; }
__host__ __device__ __forceinline__ void stage_rc8(int b, int& R, int& C) { const int st = b / 1024, sb = b % 1024, r = sb / 64, j = ((sb % 64) / 16) ^ ((r >> 3) & 1); R = (st >> 1) * 16 + r; C = (st & 1) * 32 + j * 8; }
__host__ __device__ __forceinline__ int lds_byte8(int r, int fq, int half) { const int rr = r & 15; return ((r >> 4) * 2 + (fq >> 1)) * 1024 + rr * 64 + (((2 * (fq & 1) + half) ^ ((rr >> 3) & 1)) * 16); }
__host__ __device__ __forceinline__ int perm32(int rho) { const int n = rho >> 4, i = rho & 15; return 8 * (i >> 2) + 4 * n + (i & 3); }

struct Unit { int pm, pn; const char* A; const char* B; const int* list; int nrows; int aux; };

__device__ __forceinline__ void xcd_decode(int L, int nM, int nN, int& pm, int& pn) {
    const int nwg = nM * nN; int wgid = L;
    { const int q = nwg / NXCD, r = nwg % NXCD, xcd = wgid % NXCD, off = wgid / NXCD; wgid = (xcd < r ? xcd * (q + 1) : r * (q + 1) + (xcd - r) * q) + off; }
    const int nig = WGM * nN, gid = wgid / nig, fm = gid * WGM, gsz = (nM - fm) < WGM ? (nM - fm) : WGM;
    pm = fm + ((wgid % nig) % gsz); pn = (wgid % nig) / gsz;
}
struct SchedPlain {
    const char* A; const char* B; int lda, ldb, nM, nN, G, c, a_div, a_colbytes;
    unsigned* dq; int dstride, dbase;
    __device__ __forceinline__ bool next(int i, Unit& u) const { return at((long)i * G + c, u); }
    __device__ __forceinline__ bool at(const long L, Unit& u) const {
        if (L >= (long)nM * nN) return false;
        int pm, pn; xcd_decode((int)L, nM, nN, pm, pn);
        u.pm = pm; u.pn = pn; u.A = A + (size_t)pm * BM * lda * 2 + (size_t)(pn / a_div) * a_colbytes; u.B = B + (size_t)pn * BM * ldb * 2; u.list = nullptr; u.nrows = BM; u.aux = 0; return true;
    }
};

__device__ __forceinline__ unsigned cvt_pk_bf16(float lo, float hi) { unsigned r; asm volatile("v_cvt_pk_bf16_f32 %0, %1, %2" : "=v"(r) : "v"(lo), "v"(hi)); return r; }

struct EpiBf16 {
    static constexpr bool PERM = true;
    bf16_t* O; int ldc; float scale;
    __device__ __forceinline__ void operator()(const f32x4 (&acc)[2][2][4][2], const Unit& u, int wr, int wc, int fr, int fq) const {
        const int row0 = u.pm * BM + wr * 64 + fr, col0 = u.pn * BM + wc * 32 + 8 * fq;
#pragma unroll
        for (int ai = 0; ai < 2; ++ai)
#pragma unroll
            for (int m = 0; m < 4; ++m) { bf16_t* rowp = O + (size_t)(row0 + ai * HALF + m * 16) * ldc + col0;
#pragma unroll
                for (int bj = 0; bj < 2; ++bj) { const f32x4 v0 = acc[ai][bj][m][0] * scale, v1 = acc[ai][bj][m][1] * scale;
                    u32x4 w; w.x = cvt_pk_bf16(v0[0], v0[1]); w.y = cvt_pk_bf16(v0[2], v0[3]); w.z = cvt_pk_bf16(v1[0], v1[1]); w.w = cvt_pk_bf16(v1[2], v1[3]);
                    *(u32x4*)(rowp + bj * HALF) = w; } }
    }
};
struct EpiFp8 {
    static constexpr bool PERM = true;
    unsigned char* O; int ldc; float scale;
    __device__ __forceinline__ void operator()(const f32x4 (&acc)[2][2][4][2], const Unit& u, int wr, int wc, int fr, int fq) const {
        const int row0 = u.pm * BM + wr * 64 + fr, col0 = u.pn * BM + wc * 32 + 8 * fq;
#pragma unroll
        for (int ai = 0; ai < 2; ++ai)
#pragma unroll
            for (int m = 0; m < 4; ++m) { unsigned char* rowp = O + (size_t)(row0 + ai * HALF + m * 16) * ldc + col0;
#pragma unroll
                for (int bj = 0; bj < 2; ++bj) { const f32x4 v0 = acc[ai][bj][m][0] * scale, v1 = acc[ai][bj][m][1] * scale;
                    int a = 0, b = 0; a = cvt8s(v0[0], v0[1], a, false); a = cvt8s(v0[2], v0[3], a, true); b = cvt8s(v1[0], v1[1], b, false); b = cvt8s(v1[2], v1[3], b, true);
                    u32x2 w; w.x = (unsigned)a; w.y = (unsigned)b; *(u32x2*)(rowp + bj * HALF) = w; } }
    }
};
template <bool IN16>
struct EpiResid {
    static constexpr bool PERM = true;
    const float* xin_lat; const float* xin_ctx; bf16_t* XB; const float* modbase; int which; float scale;
    __device__ __forceinline__ void operator()(const f32x4 (&acc)[2][2][4][2], const Unit& u, int wr, int wc, int fr, int fq) const {
        const bool lat = u.pm < TL / BM; const int s = lat ? (u.pm * BM) / SEQ : 2;
        const float* xi = lat ? xin_lat + (size_t)u.pm * BM * DM : xin_ctx + (size_t)(u.pm * BM - TL) * DM;
        bf16_t* xb = XB + (size_t)u.pm * BM * DM;
        const float* g = modbase + (size_t)s * 6 * DM + which * DM;
        const int col0 = u.pn * BM + wc * 32 + 8 * fq;
        const size_t ro0 = (size_t)(wr * 64 + fr) * DM + col0;
#pragma unroll
        for (int bj = 0; bj < 2; ++bj) { const f32x4 g0 = *(const f32x4*)(g + col0 + bj * HALF) * scale, g1 = *(const f32x4*)(g + col0 + bj * HALF + 4) * scale;
            f32x4 xa[2][4][2];
#pragma unroll
            for (int ai = 0; ai < 2; ++ai)
#pragma unroll
                for (int m = 0; m < 4; ++m) { const size_t ro = ro0 + (size_t)(ai * HALF + m * 16) * DM + bj * HALF;
                    if constexpr (IN16) { const u32x4 t = *(const u32x4*)(xb + ro); xa[ai][m][0] = (f32x4){lo16(t.x), hi16(t.x), lo16(t.y), hi16(t.y)}; xa[ai][m][1] = (f32x4){lo16(t.z), hi16(t.z), lo16(t.w), hi16(t.w)}; }
                    else { xa[ai][m][0] = *(const f32x4*)(xi + ro); xa[ai][m][1] = *(const f32x4*)(xi + ro + 4); } }
#pragma unroll
            for (int ai = 0; ai < 2; ++ai)
#pragma unroll
                for (int m = 0; m < 4; ++m) { const size_t ro = ro0 + (size_t)(ai * HALF + m * 16) * DM + bj * HALF;
                    const f32x4 r0 = xa[ai][m][0] + g0 * acc[ai][bj][m][0], r1 = xa[ai][m][1] + g1 * acc[ai][bj][m][1];
                    u32x4 w; w.x = cvt_pk_bf16(r0[0], r0[1]); w.y = cvt_pk_bf16(r0[2], r0[3]); w.z = cvt_pk_bf16(r1[0], r1[1]); w.w = cvt_pk_bf16(r1[2], r1[3]);
                    *(u32x4*)(xb + ro) = w; }
            asm volatile("" ::: "memory"); }
    }
};

template <class Epi, class Sched, bool GATHER, bool FP8 = false, bool DYN = false>
__device__ __forceinline__ void gemm_phase(LAS unsigned char* lds, const int tid_in, const int lda, const int ldb, const int K, const Sched& S, const Epi& E) {
    const int wid = __builtin_amdgcn_readfirstlane(tid_in >> 6), lane = tid_in & 63, wr = wid >> 2, wc = wid & 3, fr = lane & 15, fq = lane >> 4;
    const int nt = K / BK;
#define tid (wid * 64 + lane)
    unsigned ao[2][2], voffA[2], voffB[2];
#pragma unroll
    for (int i = 0; i < 2; ++i) { int R, C; if constexpr (FP8) stage_rc8(tid * 16 + i * 8192, R, C); else stage_rc(tid * 16 + i * 8192, R, C); const int Rb = Epi::PERM ? ((R & ~31) + perm32(R & 31)) : R;
        voffB[i] = (unsigned)(Rb * ldb + C) * 2u; voffA[i] = (unsigned)(R * lda + C) * 2u;
        ao[0][i] = 0u; ao[1][i] = 0u; }
    const size_t kstep = (size_t)(BK * 2);
    const size_t hstepB = (size_t)HALF * ldb * 2, hstepA = (size_t)HALF * lda * 2;
    const unsigned ldsw = (unsigned)wid * 1024u;
    const int aoff = lds_byte(wr * 64 + fr, fq * 8), boff = lds_byte(wc * 32 + fr, fq * 8);
    const int aoff8 = lds_byte8(wr * 64 + fr, fq, 0), boff8 = lds_byte8(wc * 32 + fr, fq, 0), aoff8b = lds_byte8(wr * 64 + fr, fq, 1), boff8b = lds_byte8(wc * 32 + fr, fq, 1);
#define PG8_SA(b, h) (((b) * 2 + (h)) * HTB)
#define PG8_SB(b, h) ((4 + (b) * 2 + (h)) * HTB)
#define PG8_STAGE(bufoff, gbase, voff) do { _Pragma("unroll") for (int _i = 0; _i < 2; ++_i) \
        __builtin_amdgcn_global_load_lds((const unsigned*)((const char*)(gbase) + (voff)[_i]), (LAS unsigned*)(lds + (bufoff) + ldsw + _i * 8192), 16, 0, 0); } while (0)
#define PG8_STAGE_A(bufoff, gbase, h, nx) do { if constexpr (GATHER) { _Pragma("unroll") for (int _i = 0; _i < 2; ++_i) { const unsigned _o = ao[h][_i]; \
        __builtin_amdgcn_global_load_lds((const unsigned*)((const char*)(gbase) + _o), (LAS unsigned*)(lds + (bufoff) + ldsw + _i * 8192), 16, 0, 0); } } \
        else { PG8_STAGE(bufoff, (const char*)(gbase) + ((h) ? hstepA : (size_t)0), voffA); } } while (0)
#define PG8_LDA(dst, b, h) do { if constexpr (FP8) { _Pragma("unroll") for (int m = 0; m < 4; ++m) dst##8[m] = __builtin_shufflevector(*(const LAS v4i_t*)(lds + PG8_SA(b, h) + aoff8 + m * 2048), *(const LAS v4i_t*)(lds + PG8_SA(b, h) + aoff8b + m * 2048), 0, 1, 2, 3, 4, 5, 6, 7); } \
        else { _Pragma("unroll") for (int m = 0; m < 4; ++m) _Pragma("unroll") for (int k = 0; k < 2; ++k) dst[m][k] = *(const LAS bf16x8*)(lds + PG8_SA(b, h) + aoff + m * 2048 + k * 1024); } } while (0)
#define PG8_LDB(dst, b, h) do { if constexpr (FP8) { _Pragma("unroll") for (int n = 0; n < 2; ++n) dst##8[n] = __builtin_shufflevector(*(const LAS v4i_t*)(lds + PG8_SB(b, h) + boff8 + n * 2048), *(const LAS v4i_t*)(lds + PG8_SB(b, h) + boff8b + n * 2048), 0, 1, 2, 3, 4, 5, 6, 7); } \
        else { _Pragma("unroll") for (int n = 0; n < 2; ++n) _Pragma("unroll") for (int k = 0; k < 2; ++k) dst[n][k] = *(const LAS bf16x8*)(lds + PG8_SB(b, h) + boff + n * 2048 + k * 1024); } } while (0)
#define PG8_MMA(ai, bj, At, Bt) do { __builtin_amdgcn_s_setprio(1); if constexpr (FP8) { _Pragma("unroll") for (int m = 0; m < 4; ++m) _Pragma("unroll") for (int n = 0; n < 2; ++n) \
        asm volatile("v_mfma_f32_16x16x128_f8f6f4 %0, %1, %2, %0" : "+v"(acc[ai][bj][m][n]) : "v"(Bt##8[n]), "v"(At##8[m])); } \
        else { _Pragma("unroll") for (int m = 0; m < 4; ++m) _Pragma("unroll") for (int n = 0; n < 2; ++n) _Pragma("unroll") for (int k = 0; k < 2; ++k) \
        acc[ai][bj][m][n] = __builtin_amdgcn_mfma_f32_16x16x32_bf16(Bt[n][k], At[m][k], acc[ai][bj][m][n], 0, 0, 0); } __builtin_amdgcn_s_setprio(0); } while (0)
#define PG8_WAIT_V(n) asm volatile("s_waitcnt vmcnt(" #n ")" ::: "memory")
#define PG8_WAIT_L(n) asm volatile("s_waitcnt lgkmcnt(" #n ")" ::: "memory")
#define PG8_BAR __builtin_amdgcn_s_barrier()
#define PG8_SCHED __builtin_amdgcn_sched_barrier(0)
#define PG8_GOFF(dst, u) do { if constexpr (GATHER) { _Pragma("unroll") for (int _i = 0; _i < 2; ++_i) { int _R, _C; if constexpr (FP8) stage_rc8(tid * 16 + _i * 8192, _R, _C); else stage_rc(tid * 16 + _i * 8192, _R, _C); \
        _Pragma("unroll") for (int _h = 0; _h < 2; ++_h) { const int _r = _R + _h * HALF; \
        const int _e = (_r < (u).nrows) ? (u).list[_r] : (u).list[0]; dst[_h][_i] = (unsigned)(_e >> 1) * (unsigned)(lda * 2) + (unsigned)(_C * 2); } } } } while (0)
    Unit cur, nxt; int ui = 0;
    if (!S.next(0, cur)) return;
    volatile LAS unsigned* Qs = (volatile LAS unsigned*)(lds + 131072 + 320) + 24;
    unsigned pend = 0;
    if constexpr (DYN) {
        if (tid_in == 0) Qs[1] = __hip_atomic_fetch_add(S.dq, 1u, __ATOMIC_RELAXED, __HIP_MEMORY_SCOPE_AGENT);
        asm volatile("s_waitcnt lgkmcnt(0)" ::: "memory"); __builtin_amdgcn_s_barrier();
    }
    f32x4 acc[2][2][4][2];
#define PG8_ZERO_ACC() do { float _z = 0.f; asm volatile("" : "+v"(_z)); const f32x4 _zv = (f32x4){_z, _z, _z, _z}; \
    _Pragma("unroll") for (int a = 0; a < 2; ++a) _Pragma("unroll") for (int b = 0; b < 2; ++b) _Pragma("unroll") for (int m = 0; m < 4; ++m) _Pragma("unroll") for (int n = 0; n < 2; ++n) acc[a][b][m][n] = _zv; \
    if constexpr (FP8) asm volatile("s_nop 15" ::: "memory"); } while (0)
    PG8_ZERO_ACC();
    const int sc1 = 0x7f7f7f7f;
    bf16x8 At[4][2], B0[2][2], B1[2][2]; v8i_t At8[4], B08[2], B18[2];
    const char* cA = cur.A; const char* cB = cur.B;
    PG8_GOFF(ao, cur);
    PG8_STAGE(PG8_SB(0, 0), cB, voffB); PG8_STAGE(PG8_SB(0, 1), cB + hstepB, voffB); PG8_STAGE_A(PG8_SA(0, 0), cA, 0, false); PG8_STAGE_A(PG8_SA(0, 1), cA, 1, false);
    if (wr == 1) PG8_BAR;
    PG8_WAIT_V(2); PG8_BAR;
    PG8_STAGE(PG8_SB(1, 0), cB + kstep, voffB); PG8_STAGE_A(PG8_SA(1, 0), cA + kstep, 0, false); PG8_STAGE(PG8_SB(1, 1), cB + hstepB + kstep, voffB);
    PG8_WAIT_V(6); PG8_BAR;
    for (;;) {
        bool has_next;
        if constexpr (DYN) {
            const unsigned tk = (unsigned)__builtin_amdgcn_readfirstlane((int)Qs[(ui + 1) & 1]);
            has_next = S.at((long)S.G + (long)tk * S.dstride + S.dbase, nxt);
            if (tid_in == 0) asm volatile("global_atomic_add %0, %1, %2, off sc0" : "=v"(pend) : "v"(S.dq), "v"(1u) : "memory");
        } else has_next = S.next(ui + 1, nxt);
        const char* nA = has_next ? nxt.A : cA; const char* nB = has_next ? nxt.B : cB;
#if CLK_PROBE >= 3 && CLK_PROBE <= 5
        if (FP8 && (ui == 1 || ui == 2) && blockIdx.x == 0 && tid_in == 0 && ((volatile LAS unsigned*)(lds + 131072 + 320))[20] == 1u) { volatile LAS unsigned* M_ = (volatile LAS unsigned*)(lds + 131072 + 320);
            const unsigned now = (unsigned)__builtin_readcyclecounter();
            if (ui == 1) M_[16] = now; else { if (CLK_PROBE == 4) M_[18] = now - M_[17]; if (CLK_PROBE == 5) M_[18] = (now - M_[16]) / 2u; } }
#endif
        for (int t = 0; t < nt; t += 2) {
            const bool last = (t == nt - 2);
            const char* a1 = cA + (size_t)(t + 1) * kstep;
            const char* a2 = last ? nA : cA + (size_t)(t + 2) * kstep; const char* b2 = last ? nB : cB + (size_t)(t + 2) * kstep;
            const char* a3 = a2 + kstep; const char* b3 = b2 + kstep;
            const bool nx = GATHER && last;
            PG8_LDB(B0, 0, 0); PG8_LDB(B1, 0, 1); PG8_SCHED; PG8_LDA(At, 0, 0); PG8_STAGE_A(PG8_SA(1, 1), a1, 1, false);
            if constexpr (GATHER) { if (last && has_next) { PG8_GOFF(ao, nxt); } }
            PG8_WAIT_V(8); PG8_WAIT_L(0); PG8_BAR; PG8_MMA(0, 0, At, B0); PG8_MMA(0, 1, At, B1); PG8_BAR; PG8_SCHED;
            PG8_LDA(At, 0, 1); PG8_STAGE(PG8_SB(0, 0), b2, voffB); PG8_STAGE(PG8_SB(0, 1), b2 + hstepB, voffB); PG8_STAGE_A(PG8_SA(0, 0), a2, 0, nx);
            PG8_WAIT_V(8); PG8_WAIT_L(0); PG8_BAR; PG8_MMA(1, 0, At, B0); PG8_MMA(1, 1, At, B1); PG8_BAR; PG8_SCHED;
            PG8_LDB(B0, 1, 0); PG8_LDB(B1, 1, 1); PG8_SCHED; PG8_LDA(At, 1, 0); PG8_STAGE_A(PG8_SA(0, 1), a2, 1, nx);
            PG8_WAIT_V(8); PG8_WAIT_L(0); PG8_BAR; PG8_MMA(0, 0, At, B0); PG8_MMA(0, 1, At, B1); PG8_BAR; PG8_SCHED;
            PG8_LDA(At, 1, 1); PG8_STAGE(PG8_SB(1, 0), b3, voffB); PG8_STAGE(PG8_SB(1, 1), b3 + hstepB, voffB); PG8_STAGE_A(PG8_SA(1, 0), a3, 0, nx);
            PG8_WAIT_V(8); PG8_WAIT_L(0); PG8_BAR; PG8_MMA(1, 0, At, B0); PG8_MMA(1, 1, At, B1); PG8_BAR; PG8_SCHED;
        }
#if CLK_PROBE >= 3 && CLK_PROBE <= 5
        if (FP8 && ui == 1 && blockIdx.x == 0 && tid_in == 0 && ((volatile LAS unsigned*)(lds + 131072 + 320))[20] == 1u) { volatile LAS unsigned* M_ = (volatile LAS unsigned*)(lds + 131072 + 320);
            const unsigned now = (unsigned)__builtin_readcyclecounter(); M_[17] = now; if (CLK_PROBE == 3) M_[18] = (now - M_[16]) / (unsigned)nt * 10u; }
#endif
        if constexpr (DYN) { if (tid_in == 0) Qs[ui & 1] = pend; asm volatile("s_waitcnt lgkmcnt(0)" ::: "memory"); }
        if (wr == 0) PG8_BAR;
        if constexpr (FP8) asm volatile("s_nop 15\n\ts_nop 15" ::: "memory");
        { int ln = lane; asm volatile("" : "+v"(ln)); E(acc, cur, wr, wc, ln & 15, ln >> 4); }
        if (!has_next) break;
        PG8_ZERO_ACC();
        cur = nxt; cA = nA; cB = nB; ++ui;
        if (wr == 1) PG8_BAR;
    }
    PG8_WAIT_V(0);
    PG8_BAR;
#undef PG8_SA
#undef PG8_SB
#undef PG8_STAGE
#undef PG8_STAGE_A
#undef PG8_LDA
#undef PG8_LDB
#undef PG8_MMA
#undef PG8_WAIT_V
#undef PG8_WAIT_L
#undef PG8_BAR
#undef PG8_SCHED
#undef PG8_GOFF
#undef PG8_ZERO_ACC
#undef tid
}
}


struct MapPlain { __device__ __forceinline__ int operator()(int n) const { return n; } };
struct MapGate { int i; __device__ __forceinline__ int operator()(int ch) const { return (ch >> 6) * 256 + 128 * (i >> 1) + 32 * ((ch & 63) >> 4) + 16 * (i & 1) + (ch & 15); } };
struct MapW13 { int which; __device__ __forceinline__ int operator()(int j) const { return (j >> 7) * 256 + which * 128 + (j & 127); } };
template <class Map> __device__ __forceinline__ void cvt_item(const float* W, int N, int k0, int n0, bf16_t* WT, int ldk, const Map& map, LAS float* scr, int lane) {
#pragma unroll 8
    for (int i = 0; i < 32; ++i) { const int kk = 2 * i + (lane >> 5); scr[kk * 33 + (lane & 31)] = W[(size_t)(k0 + kk) * N + n0 + (lane & 31)]; }
    asm volatile("s_waitcnt lgkmcnt(0)" ::: "memory");
    const int c = lane & 7;
#pragma unroll
    for (int j = 0; j < 4; ++j) { const int n = (lane >> 3) + 8 * j; const LAS float* sp = scr + (8 * c) * 33 + n;
        u32x4 o; o.x = pk2(sp[0 * 33], sp[1 * 33]); o.y = pk2(sp[2 * 33], sp[3 * 33]); o.z = pk2(sp[4 * 33], sp[5 * 33]); o.w = pk2(sp[6 * 33], sp[7 * 33]);
        *(u32x4*)(WT + (size_t)map(n0 + n) * ldk + k0 + 8 * c) = o; }
    asm volatile("s_waitcnt lgkmcnt(0)" ::: "memory");
}
template <class Map> __device__ __forceinline__ void cvt_item8(const float* W, int N, int k0, int n0, unsigned char* WT, int ldk, const Map& map, float scale, LAS float* scr, int lane) {
#pragma unroll 8
    for (int i = 0; i < 32; ++i) { const int kk = 2 * i + (lane >> 5); scr[kk * 33 + (lane & 31)] = W[(size_t)(k0 + kk) * N + n0 + (lane & 31)]; }
    asm volatile("s_waitcnt lgkmcnt(0)" ::: "memory");
    const int c = lane & 7;
#pragma unroll
    for (int j = 0; j < 4; ++j) { const int n = (lane >> 3) + 8 * j; const LAS float* sp = scr + (8 * c) * 33 + n;
        int a = 0, b = 0;
        a = __builtin_amdgcn_cvt_pk_fp8_f32(sp[0 * 33] * scale, sp[1 * 33] * scale, a, false); a = __builtin_amdgcn_cvt_pk_fp8_f32(sp[2 * 33] * scale, sp[3 * 33] * scale, a, true);
        b = __builtin_amdgcn_cvt_pk_fp8_f32(sp[4 * 33] * scale, sp[5 * 33] * scale, b, false); b = __builtin_amdgcn_cvt_pk_fp8_f32(sp[6 * 33] * scale, sp[7 * 33] * scale, b, true);
        u32x2 o; o.x = (unsigned)a; o.y = (unsigned)b;
        *(u32x2*)(WT + (size_t)map(n0 + n) * ldk + k0 + 8 * c) = o; }
    asm volatile("s_waitcnt lgkmcnt(0)" ::: "memory");
}
template <class Map> __device__ __forceinline__ int cvt_matrix8(Frame& F, const float* W, int K, int N, unsigned char* WT, const Map& map, float scale, int run, int ldk = 0) {
    LAS float* scr = (LAS float*)(F.lds + F.wave * 8448);
    const int gw = F.bid * NWAVES + F.wave, NGW = F.G * NWAVES;
    const int nblk = N / 32, nitems = (K / 64) * nblk;
    int first = (gw - (run % NGW) + NGW) % NGW;
    for (int it = first; it < nitems; it += NGW) cvt_item8(W, N, (it / nblk) * 64, (it % nblk) * 32, WT, ldk ? ldk : K, map, scale, scr, F.lane);
    return run + nitems;
}
template <class Map> __device__ __forceinline__ int cvt_matrix(Frame& F, const float* W, int K, int N, bf16_t* WT, const Map& map, int run) {
    LAS float* scr = (LAS float*)(F.lds + F.wave * 8448);
    const int gw = F.bid * NWAVES + F.wave, NGW = F.G * NWAVES;
    const int nblk = N / 32, nitems = (K / 64) * nblk;
    int first = (gw - (run % NGW) + NGW) % NGW;
    for (int it = first; it < nitems; it += NGW) cvt_item(W, N, (it / nblk) * 64, (it % nblk) * 32, WT, K, map, scr, F.lane);
    return run + nitems;
}
__device__ __forceinline__ void ph_convert(Frame& F) {
    int run = 0;
    for (int l = 0; l < DEPTH; ++l) {
        unsigned char* wl = F.ws + WS_W + (size_t)l * WL_STRIDE;
        run = cvt_matrix8(F, F.in(8) + (size_t)l * DM * DIN, DM, DIN, (unsigned char*)(wl + WO_IN), MapPlain{}, GATE_WSCALE, run);
        {
            u32x4* z = (u32x4*)((unsigned char*)(wl + WO_IN) + (size_t)DIN * DM); const int n16 = (PP - DIN) * DM / 16;
            for (int i = F.bid * NTHREADS + F.tid; i < n16; i += F.G * NTHREADS) z[i] = (u32x4){0u, 0u, 0u, 0u};
        }
        run = cvt_matrix8(F, F.in(12) + (size_t)l * 256 * 1024, 256, 1024, (unsigned char*)(wl + WO_UQ), MapPlain{}, GATE_WSCALE, run, 512);
        run = cvt_matrix8(F, F.in(10) + (size_t)l * 384 * 768, 384, 768, (unsigned char*)(wl + WO_UQ) + 1024 * 512 + 128, MapPlain{}, GATE_WSCALE, run, 512);
        {
            unsigned char* wb = (unsigned char*)(wl + WO_UQ);
            for (int i = F.bid * NTHREADS + F.tid; i < 1024 * 16 + 768 * 8; i += F.G * NTHREADS) {
                u32x4* z = (i < 1024 * 16) ? (u32x4*)(wb + (size_t)(i >> 4) * 512 + 256 + (i & 15) * 16) : (u32x4*)(wb + (size_t)(1024 + ((i - 1024 * 16) >> 3)) * 512 + ((i - 1024 * 16) & 7) * 16);
                *z = (u32x4){0u, 0u, 0u, 0u};
            }
        }
        for (int i = 0; i < 4; ++i) run = cvt_matrix8(F, F.in(24) + (size_t)(l * 4 + i) * DM * DM, DM, DM, (unsigned char*)(wl + WO_G), MapGate{i}, GATE_WSCALE, run);
        for (int i = 0; i < 4; ++i) run = cvt_matrix8(F, F.in(23) + (size_t)(l * 4 + i) * 512 * DM, 512, DM, (unsigned char*)(wl + WO_B) + (size_t)i * DM * 512, MapPlain{}, GATE_WSCALE, run);
        run = cvt_matrix8(F, F.in(26) + (size_t)l * DM * DM, DM, DM, (unsigned char*)(wl + WO_O), MapPlain{}, GATE_WSCALE, run);
        for (int e = 0; e < NEXP; ++e) {
            run = cvt_matrix8(F, F.in(29) + (size_t)(l * NEXP + e) * DM * DEXP, DM, DEXP, (unsigned char*)(wl + WO_13) + (size_t)e * 1024 * DM, MapW13{0}, GATE_WSCALE, run);
            run = cvt_matrix8(F, F.in(30) + (size_t)(l * NEXP + e) * DM * DEXP, DM, DEXP, (unsigned char*)(wl + WO_13) + (size_t)e * 1024 * DM, MapW13{1}, GATE_WSCALE, run);
            run = cvt_matrix8(F, F.in(31) + (size_t)(l * NEXP + e) * DEXP * DM, DEXP, DM, (unsigned char*)(wl + WO_2) + (size_t)e * DM * DEXP, MapPlain{}, GATE_WSCALE, run);
        }
    }
}

namespace pg8 {
__device__ __forceinline__ float fsigmoid(float x) { return __builtin_amdgcn_rcpf(1.0f + __builtin_amdgcn_exp2f(-1.4426950408889634f * x)); }
struct EpiGate {
    static constexpr bool PERM = false;
    const unsigned char* BV; const float* bg; bf16_t* ACC;
    __device__ __forceinline__ void operator()(const f32x4 (&acc)[2][2][4][2], const Unit& u, int wr, int wc, int fr, int fq) const {
        const int ch0 = u.pn * 64 + wc * 16 + fq * 4;
        f32x4 b[4];
#pragma unroll
        for (int i = 0; i < 4; ++i) b[i] = *(const f32x4*)(bg + i * DM + ch0);
        int vv[2][4][4];
#pragma unroll
        for (int ai = 0; ai < 2; ++ai)
#pragma unroll
            for (int m = 0; m < 4; ++m) { const unsigned char* bv = BV + (size_t)(u.pm * BM + ai * HALF + wr * 64 + m * 16 + fr) * 8192 + ch0;
#pragma unroll
                for (int i = 0; i < 4; ++i) vv[ai][m][i] = *(const int*)(bv + i * DM); }
#pragma unroll
        for (int ai = 0; ai < 2; ++ai) {
            const int (&v)[4][4] = vv[ai];
#pragma unroll
            for (int m = 0; m < 4; ++m) { const size_t row = (size_t)(u.pm * BM + ai * HALF + wr * 64 + m * 16 + fr);
                f32x4 tot = (f32x4){0.f, 0.f, 0.f, 0.f};
#pragma unroll
                for (int bj = 0; bj < 2; ++bj)
#pragma unroll
                    for (int n = 0; n < 2; ++n) { const int i = 2 * bj + n; const f32x4 a = acc[ai][bj][m][n] * (1.0f / GATE_WSCALE) + b[i];
                        tot.x += fsigmoid(a.x) * __builtin_amdgcn_cvt_f32_fp8(v[m][i], 0); tot.y += fsigmoid(a.y) * __builtin_amdgcn_cvt_f32_fp8(v[m][i], 1);
                        tot.z += fsigmoid(a.z) * __builtin_amdgcn_cvt_f32_fp8(v[m][i], 2); tot.w += fsigmoid(a.w) * __builtin_amdgcn_cvt_f32_fp8(v[m][i], 3); }
                const float os = ACC_SCALE / BV_SCALE;
                int o8 = 0; o8 = cvt8s(tot.x * os, tot.y * os, o8, false); o8 = cvt8s(tot.z * os, tot.w * os, o8, true);
                *(int*)((unsigned char*)ACC + row * DM + ch0) = o8; }
            asm volatile("" ::: "memory"); }
    }
};
struct SchedMoe {
    const unsigned* ecnt; const int* elist; const char* A; const char* W; int npn, G, c; size_t w_estride, w_pnstride, a_tstride; bool gather;
    unsigned* dq; int dstride, dbase;
    __device__ __forceinline__ bool next(int i, Unit& u) const { return at((long)i * G + c, u); }
    __device__ __forceinline__ bool at(const long L, Unit& u) const {
        int nt = 0;
        for (int e = 0; e < NEXP; ++e) nt += ((int)ecnt[e] + 255) >> 8;
        if (L >= (long)nt * npn) return false;
        const int ti = (int)(L / npn), pn = (int)(L % npn);
        int e = 0, tb = 0, cn = 0, run = 0;
        for (int q = 0; q < NEXP; ++q) { const int n = (int)ecnt[q], t = (n + 255) >> 8; if (ti >= run && ti < run + t) { e = q; tb = run; cn = n; } run += t; }
        u.pm = ti; u.pn = pn; u.A = gather ? A : A + (size_t)ti * a_tstride; u.B = W + (size_t)e * w_estride + (size_t)pn * w_pnstride;
        u.list = elist + (size_t)e * TT + (size_t)(ti - tb) * 256; u.nrows = min(256, cn - (ti - tb) * 256); u.aux = e; return true;
    }
};
__device__ __forceinline__ float fsilu(float x) { return x * fsigmoid(x); }
struct EpiSwiGLU {
    static constexpr bool PERM = true;
    unsigned char* HID;
    __device__ __forceinline__ void operator()(const f32x4 (&acc)[2][2][4][2], const Unit& u, int wr, int wc, int fr, int fq) const {
        const int col0 = u.pn * 128 + wc * 32 + 8 * fq; const float is = 1.0f / GATE_WSCALE;
#pragma unroll
        for (int ai = 0; ai < 2; ++ai)
#pragma unroll
            for (int m = 0; m < 4; ++m) { const size_t row = (size_t)(u.pm * BM + ai * HALF + wr * 64 + m * 16 + fr);
                const f32x4 a0 = acc[ai][0][m][0] * is, a1 = acc[ai][0][m][1] * is, c0 = acc[ai][1][m][0] * is, c1 = acc[ai][1][m][1] * is;
                int x = 0, y = 0;
                x = cvt8s(fsilu(a0.x) * c0.x, fsilu(a0.y) * c0.y, x, false); x = cvt8s(fsilu(a0.z) * c0.z, fsilu(a0.w) * c0.w, x, true);
                y = cvt8s(fsilu(a1.x) * c1.x, fsilu(a1.y) * c1.y, y, false); y = cvt8s(fsilu(a1.z) * c1.z, fsilu(a1.w) * c1.w, y, true);
                u32x2 w; w.x = (unsigned)x; w.y = (unsigned)y;
                *(u32x2*)(HID + row * DEXP + col0) = w; }
    }
};
struct EpiMoeDown {
    static constexpr bool PERM = true;
    unsigned char* Y;
    __device__ __forceinline__ void operator()(const f32x4 (&acc)[2][2][4][2], const Unit& u, int wr, int wc, int fr, int fq) const {
        const int col0 = u.pn * BM + wc * 32 + 8 * fq;
        const float* lw = (const float*)((const char*)u.list + (WS_ELW - WS_ELIST));
#pragma unroll
        for (int ai = 0; ai < 2; ++ai)
#pragma unroll
            for (int m = 0; m < 4; ++m) { const int r = ai * HALF + wr * 64 + m * 16 + fr;
                if (r < u.nrows) { const int en = u.list[r]; const float w = lw[r] * (Y_SCALE / GATE_WSCALE);
                    unsigned char* rowp = Y + (size_t)(en & 1) * TT * DM + (size_t)(en >> 1) * DM + col0;
#pragma unroll
                    for (int bj = 0; bj < 2; ++bj) { const f32x4 v0 = acc[ai][bj][m][0] * w, v1 = acc[ai][bj][m][1] * w;
                        int a = 0, b = 0; a = cvt8s(v0[0], v0[1], a, false); a = cvt8s(v0[2], v0[3], a, true); b = cvt8s(v1[0], v1[1], b, false); b = cvt8s(v1[2], v1[3], b, true);
                        u32x2 o; o.x = (unsigned)a; o.y = (unsigned)b; *(u32x2*)(rowp + bj * HALF) = o; } }
                asm volatile("" ::: "memory"); }
    }
};
}
__device__ __forceinline__ unsigned* dyn_q(Frame& F, int id, int xcd) { return (unsigned*)(F.ws + WS_CTL) + CW_Q + (id * 8 + xcd) * 32; }
#define DQ_PLAIN(id) dyn_q(F, (id), F.bid & 7), 8, F.bid & 7
#define DQ_FLAT(id) dyn_q(F, (id), 0), 1, 0
__device__ __forceinline__ void ph_fbranch(Frame& F, int l) {
    const int M = (l == 0) ? TT : TL;
    pg8::SchedPlain S{(const char*)(F.ws + WS_OUTS), (const char*)(F.ws + WS_W + (size_t)l * WL_STRIDE + WO_B), DM / 2, 256, M / 256, 32, F.G, F.bid, 8, 512, DQ_PLAIN(l * 8 + 2)};
    pg8::EpiFp8 E{F.ws + WS_BV, 8192, BV_SCALE / (OUT_SCALE * GATE_WSCALE)};
    pg8::gemm_phase<pg8::EpiFp8, pg8::SchedPlain, false, true, DYNQ>(F.lds, F.tid, DM / 2, 256, 256, S, E);
}
__device__ __forceinline__ void ph_fgate(Frame& F, int l) {
    const int M = (l == 0) ? TT : TL;
    pg8::SchedPlain S{(const char*)(F.ws + WS_H8), (const char*)(F.ws + WS_W + (size_t)l * WL_STRIDE + WO_G), DM / 2, DM / 2, M / 256, 32, F.G, F.bid, 1 << 30, 0, DQ_PLAIN(l * 8 + 3)};
    pg8::EpiGate E{F.ws + WS_BV, F.in(25) + (size_t)l * 4 * DM, (bf16_t*)(F.ws + WS_ACC)};
    pg8::gemm_phase<pg8::EpiGate, pg8::SchedPlain, false, true, DYNQ>(F.lds, F.tid, DM / 2, DM / 2, DM / 2, S, E);
}
__device__ __forceinline__ void ph_fmoe_up(Frame& F, int l) {
    pg8::SchedMoe S{(const unsigned*)(F.ws + WS_CTL) + CW_ECNT + l * 16, (const int*)(F.ws + WS_ELIST), (const char*)(F.ws + WS_H8), (const char*)(F.ws + WS_W + (size_t)l * WL_STRIDE + WO_13), 4, F.G, F.bid,
                    (size_t)1024 * DM, (size_t)256 * DM, 0, true, DQ_FLAT(l * 8 + 5)};
    pg8::EpiSwiGLU E{(unsigned char*)(F.ws + WS_HID)};
    pg8::gemm_phase<pg8::EpiSwiGLU, pg8::SchedMoe, true, true, DYNQ>(F.lds, F.tid, DM / 2, DM / 2, DM / 2, S, E);
}
__device__ __forceinline__ void ph_fmoe_down(Frame& F, int l) {
    pg8::SchedMoe S{(const unsigned*)(F.ws + WS_CTL) + CW_ECNT + l * 16, (const int*)(F.ws + WS_ELIST), (const char*)(F.ws + WS_HID), (const char*)(F.ws + WS_W + (size_t)l * WL_STRIDE + WO_2), 8, F.G, F.bid,
                    (size_t)DM * DEXP, (size_t)256 * DEXP, (size_t)256 * DEXP, false, DQ_FLAT(l * 8 + 6)};
    pg8::EpiMoeDown E{(unsigned char*)(F.ws + WS_PROJ)};
    pg8::gemm_phase<pg8::EpiMoeDown, pg8::SchedMoe, false, true, DYNQ>(F.lds, F.tid, DEXP / 2, DEXP / 2, DEXP / 2, S, E);
}

namespace fa {
using bf16x8 = __attribute__((ext_vector_type(8))) short;
using s16x4 = __attribute__((ext_vector_type(4))) short;
using f32x16 = __attribute__((ext_vector_type(16))) float;
constexpr int NW = 8, QBLK = 32, KVBLK = 64;
constexpr float THR = 8.f;
#define FA_SBAR() __builtin_amdgcn_sched_barrier(0)
__device__ __forceinline__ int crow(int r, int hi) { return (r & 3) + 8 * (r >> 2) + 4 * hi; }
__device__ __forceinline__ unsigned cvtpk(float lo, float hi) { unsigned r; asm volatile("v_cvt_pk_bf16_f32 %0, %1, %2" : "=v"(r) : "v"(lo), "v"(hi)); return r; }
template <int DQK> __device__ __forceinline__ int kswz(int row, int colB) { return row * (DQK * 2) + (colB ^ ((row & 7) << 4)); }
__device__ __forceinline__ int v_st(int k, int c) { const int kk = (k & ~0xC) | ((k & 4) << 1) | ((k & 8) >> 1); return ((kk >> 3) * 4 + (c >> 5)) * 512 + ((kk & 7) * 32 + (c & 31)) * 2; }
__device__ __forceinline__ int v_rd_base(int lane) { return ((lane & 3) << 3) | (((lane >> 2) & 3) << 6) | (((lane >> 4) & 1) << 5) | (((lane >> 5) & 1) << 8); }
constexpr int v_rd_off(int d0, int ks, int half) { return d0 * 512 + ks * 4096 + half * 2048; }
template <int OFF> __device__ __forceinline__ s16x4 tr_read(int vb) { s16x4 r; asm volatile("ds_read_b64_tr_b16 %0, %1 offset:%2" : "=&v"(r) : "v"(vb), "i"(OFF) : "memory"); return r; }
template <int D0> __device__ __forceinline__ void pv_one(f32x16& od, int vb, bf16x8 pa0, bf16x8 pa1, bf16x8 pa2, bf16x8 pa3) {
    const s16x4 l0 = tr_read<v_rd_off(D0, 0, 0)>(vb), h0 = tr_read<v_rd_off(D0, 0, 1)>(vb), l1 = tr_read<v_rd_off(D0, 1, 0)>(vb), h1 = tr_read<v_rd_off(D0, 1, 1)>(vb);
    const s16x4 l2 = tr_read<v_rd_off(D0, 2, 0)>(vb), h2 = tr_read<v_rd_off(D0, 2, 1)>(vb), l3 = tr_read<v_rd_off(D0, 3, 0)>(vb), h3 = tr_read<v_rd_off(D0, 3, 1)>(vb);
    asm volatile("s_waitcnt lgkmcnt(0)" ::: "memory"); FA_SBAR();
#define FA_PK(L, H) (bf16x8){L[0], L[1], L[2], L[3], H[0], H[1], H[2], H[3]}
    od = __builtin_amdgcn_mfma_f32_32x32x16_bf16(pa0, FA_PK(l0, h0), od, 0, 0, 0);
    od = __builtin_amdgcn_mfma_f32_32x32x16_bf16(pa1, FA_PK(l1, h1), od, 0, 0, 0);
    od = __builtin_amdgcn_mfma_f32_32x32x16_bf16(pa2, FA_PK(l2, h2), od, 0, 0, 0);
    od = __builtin_amdgcn_mfma_f32_32x32x16_bf16(pa3, FA_PK(l3, h3), od, 0, 0, 0);
#undef FA_PK
}
__device__ __forceinline__ void pv_d0(f32x16* o, int vb, bf16x8 pa0, bf16x8 pa1, bf16x8 pa2, bf16x8 pa3) {
    pv_one<0>(o[0], vb, pa0, pa1, pa2, pa3); pv_one<1>(o[1], vb, pa0, pa1, pa2, pa3); pv_one<2>(o[2], vb, pa0, pa1, pa2, pa3); pv_one<3>(o[3], vb, pa0, pa1, pa2, pa3);
}
__device__ __forceinline__ void partialSM(f32x16& p0, f32x16& p1, float& m_reg, float& mn, float& alpha, const float C, const float thr_raw) {
    float pmax = p0[0];
#pragma unroll
    for (int r = 1; r < 16; ++r) pmax = fmaxf(pmax, p0[r]);
#pragma unroll
    for (int r = 0; r < 16; ++r) pmax = fmaxf(pmax, p1[r]);
    { auto rr = __builtin_amdgcn_permlane32_swap(__float_as_uint(pmax), __float_as_uint(pmax), false, false); pmax = fmaxf(__uint_as_float(rr[0]), __uint_as_float(rr[1])); }
    if (__builtin_expect(__all(pmax - m_reg <= thr_raw), 1)) { mn = m_reg; alpha = 1.f; }
    else { mn = fmaxf(m_reg, pmax); alpha = __builtin_amdgcn_exp2f((m_reg - mn) * C); m_reg = mn; }
    const float mnC = -mn * C;
#pragma unroll
    for (int r = 0; r < 16; ++r) p0[r] = fmaf(p0[r], C, mnC);
#pragma unroll
    for (int r = 0; r < 16; ++r) p1[r] = fmaf(p1[r], C, mnC);
#pragma unroll
    for (int r = 0; r < 16; ++r) p0[r] = __builtin_amdgcn_exp2f(p0[r]);
}
__device__ __forceinline__ void finishSM(f32x16& p0, f32x16& p1, float alpha, float& l_reg, bf16x8& pa0, bf16x8& pa1, bf16x8& pa2, bf16x8& pa3) {
#pragma unroll
    for (int r = 0; r < 16; ++r) p1[r] = __builtin_amdgcn_exp2f(p1[r]);
    float ps = 0;
#pragma unroll
    for (int r = 0; r < 16; ++r) ps += p0[r];
#pragma unroll
    for (int r = 0; r < 16; ++r) ps += p1[r];
    { auto rr = __builtin_amdgcn_permlane32_swap(__float_as_uint(ps), __float_as_uint(ps), false, false); ps = __uint_as_float(rr[0]) + __uint_as_float(rr[1]); }
    l_reg = l_reg * alpha + ps;
#define FA_PK4(P, BASE, OUT) do { unsigned a0 = cvtpk(P[BASE + 0], P[BASE + 1]), a1 = cvtpk(P[BASE + 2], P[BASE + 3]);   \
    unsigned b0 = cvtpk(P[BASE + 4], P[BASE + 5]), b1 = cvtpk(P[BASE + 6], P[BASE + 7]);                              \
    auto r0 = __builtin_amdgcn_permlane32_swap(a0, b0, false, false); auto r1 = __builtin_amdgcn_permlane32_swap(a1, b1, false, false); \
    u32x4 w = {r0[0], r1[0], r0[1], r1[1]}; OUT = *reinterpret_cast<bf16x8*>(&w); } while (0)
    FA_PK4(p0, 0, pa0); FA_PK4(p0, 8, pa1); FA_PK4(p1, 0, pa2); FA_PK4(p1, 8, pa3);
#undef FA_PK4
}
template <int DQK> __device__ __forceinline__ void qkt(f32x16& p0, f32x16& p1, const char* Ks, const bf16x8* qr, const char* qx, int r32, int hi) {
    p0 = f32x16{}; p1 = f32x16{};
#pragma unroll
    for (int d0 = 0; d0 < DQK / 16; ++d0) { const int cb = (d0 * 16 + hi * 8) * 2;
        const bf16x8 b0 = *reinterpret_cast<const bf16x8*>(Ks + kswz<DQK>(r32, cb));
        const bf16x8 b1 = *reinterpret_cast<const bf16x8*>(Ks + kswz<DQK>(32 + r32, cb));
        const bf16x8 q = d0 < 8 ? qr[d0 < 8 ? d0 : 0] : *reinterpret_cast<const bf16x8*>(qx + (d0 - 8) * 1024);
        p0 = __builtin_amdgcn_mfma_f32_32x32x16_bf16(b0, q, p0, 0, 0, 0);
        p1 = __builtin_amdgcn_mfma_f32_32x32x16_bf16(b1, q, p1, 0, 0, 0);
        if (DQK == 192 && (d0 & 3) == 3) FA_SBAR(); }
}
struct Tiles {
    int nctx_t;
    int ctx_row0;
    int lat_row0;
    int NT;
    __device__ __forceinline__ int krow(int t) const { return t < nctx_t ? ctx_row0 + t * KVBLK : lat_row0 + (t - nctx_t) * KVBLK; }
};
constexpr float NEGM = -1e30f;
template <int MODE> __device__ __forceinline__ void mask_tile(f32x16& p0, f32x16& p1, int t, const Tiles& T, int q_a, int q_b, int k_a, int hi, const float* rpbL) {
    if (MODE == 0 || t < T.nctx_t) return;
    const int tl = t - T.nctx_t;
    if (MODE == 1) {
        const int kb = k_a + tl * KVBLK + 4 * hi - q_a;
#pragma unroll
        for (int r = 0; r < 16; ++r) { const int d0 = kb + (r & 3) + 8 * (r >> 2), d1 = d0 + 32;
            if (d0 > 128 || d0 < -128) p0[r] = NEGM; if (d1 > 128 || d1 < -128) p1[r] = NEGM; }
    } else {
        const int kr = k_a + tl;
        const int rs = min(max(q_a - 4, 0), 128 - 8), cs = min(max(q_b - 8, 0), 64 - 16);
        const bool rok = (kr >= rs) && (kr < rs + 8);
        const float* brow = rpbL + (kr - q_a + 7) * 31 + (15 - q_b);
#pragma unroll
        for (int r = 0; r < 16; ++r) { const int c0 = 4 * hi + (r & 3) + 8 * (r >> 2), c1 = c0 + 32;
            const bool ok0 = rok && c0 >= cs && c0 < cs + 16, ok1 = rok && c1 >= cs && c1 < cs + 16;
            p0[r] = ok0 ? p0[r] + brow[c0] : NEGM; p1[r] = ok1 ? p1[r] + brow[c1] : NEGM;
            if ((r & 3) == 3) asm volatile("" ::: "memory"); }
    }
}

template <int DQK, int SDEPTH, int MODE, int LDQ, int LDK, int LDV>
__device__ __forceinline__ void attn_unit(const bf16_t* __restrict__ Qb, const bf16_t* __restrict__ Kb, const bf16_t* __restrict__ Vb,
                                          bf16_t* __restrict__ Ob, const Tiles T, const float scale, const bool has_sink, const float sink,
                                          const int q_a0, const int k_a, const float* rpbL, char* lds, const int tid_in) {
    constexpr int LDO = DM;
    int tid = tid_in; asm volatile("" : "+v"(tid));
    constexpr int SHM_V = KVBLK * 128 * 2, SHM_K = KVBLK * DQK * 2;
    constexpr int KCH = DQK / 8 * KVBLK / 512;
    const int wid = tid >> 6, lane = tid & 63, r32 = lane & 31, hi = lane >> 5;
    char* V_lds = lds; char* K_lds = lds + 2 * SHM_V;
    float* ws = (float*)(lds + 2 * SHM_V + 2 * SHM_K) + wid * 64; float* li_l = ws; float* al_l = ws + 32;
    const float C = scale * 1.4426950408889634f, thr_raw = THR / scale;
    float m_reg = -1e30f, l_reg = 0; f32x16 o[4] = {}; bf16x8 qr[8];
    const bf16_t* Qw = Qb + (size_t)(wid * QBLK + r32) * LDQ + hi * 8;
#pragma unroll
    for (int d0 = 0; d0 < 8; ++d0) qr[d0] = *reinterpret_cast<const bf16x8*>(Qw + d0 * 16);
    char* qx = lds + 2 * SHM_V + 2 * SHM_K + NW * 256 + wid * 4096 + lane * 16;
    if constexpr (DQK == 192) {
#pragma unroll
        for (int d0 = 8; d0 < 12; ++d0) *(bf16x8*)(qx + (d0 - 8) * 1024) = *reinterpret_cast<const bf16x8*>(Qw + d0 * 16);
    }
    const int sr = tid >> 4, sc = (tid & 15) * 8, vst0 = v_st(sr, sc), vst1 = v_st(32 + sr, sc);
    int krw[KCH], kcb[KCH];
#pragma unroll
    for (int i = 0; i < KCH; ++i) { const int id = tid + 512 * i; krw[i] = id / (DQK / 8); kcb[i] = (id % (DQK / 8)) * 16; }
    const int vb0 = (int)(uintptr_t)V_lds + v_rd_base(lane);
    struct { bf16x8 vs0, vs1, ks[KCH]; } sr_[SDEPTH];
    const char* Vp = (const char*)(Vb + (size_t)sr * LDV + sc);
    const char* Kp[KCH];
#pragma unroll
    for (int c_ = 0; c_ < KCH; ++c_) Kp[c_] = (const char*)Kb + (size_t)krw[c_] * LDK * 2 + kcb[c_];
#define FA_SLOAD(i, t) do { const size_t kr_ = (size_t)T.krow(t); sr_[i].vs0 = *reinterpret_cast<const bf16x8*>(Vp + kr_ * (LDV * 2)); sr_[i].vs1 = *reinterpret_cast<const bf16x8*>(Vp + (kr_ + 32) * (LDV * 2)); \
    _Pragma("unroll") for (int c_ = 0; c_ < KCH; ++c_) sr_[i].ks[c_] = *reinterpret_cast<const bf16x8*>(Kp[c_] + kr_ * (LDK * 2)); } while (0)
#define FA_SWRITE(b, i) do { *(bf16x8*)(V_lds + (b) * SHM_V + vst0) = sr_[i].vs0; *(bf16x8*)(V_lds + (b) * SHM_V + vst1) = sr_[i].vs1; \
    _Pragma("unroll") for (int c_ = 0; c_ < KCH; ++c_) *(bf16x8*)(K_lds + (b) * SHM_K + kswz<DQK>(krw[c_], kcb[c_])) = sr_[i].ks[c_]; } while (0)
#define FA_SWAIT() do { if constexpr (SDEPTH == 2) { if constexpr (KCH == 2) asm volatile("s_waitcnt vmcnt(4)" ::: "memory"); else asm volatile("s_waitcnt vmcnt(5)" ::: "memory"); } else asm volatile("s_waitcnt vmcnt(0)" ::: "memory"); } while (0)
#define FA_RESC(a) do { if (__any((a) < 1.f)) { if (hi == 0) al_l[r32] = (a); asm volatile("s_waitcnt lgkmcnt(0)" ::: "memory"); \
    _Pragma("unroll") for (int d = 0; d < 4; ++d) _Pragma("unroll") for (int r = 0; r < 16; ++r) o[d][r] *= al_l[crow(r, hi)]; } } while (0)
    const int q_a = (MODE == 1) ? q_a0 + wid * QBLK + r32 : q_a0 + ((wid * QBLK + r32) >> 6), q_b = (wid * QBLK + r32) & 63;
#define FA_MASK(P0, P1, t) mask_tile<MODE>(P0, P1, t, T, q_a, q_b, k_a, hi, rpbL)
    f32x16 pA0, pA1, pB0, pB1; float mnA, mnB, alA, alB; bf16x8 pa0, pa1, pa2, pa3; const int NT = T.NT;
    constexpr int SE = 0, SO = SDEPTH - 1;
    FA_SLOAD(SE, 0); asm volatile("s_waitcnt vmcnt(0)" ::: "memory"); FA_SWRITE(0, SE); __syncthreads();
    qkt<DQK>(pA0, pA1, K_lds, qr, qx, r32, hi); FA_MASK(pA0, pA1, 0); partialSM(pA0, pA1, m_reg, mnA, alA, C, thr_raw);
    FA_SLOAD(SO, 1); if constexpr (SDEPTH == 2) { if (2 < NT) FA_SLOAD(SE, 2); }
    FA_SWAIT(); FA_SWRITE(1, SO); __syncthreads();
    for (int j = 1; j + 1 < NT; j += 2) {
        FA_SBAR(); qkt<DQK>(pB0, pB1, K_lds + SHM_K, qr, qx, r32, hi); FA_MASK(pB0, pB1, j);
        finishSM(pA0, pA1, alA, l_reg, pa0, pa1, pa2, pa3); FA_SBAR();
        FA_SLOAD(SO, j + SDEPTH); FA_SBAR();
        pv_d0(o, vb0, pa0, pa1, pa2, pa3); partialSM(pB0, pB1, m_reg, mnB, alB, C, thr_raw);
        __syncthreads(); FA_SWAIT(); FA_SWRITE(0, SE);
        FA_RESC(alB); __syncthreads();
        FA_SBAR(); qkt<DQK>(pA0, pA1, K_lds, qr, qx, r32, hi); FA_MASK(pA0, pA1, j + 1);
        finishSM(pB0, pB1, alB, l_reg, pa0, pa1, pa2, pa3); FA_SBAR();
        if (SDEPTH == 1 || j + 3 < NT) FA_SLOAD(SE, j + 1 + SDEPTH); FA_SBAR();
        pv_d0(o, vb0 + SHM_V, pa0, pa1, pa2, pa3); partialSM(pA0, pA1, m_reg, mnA, alA, C, thr_raw);
        __syncthreads(); FA_SWAIT(); FA_SWRITE(1, SO);
        FA_RESC(alA); __syncthreads();
    }
    FA_SBAR(); qkt<DQK>(pB0, pB1, K_lds + SHM_K, qr, qx, r32, hi); FA_MASK(pB0, pB1, NT - 1);
    finishSM(pA0, pA1, alA, l_reg, pa0, pa1, pa2, pa3); FA_SBAR();
    pv_d0(o, vb0, pa0, pa1, pa2, pa3); partialSM(pB0, pB1, m_reg, mnB, alB, C, thr_raw);
    __syncthreads(); FA_RESC(alB);
    finishSM(pB0, pB1, alB, l_reg, pa0, pa1, pa2, pa3); FA_SBAR();
    pv_d0(o, vb0 + SHM_V, pa0, pa1, pa2, pa3);
    if (has_sink) l_reg += __builtin_amdgcn_exp2f(sink * 1.4426950408889634f - m_reg * C);
    if (hi == 0) li_l[r32] = l_reg; asm volatile("s_waitcnt lgkmcnt(0)" ::: "memory");
    float rli[16];
#pragma unroll
    for (int r = 0; r < 16; ++r) rli[r] = __builtin_amdgcn_rcpf(li_l[crow(r, hi)]);
    __syncthreads();
    int tid2 = tid_in; asm volatile("" : "+v"(tid2));
    const int lane2 = tid2 & 63, wid2 = tid2 >> 6;
    bf16_t* stg = (bf16_t*)(lds + wid2 * (32 * 272));
#pragma unroll
    for (int r = 0; r < 16; ++r) { const int orow = crow(r, hi);
#pragma unroll
        for (int d0 = 0; d0 < 4; ++d0) stg[orow * 136 + d0 * 32 + r32] = (bf16_t)f2bf(o[d0][r] * rli[r]); }
    asm volatile("s_waitcnt lgkmcnt(0)" ::: "memory");
    bf16_t* Ow = Ob + (size_t)(wid2 * QBLK) * LDO;
#pragma unroll
    for (int i = 0; i < 8; ++i) { const int row = i * 4 + (lane2 >> 4), ch = lane2 & 15; const u32x4 v = *(const u32x4*)(stg + row * 136 + ch * 8); *(u32x4*)(Ow + (size_t)row * LDO + ch * 8) = v; }
    __syncthreads();
#undef FA_SLOAD
#undef FA_SWRITE
#undef FA_SWAIT
#undef FA_RESC
#undef FA_MASK
}

template <int LDQ, int LDK, int LDV>
__device__ __forceinline__ void attn_unit_sp192(const bf16_t* __restrict__ Qb, const bf16_t* __restrict__ Kb, const bf16_t* __restrict__ Vb, bf16_t* __restrict__ Ob, const Tiles T, const float scale, char* lds, const int tid_in) {
    constexpr int DQK = 192, LDO = DM, SHM_V = KVBLK * 128 * 2, SHM_K = KVBLK * DQK * 2, KCH = 3;
    int tid = tid_in; asm volatile("" : "+v"(tid));
    const int wid = tid >> 6, lane = tid & 63, r32 = lane & 31, hi = lane >> 5;
    char* V_lds = lds; char* K_lds = lds + 2 * SHM_V;
    float* ws = (float*)(lds + 2 * SHM_V + 2 * SHM_K) + wid * 64; float* li_l = ws; float* al_l = ws + 32;
    const float C = scale * 1.4426950408889634f, thr_raw = THR / scale;
    float m_reg = -1e30f, l_reg = 0; f32x16 o[4] = {}; bf16x8 qr[12];
    const bf16_t* Qw = Qb + (size_t)(wid * QBLK + r32) * LDQ + hi * 8;
#pragma unroll
    for (int d0 = 0; d0 < 12; ++d0) qr[d0] = *reinterpret_cast<const bf16x8*>(Qw + d0 * 16);
    const int sr = tid >> 4, sc = (tid & 15) * 8, vst0 = v_st(sr, sc), vst1 = v_st(32 + sr, sc);
    int krw[KCH], kcb[KCH];
#pragma unroll
    for (int i = 0; i < KCH; ++i) { const int id = tid + 512 * i; krw[i] = id / 24; kcb[i] = (id % 24) * 16; }
    const int vb0 = (int)(uintptr_t)V_lds + v_rd_base(lane);
    const char* Vp = (const char*)(Vb + (size_t)sr * LDV + sc);
    const char* Kp[KCH];
#pragma unroll
    for (int c_ = 0; c_ < KCH; ++c_) Kp[c_] = (const char*)Kb + (size_t)krw[c_] * LDK * 2 + kcb[c_];
    bf16x8 vs0, vs1, ks[KCH];
#define FB_SLOAD(t) do { const size_t kr_ = (size_t)T.krow(t); vs0 = *reinterpret_cast<const bf16x8*>(Vp + kr_ * (LDV * 2)); vs1 = *reinterpret_cast<const bf16x8*>(Vp + (kr_ + 32) * (LDV * 2)); \
    _Pragma("unroll") for (int c_ = 0; c_ < KCH; ++c_) ks[c_] = *reinterpret_cast<const bf16x8*>(Kp[c_] + kr_ * (LDK * 2)); } while (0)
#define FB_SWRITE(b) do { *(bf16x8*)(V_lds + (b) * SHM_V + vst0) = vs0; *(bf16x8*)(V_lds + (b) * SHM_V + vst1) = vs1; \
    _Pragma("unroll") for (int c_ = 0; c_ < KCH; ++c_) *(bf16x8*)(K_lds + (b) * SHM_K + kswz<DQK>(krw[c_], kcb[c_])) = ks[c_]; } while (0)
    const int NT = T.NT;
    FB_SLOAD(0); asm volatile("s_waitcnt vmcnt(0)" ::: "memory"); FB_SWRITE(0); __syncthreads();
    for (int j = 0; j < NT; ++j) {
        const int b = j & 1;
        if (j + 1 < NT) FB_SLOAD(j + 1);
        __builtin_amdgcn_sched_barrier(0);
        f32x16 p0 = f32x16{}, p1 = f32x16{};
        { const char* Ks = K_lds + b * SHM_K;
#pragma unroll
          for (int d0 = 0; d0 < 12; ++d0) { const int cb = (d0 * 16 + hi * 8) * 2;
              const bf16x8 b0 = *reinterpret_cast<const bf16x8*>(Ks + kswz<DQK>(r32, cb));
              const bf16x8 b1 = *reinterpret_cast<const bf16x8*>(Ks + kswz<DQK>(32 + r32, cb));
              p0 = __builtin_amdgcn_mfma_f32_32x32x16_bf16(b0, qr[d0], p0, 0, 0, 0);
              p1 = __builtin_amdgcn_mfma_f32_32x32x16_bf16(b1, qr[d0], p1, 0, 0, 0); } }
        float mn, al; bf16x8 pa0, pa1, pa2, pa3;
        partialSM(p0, p1, m_reg, mn, al, C, thr_raw);
        if (__any(al < 1.f)) { if (hi == 0) al_l[r32] = al; asm volatile("s_waitcnt lgkmcnt(0)" ::: "memory");
#pragma unroll
            for (int d = 0; d < 4; ++d)
#pragma unroll
                for (int r = 0; r < 16; ++r) o[d][r] *= al_l[crow(r, hi)]; }
        finishSM(p0, p1, al, l_reg, pa0, pa1, pa2, pa3);
        __builtin_amdgcn_sched_barrier(0);
        pv_d0(o, vb0 + b * SHM_V, pa0, pa1, pa2, pa3);
        if (j + 1 < NT) { asm volatile("s_waitcnt vmcnt(0)" ::: "memory"); FB_SWRITE(b ^ 1); }
        __syncthreads();
    }
    if (hi == 0) li_l[r32] = l_reg; asm volatile("s_waitcnt lgkmcnt(0)" ::: "memory");
    float rli[16];
#pragma unroll
    for (int r = 0; r < 16; ++r) rli[r] = __builtin_amdgcn_rcpf(li_l[crow(r, hi)]);
    __syncthreads();
    int tid2 = tid_in; asm volatile("" : "+v"(tid2));
    const int lane2 = tid2 & 63, wid2 = tid2 >> 6;
    bf16_t* stg = (bf16_t*)(lds + wid2 * (32 * 272));
#pragma unroll
    for (int r = 0; r < 16; ++r) { const int orow = crow(r, hi);
#pragma unroll
        for (int d0 = 0; d0 < 4; ++d0) stg[orow * 136 + d0 * 32 + r32] = (bf16_t)f2bf(o[d0][r] * rli[r]); }
    asm volatile("s_waitcnt lgkmcnt(0)" ::: "memory");
    bf16_t* Ow = Ob + (size_t)(wid2 * QBLK) * LDO;
#pragma unroll
    for (int i = 0; i < 8; ++i) { const int row = i * 4 + (lane2 >> 4), ch = lane2 & 15; const u32x4 v = *(const u32x4*)(stg + row * 136 + ch * 8); *(u32x4*)(Ow + (size_t)row * LDO + ch * 8) = v; }
    __syncthreads();
#undef FB_SLOAD
#undef FB_SWRITE
}
#undef FA_SBAR
}

namespace fa8 {
typedef int v8i_t __attribute__((ext_vector_type(8)));
typedef int v4i_t __attribute__((ext_vector_type(4)));
using fa::f32x16; using fa::crow;
constexpr int VP = 80;
constexpr float THR8 = 3.f, POFF = 4.f;
struct Tiles8 {
    int nctx_t, ctx_row0, lat_row0, NT, vk_lat0;
    __device__ __forceinline__ int krow(int t) const { return t < nctx_t ? ctx_row0 + t * 64 : lat_row0 + (t - nctx_t) * 64; }
    __device__ __forceinline__ int vkey(int t) const { return t < nctx_t ? t * 64 : vk_lat0 + (t - nctx_t) * 64; }
};
#define FA8_SBAR() __builtin_amdgcn_sched_barrier(0)
#define FA8_MFMA(a, b, c) __builtin_amdgcn_mfma_scale_f32_32x32x64_f8f6f4(a, b, c, 0, 0, 0, 0, 0, 0)
#define FA8_LD32(p) __builtin_shufflevector(*(const v4i_t*)(p), *(const v4i_t*)((p) + 16), 0, 1, 2, 3, 4, 5, 6, 7)
#define FA8_MX3(a, b, c) __builtin_fmaxf(__builtin_fmaxf((a), (b)), (c))
typedef short v2s_t __attribute__((ext_vector_type(2)));
template <bool FIRST>
__device__ __forceinline__ void partialSM8(f32x16& p0, f32x16& p1, float& m_reg, float& alpha, float& scl, const float thr2) {
    float pa_ = FA8_MX3(p0[0], p0[1], p1[0]), pb_ = FA8_MX3(p0[2], p0[3], p1[1]); pa_ = FA8_MX3(pa_, p1[2], p1[3]);
#pragma unroll
    for (int r = 4; r < 16; r += 4) { pa_ = FA8_MX3(pa_, p0[r], p0[r + 1]); pb_ = FA8_MX3(pb_, p0[r + 2], p0[r + 3]); pa_ = FA8_MX3(pa_, p1[r], p1[r + 1]); pb_ = FA8_MX3(pb_, p1[r + 2], p1[r + 3]); }
    float pmax = __builtin_fmaxf(pa_, pb_);
    { auto rr = __builtin_amdgcn_permlane32_swap(__float_as_uint(pmax), __float_as_uint(pmax), false, false); pmax = fmaxf(__uint_as_float(rr[0]), __uint_as_float(rr[1])); }
    if (!FIRST && __builtin_expect(__all(pmax - m_reg <= thr2), 1)) { alpha = 1.f; }
    else {
        const float mn = (FIRST || pmax - m_reg > thr2) ? __builtin_ceilf(pmax) : m_reg;
        alpha = FIRST ? 0.f : __builtin_ldexpf(1.0f, (int)(m_reg - mn));
        m_reg = mn;
        scl = __builtin_ldexpf(1.0f, SCL_DIV ? (int)(mn - POFF) : (int)(POFF - mn));
    }
#if VALU_PROBE
#pragma unroll
    for (int r = 0; r < 16; ++r) { asm volatile("v_mul_f32 %0, 1.0, %0" : "+v"(p0[r])); asm volatile("v_mul_f32 %0, 1.0, %0" : "+v"(p1[r])); }
#endif
#pragma unroll
    for (int r = 0; r < 16; ++r) p0[r] = __builtin_amdgcn_exp2f(p0[r]);
}
__device__ __forceinline__ void finishSM8(f32x16& p0, f32x16& p1, float& l_reg, v8i_t& pa, const float scl) {
#pragma unroll
    for (int r = 0; r < 16; ++r) p1[r] = __builtin_amdgcn_exp2f(p1[r]);
    float ps = 0;
#pragma unroll
    for (int r = 0; r < 16; ++r) ps += p0[r];
#pragma unroll
    for (int r = 0; r < 16; ++r) ps += p1[r];
    { auto rr = __builtin_amdgcn_permlane32_swap(__float_as_uint(ps), __float_as_uint(ps), false, false); ps = __uint_as_float(rr[0]) + __uint_as_float(rr[1]); }
    l_reg += ps;
#pragma unroll
    for (int k = 0; k < 4; ++k) { v2s_t w = __builtin_bit_cast(v2s_t, p0[4 * k]);
        w = __builtin_amdgcn_cvt_scalef32_pk_fp8_f32(w, p0[4 * k], p0[4 * k + 1], scl, false); w = __builtin_amdgcn_cvt_scalef32_pk_fp8_f32(w, p0[4 * k + 2], p0[4 * k + 3], scl, true); pa[k] = __builtin_bit_cast(int, w); }
#pragma unroll
    for (int k = 0; k < 4; ++k) { v2s_t w = __builtin_bit_cast(v2s_t, p1[4 * k]);
        w = __builtin_amdgcn_cvt_scalef32_pk_fp8_f32(w, p1[4 * k], p1[4 * k + 1], scl, false); w = __builtin_amdgcn_cvt_scalef32_pk_fp8_f32(w, p1[4 * k + 2], p1[4 * k + 3], scl, true); pa[4 + k] = __builtin_bit_cast(int, w); }
}
template <int DQK> __device__ __forceinline__ void qkt8(f32x16& p0, f32x16& p1, const char* Ks, const v8i_t* qf, int r32, int hi) {
    constexpr int KP = DQK + 16;
    p0 = f32x16{}; p1 = f32x16{};
#pragma unroll
    for (int c = 0; c < DQK / 64; ++c) {
        const v8i_t a0 = FA8_LD32(Ks + r32 * KP + c * 64 + hi * 32);
        const v8i_t a1 = FA8_LD32(Ks + (32 + r32) * KP + c * 64 + hi * 32);
        p0 = FA8_MFMA(a0, qf[c], p0);
        p1 = FA8_MFMA(a1, qf[c], p1); }
}
__device__ __forceinline__ void pv8(f32x16* o, const char* Vs, const v8i_t pa, int r32, int hi) {
#pragma unroll
    for (int n = 0; n < 4; ++n) { const v8i_t b = FA8_LD32(Vs + (32 * n + r32) * VP + hi * 32); o[n] = FA8_MFMA(pa, b, o[n]); }
}

template <int DQK, int SDEPTH, int MODE>
__device__ __forceinline__ void attn_unit8(const unsigned char* __restrict__ Qb, const unsigned char* __restrict__ Kb, const unsigned char* __restrict__ Vt, bf16_t* __restrict__ Ob,
                                           const Tiles8 T, const float scale, const bool has_sink, const float sink, const int q_a0, const int k_a, const float* rpbL, char* lds, const int tid_in) {
    constexpr int LDO = DM, KP = DQK + 16, SHM_K = 64 * KP, SHM_V = 128 * VP;
    int tid = tid_in; asm volatile("" : "+v"(tid));
    const int wid = tid >> 6, lane = tid & 63, r32 = lane & 31, hi = lane >> 5;
    char* K_lds = lds; char* V_lds = lds + 3 * SHM_K;
    float* ws = (float*)(lds + 3 * SHM_K + 3 * SHM_V) + wid * 64; float* li_l = ws; float* al_l = ws + 32;
    const float thr2 = THR8 * 1.4426950408889634f;
    float m_reg = 0.f, l_reg = 0, scl = 1.f; f32x16 o[4] = {}; v8i_t qf[DQK / 64];
    { const unsigned char* Qw = Qb + (size_t)(wid * 32 + r32) * Q8P + hi * 32;
#pragma unroll
      for (int c = 0; c < DQK / 64; ++c) qf[c] = FA8_LD32(Qw + c * 64); }
    constexpr int PS = (DQK == 128) ? 16 : 8, PPR = DQK / PS, KCH = 64 * PPR / 512;
    typedef unsigned kpiece_t __attribute__((ext_vector_type(PS / 4)));
    const int krow_ = (tid * KCH) / PPR, kpc_ = (tid * KCH) % PPR; const int kdst0 = krow_ * KP + kpc_ * PS; const unsigned char* Kp0 = Kb + (size_t)krow_ * K8P + kpc_ * PS;
    const int vdst = (tid >> 2) * VP + (tid & 3) * 16; const unsigned char* Vp = Vt + (size_t)(tid >> 2) * VTP + (tid & 3) * 16;
    struct { kpiece_t ks[KCH]; u32x4 vs; } sr_[SDEPTH];
#define FA8_SLOAD(i, t) do { const size_t kr_ = (size_t)T.krow(t); const int vk_ = T.vkey(t); sr_[i].vs = *(const u32x4*)(Vp + vk_); \
    _Pragma("unroll") for (int c_ = 0; c_ < KCH; ++c_) sr_[i].ks[c_] = *(const kpiece_t*)(Kp0 + kr_ * K8P + c_ * PS); } while (0)
#define FA8_SWRITE(b, i) do { *(u32x4*)(V_lds + (b) * SHM_V + vdst) = sr_[i].vs; \
    _Pragma("unroll") for (int c_ = 0; c_ < KCH; ++c_) *(kpiece_t*)(K_lds + (b) * SHM_K + kdst0 + c_ * PS) = sr_[i].ks[c_]; } while (0)
#define FA8_SWAIT() do { if constexpr (KCH == 1) asm volatile("s_waitcnt vmcnt(2)" ::: "memory"); else asm volatile("s_waitcnt vmcnt(4)" ::: "memory"); } while (0)
#define FA8_RESC(a) do { if (__any((a) < 1.f)) { if (hi == 0) al_l[r32] = (a); asm volatile("s_waitcnt lgkmcnt(0)" ::: "memory"); \
    _Pragma("unroll") for (int d = 0; d < 4; ++d) _Pragma("unroll") for (int r = 0; r < 16; ++r) o[d][r] *= al_l[crow(r, hi)]; } } while (0)
    const int q_a = (MODE == 1) ? q_a0 + wid * 32 + r32 : q_a0 + ((wid * 32 + r32) >> 6), q_b = (wid * 32 + r32) & 63;
    const fa::Tiles TM{T.nctx_t, 0, 0, T.NT};
#define FA8_MASK(P0, P1, t) fa::mask_tile<MODE>(P0, P1, t, TM, q_a, q_b, k_a, hi, rpbL)
    f32x16 pA0, pA1, pB0, pB1; float alA, alB; v8i_t pa; const int NT = T.NT;
    constexpr int SE = 0, SO = SDEPTH - 1;
    static_assert(SDEPTH == 2, "the three-slot ring is written for two-deep register staging");
    FA8_SLOAD(SE, 0); FA8_SLOAD(SO, 1); FA8_SWAIT(); FA8_SWRITE(0, SE); __syncthreads();
    qkt8<DQK>(pA0, pA1, K_lds, qf, r32, hi); FA8_MASK(pA0, pA1, 0); partialSM8<true>(pA0, pA1, m_reg, alA, scl, thr2);
    if (2 < NT) { FA8_SLOAD(SE, 2); FA8_SWAIT(); } else asm volatile("s_waitcnt vmcnt(0)" ::: "memory");
    FA8_SWRITE(1, SO); __syncthreads();
    int s_m = 0, s_c = 1, s_p = 2;
    for (int j = 1; j + 1 < NT; j += 2) {
        FA8_SBAR(); qkt8<DQK>(pB0, pB1, K_lds + s_c * SHM_K, qf, r32, hi); FA8_MASK(pB0, pB1, j);
        finishSM8(pA0, pA1, l_reg, pa, scl); FA8_SBAR();
        FA8_SLOAD(SO, j + 2); FA8_SBAR();
        pv8(o, V_lds + s_m * SHM_V, pa, r32, hi); partialSM8<false>(pB0, pB1, m_reg, alB, scl, thr2);
        FA8_SWAIT(); FA8_SWRITE(s_p, SE);
        FA8_RESC(alB); __syncthreads();
        FA8_SBAR(); qkt8<DQK>(pA0, pA1, K_lds + s_p * SHM_K, qf, r32, hi); FA8_MASK(pA0, pA1, j + 1);
        finishSM8(pB0, pB1, l_reg, pa, scl); FA8_SBAR();
        if (j + 3 < NT) FA8_SLOAD(SE, j + 3); FA8_SBAR();
        pv8(o, V_lds + s_c * SHM_V, pa, r32, hi); partialSM8<false>(pA0, pA1, m_reg, alA, scl, thr2);
        FA8_SWAIT(); FA8_SWRITE(s_m, SO);
        FA8_RESC(alA); __syncthreads();
        { const int t0 = s_m; s_m = s_p; s_p = s_c; s_c = t0; }
    }
    FA8_SBAR(); qkt8<DQK>(pB0, pB1, K_lds + s_c * SHM_K, qf, r32, hi); FA8_MASK(pB0, pB1, NT - 1);
    finishSM8(pA0, pA1, l_reg, pa, scl); FA8_SBAR();
    pv8(o, V_lds + s_m * SHM_V, pa, r32, hi); partialSM8<false>(pB0, pB1, m_reg, alB, scl, thr2);
    FA8_RESC(alB);
    finishSM8(pB0, pB1, l_reg, pa, scl); FA8_SBAR();
    pv8(o, V_lds + s_c * SHM_V, pa, r32, hi);
    if (has_sink) l_reg += __builtin_amdgcn_exp2f(sink * 1.4426950408889634f);
    l_reg = SCL_DIV ? l_reg * __builtin_amdgcn_rcpf(scl) : l_reg * scl;
    if (hi == 0) li_l[r32] = l_reg; asm volatile("s_waitcnt lgkmcnt(0)" ::: "memory");
    float rli[16];
#pragma unroll
    for (int r = 0; r < 16; ++r) rli[r] = __builtin_amdgcn_rcpf(li_l[crow(r, hi)]);
    __syncthreads();
    int tid2 = tid_in; asm volatile("" : "+v"(tid2));
    const int lane2 = tid2 & 63, wid2 = tid2 >> 6;
    unsigned char* stg = (unsigned char*)(lds + wid2 * (32 * 144));
#pragma unroll
    for (int r = 0; r < 16; ++r) { const int orow = crow(r, hi); const float sc_ = rli[r] * OUT_SCALE;
#pragma unroll
        for (int d0 = 0; d0 < 4; d0 += 2) { int w = 0; w = cvt8s(o[d0][r] * sc_, o[d0 + 1][r] * sc_, w, false);
            stg[orow * 144 + d0 * 32 + r32] = (unsigned char)w; stg[orow * 144 + (d0 + 1) * 32 + r32] = (unsigned char)(w >> 8); } }
    asm volatile("s_waitcnt lgkmcnt(0)" ::: "memory");
    unsigned char* Ow = (unsigned char*)Ob + (size_t)(wid2 * 32) * LDO;
#pragma unroll
    for (int i = 0; i < 4; ++i) { const int row = i * 8 + (lane2 >> 3), ch = lane2 & 7; const u32x4 v = *(const u32x4*)(stg + row * 144 + ch * 16); *(u32x4*)(Ow + (size_t)row * LDO + ch * 16) = v; }
    __syncthreads();
#undef FA8_SLOAD
#undef FA8_SWRITE
#undef FA8_SWAIT
#undef FA8_RESC
#undef FA8_MASK
}
#undef FA8_SBAR
}

#define XCDU(u) ((((u) & 7) << 5) | (((u) >> 3) & 31))
__device__ __forceinline__ void ph_fattn8(Frame& F, int l) {
    unsigned char* OUTS = F.ws + WS_OUTS;
    const unsigned char* Q8 = F.ws + WS_Q8; const unsigned char* K8 = F.ws + WS_K8; const unsigned char* V8T = F.ws + WS_V8T;
    char* lds = (char*)(unsigned char*)F.lds;
    float* rpbL = (float*)(lds + 120 * 1024);
    {
        const float* rpb = F.in(22) + (size_t)l * 4 * 15 * 31;
        for (int i = F.tid; i < 4 * 15 * 31; i += NTHREADS) rpbL[i] = rpb[i] * 1.4426950408889634f;
        __syncthreads();
    }
    const float sc128 = 0.08838834764831845f, sc192 = 0.07216878364870323f;
    const int nctxu = (l == 0) ? 8 : 0;
    if (FA_SEL & 1) for (int u = F.bid; u < 256 + nctxu; u += F.G) {
        launder(F);
        const bool cq = u >= 256; const int v = cq ? u - 256 : XCDU(u), b = cq ? (v >> 2) : (v >> 7), h = cq ? (v & 3) : ((v >> 5) & 3), r0 = cq ? TL + b * NCTX : b * SEQ + (v & 31) * 256;
        fa8::Tiles8 T{4, TL + b * NCTX, b * SEQ, cq ? 4 : 132, 256};
        fa8::attn_unit8<192, 2, 0>(Q8 + (size_t)r0 * Q8P + Q8_M + h * 192, K8 + K8_M + h * 192, V8T + (size_t)((8 + h) * 2 + b) * 128 * VTP, (bf16_t*)(OUTS + (size_t)r0 * DM + 512 + h * 128), T, sc192,
                                   false, 0.f, 0, 0, nullptr, lds, F.tid);
    }
    if (FA_SEL & 2) for (int u = F.bid; u < 256 + 3 * nctxu; u += F.G) {
        launder(F);
        const bool cq = u >= 256; const int v = cq ? u - 256 : XCDU(u);
        const int mx = cq ? ((v >> 3) == 0 ? 0 : (v >> 3) + 1) : 0, b = cq ? ((v >> 2) & 1) : (v >> 7), h = cq ? (v & 3) : ((v >> 5) & 3), r0 = cq ? TL + b * NCTX : b * SEQ + (v & 31) * 256;
        const int qo = mx == 0 ? Q8_A : (mx == 2 ? Q8_W : Q8_N), ko = mx == 0 ? K8_A : (mx == 2 ? K8_W : K8_N), kvh = (mx == 3) ? h : (h >> 1), hidx = (mx == 0 ? 0 : (mx == 2 ? 2 : 4)) + kvh;
        fa8::Tiles8 T{4, TL + b * NCTX, b * SEQ, cq ? 4 : 132, 256};
        fa8::attn_unit8<128, 2, 0>(Q8 + (size_t)r0 * Q8P + qo + h * 128, K8 + ko + kvh * 128, V8T + (size_t)(hidx * 2 + b) * 128 * VTP, (bf16_t*)(OUTS + (size_t)r0 * DM + mx * 512 + h * 128), T, sc128,
                                   mx == 2, F.in(21)[l * 4 + h], 0, 0, nullptr, lds, F.tid);
    }
    if (FA_SEL & 4) for (int u = F.bid; u < 256; u += F.G) {
        launder(F);
        const int uu = XCDU(u), b = uu >> 7, h = (uu >> 5) & 3, qb = uu & 31, r0 = b * SEQ + qb * 256;
        const int q0 = qb * 256, k0 = max(q0 - 128, 0), k1 = min(q0 + 384, SEQ);
        fa8::Tiles8 T{4, TL + b * NCTX, b * SEQ + k0, 4 + (k1 - k0) / 64, 256 + k0};
        fa8::attn_unit8<128, 2, 1>(Q8 + (size_t)r0 * Q8P + Q8_W + h * 128, K8 + K8_W + (h >> 1) * 128, V8T + (size_t)((2 + (h >> 1)) * 2 + b) * 128 * VTP, (bf16_t*)(OUTS + (size_t)r0 * DM + 2 * 512 + h * 128), T, sc128,
                                   true, F.in(21)[l * 4 + h], q0, k0, nullptr, lds, F.tid);
    }
    if (FA_SEL & 8) for (int u = F.bid; u < 256; u += F.G) {
        launder(F);
        const int uu = XCDU(u), b = uu >> 7, h = (uu >> 5) & 3, qb = uu & 31, r0 = b * SEQ + qb * 256;
        const int g0 = qb * 4, ks = min(max(g0 - 4, 0), 120), ke = min(max(g0 + 3 - 4, 0), 120) + 8;
        int nt = ke - ks; nt += (nt & 1);
        const int ks2 = (ks + nt > 128) ? 128 - nt : ks;
        fa8::Tiles8 T{4, TL + b * NCTX, b * SEQ + ks2 * 64, 4 + nt, 256 + ks2 * 64};
        fa8::attn_unit8<128, 2, 2>(Q8 + (size_t)r0 * Q8P + Q8_N + h * 128, K8 + K8_N + h * 128, V8T + (size_t)((4 + h) * 2 + b) * 128 * VTP, (bf16_t*)(OUTS + (size_t)r0 * DM + 3 * 512 + h * 128), T, sc128,
                                   false, 0.f, g0, ks2, rpbL + h * 465, lds, F.tid);
    }
}

__device__ __forceinline__ void ph_fattn(Frame& F, int l) {
    const bf16_t* PROJ = (const bf16_t*)(F.ws + WS_PROJ);
    bf16_t* OUTS = (bf16_t*)(F.ws + WS_OUTS);
    char* lds = (char*)(unsigned char*)F.lds;
    float* rpbL = (float*)(lds + 120 * 1024);
    {
        const float* rpb = F.in(22) + (size_t)l * 4 * 15 * 31;
        for (int i = F.tid; i < 4 * 15 * 31; i += NTHREADS) rpbL[i] = rpb[i] * 11.313708498984761f;
        __syncthreads();
    }
    const float sc128 = 0.08838834764831845f, sc192 = 0.07216878364870323f;
    const int nctxu = (l == 0) ? 8 : 0;
    if (FA_SEL & 1) for (int u = F.bid; u < 256 + nctxu; u += F.G) {
        launder(F);
        const bool cq = u >= 256; const int v = cq ? u - 256 : u, b = cq ? (v >> 2) : (v >> 7), h = cq ? (v & 3) : ((v >> 5) & 3), r0 = cq ? TL + b * NCTX : b * SEQ + (v & 31) * 256;
        fa::Tiles T{4, TL + b * NCTX, b * SEQ, cq ? 4 : 132};
        fa::attn_unit_sp192<768, 768, 1024>((const bf16_t*)(F.ws + WS_MQ) + (size_t)r0 * 768 + h * 192, (const bf16_t*)(F.ws + WS_MK) + h * 192, (const bf16_t*)(F.ws + WS_MKV) + h * 256 + 128,
                                            OUTS + (size_t)r0 * DM + 512 + h * 128, T, sc192, lds, F.tid);
    }
    if (FA_SEL & 2) for (int u = F.bid; u < 256 + 3 * nctxu; u += F.G) {
        launder(F);
        const bool cq = u >= 256; const int v = cq ? u - 256 : u;
        const int mx = cq ? ((v >> 3) == 0 ? 0 : (v >> 3) + 1) : 0, b = cq ? ((v >> 2) & 1) : (v >> 7), h = cq ? (v & 3) : ((v >> 5) & 3), r0 = cq ? TL + b * NCTX : b * SEQ + (v & 31) * 256;
        const int cqo = mx == 0 ? C_AQ : (mx == 2 ? C_WQ : C_NQ), cko = mx == 0 ? C_AK : (mx == 2 ? C_WK : C_NK), cvo = mx == 0 ? C_AV : (mx == 2 ? C_WV : C_NV), kvh = (mx == 3) ? h : (h >> 1);
        fa::Tiles T{4, TL + b * NCTX, b * SEQ, cq ? 4 : 132};
        fa::attn_unit<128, 1, 0, PP, PP, PP>(PROJ + (size_t)r0 * PP + cqo + h * 128, PROJ + cko + kvh * 128, PROJ + cvo + kvh * 128, OUTS + (size_t)r0 * DM + mx * 512 + h * 128, T, sc128,
                                             mx == 2, F.in(21)[l * 4 + h], 0, 0, nullptr, lds, F.tid);
    }
    if (FA_SEL & 4) for (int u = F.bid; u < 256; u += F.G) {
        launder(F);
        const int uu = XCDU(u), b = uu >> 7, h = (uu >> 5) & 3, qb = uu & 31, r0 = b * SEQ + qb * 256;
        const int q0 = qb * 256, k0 = max(q0 - 128, 0), k1 = min(q0 + 384, SEQ);
        fa::Tiles T{4, TL + b * NCTX, b * SEQ + k0, 4 + (k1 - k0) / 64};
        fa::attn_unit<128, 1, 1, PP, PP, PP>(PROJ + (size_t)r0 * PP + C_WQ + h * 128, PROJ + C_WK + (h >> 1) * 128, PROJ + C_WV + (h >> 1) * 128, OUTS + (size_t)r0 * DM + 2 * 512 + h * 128, T, sc128,
                                             true, F.in(21)[l * 4 + h], q0, k0, nullptr, lds, F.tid);
    }
    if (FA_SEL & 8) for (int u = F.bid; u < 256; u += F.G) {
        launder(F);
        const int b = u >> 7, h = (u >> 5) & 3, qb = u & 31, r0 = b * SEQ + qb * 256;
        const int g0 = qb * 4, ks = min(max(g0 - 4, 0), 120), ke = min(max(g0 + 3 - 4, 0), 120) + 8;
        int nt = ke - ks; nt += (nt & 1);
        const int ks2 = (ks + nt > 128) ? 128 - nt : ks;
        fa::Tiles T{4, TL + b * NCTX, b * SEQ + ks2 * 64, 4 + nt};
        fa::attn_unit<128, 1, 2, PP, PP, PP>(PROJ + (size_t)r0 * PP + C_NQ + h * 128, PROJ + C_NK + h * 128, PROJ + C_NV + h * 128, OUTS + (size_t)r0 * DM + 3 * 512 + h * 128, T, sc128,
                                             false, 0.f, g0, ks2, rpbL + h * 465, lds, F.tid);
    }
}

__device__ __forceinline__ void ph_fgemm_bf16(Frame& F, const bf16_t* A, int lda, const bf16_t* Bt, int K, int M, int N, bf16_t* C, int ldc) {
    pg8::SchedPlain S{(const char*)A, (const char*)Bt, lda, K, M / 256, N / 256, F.G, F.bid, 1 << 30, 0};
    pg8::EpiBf16 E{C, ldc, 1.0f};
    pg8::gemm_phase<pg8::EpiBf16, pg8::SchedPlain, false>(F.lds, F.tid, lda, K, K, S, E);
}
__device__ __forceinline__ void ph_fg1_fp8(Frame& F, int l) {
    pg8::SchedPlain S{(const char*)(F.ws + WS_H8), (const char*)(F.ws + WS_W + (size_t)l * WL_STRIDE + WO_IN), DM / 2, DM / 2, TT / 256, PP / 256, F.G, F.bid, 1 << 30, 0, DQ_PLAIN(l * 8 + 0)};
    pg8::EpiBf16 E{(bf16_t*)(F.ws + WS_PROJ), PP, 1.0f / GATE_WSCALE};
    pg8::gemm_phase<pg8::EpiBf16, pg8::SchedPlain, false, true, DYNQ>(F.lds, F.tid, DM / 2, DM / 2, DM / 2, S, E);
}
__device__ __forceinline__ void ph_fmla_up(Frame& F, int l) {
    pg8::SchedPlain S{(const char*)(F.ws + WS_MK), (const char*)(F.ws + WS_W + (size_t)l * WL_STRIDE + WO_UQ), MCP / 2, 256, TT / 256, MQP / 256, F.G, F.bid, 4, 128, DQ_PLAIN(l * 8 + 1)};
    pg8::EpiBf16 E{(bf16_t*)(F.ws + WS_MQ), MQP, 1.0f / GATE_WSCALE};
    pg8::gemm_phase<pg8::EpiBf16, pg8::SchedPlain, false, true, DYNQ>(F.lds, F.tid, MCP / 2, 256, 256, S, E);
}
__device__ __forceinline__ void ph_fout(Frame& F, int l) {
    const int M = (l == 0) ? TT : TL;
    const unsigned char* Wt = F.ws + WS_W + (size_t)l * WL_STRIDE + WO_O;
    pg8::SchedPlain S{(const char*)(F.ws + WS_ACC), (const char*)Wt, DM / 2, DM / 2, M / 256, DM / 256, F.G, F.bid, 1 << 30, 0, DQ_PLAIN(l * 8 + 4)};
    if (l == 0) { pg8::EpiResid<false> E{F.in(0), F.in(2), (bf16_t*)(F.ws + WS_H), (const float*)(F.ws + WS_MOD) + (size_t)l * 3 * 6 * DM, 2, 1.0f / (ACC_SCALE * GATE_WSCALE)};
        pg8::gemm_phase<pg8::EpiResid<false>, pg8::SchedPlain, false, true, DYNQ>(F.lds, F.tid, DM / 2, DM / 2, DM / 2, S, E); }
    else { pg8::EpiResid<true> E{nullptr, nullptr, (bf16_t*)(F.ws + WS_H), (const float*)(F.ws + WS_MOD) + (size_t)l * 3 * 6 * DM, 2, 1.0f / (ACC_SCALE * GATE_WSCALE)};
        pg8::gemm_phase<pg8::EpiResid<true>, pg8::SchedPlain, false, true, DYNQ>(F.lds, F.tid, DM / 2, DM / 2, DM / 2, S, E); }
}

constexpr int LDS_BYTES = 147456;
constexpr int MISC_OFF = 131072 + 320;
constexpr int N_PHASES = 1 + 12 * DEPTH + 1;

__global__ void __launch_bounds__(NTHREADS, 2) mega(Args args) {
    extern __shared__ __attribute__((aligned(16))) unsigned char lds[];
    Frame F;
    F.lds = (LAS unsigned char*)lds; F.out = args.out; F.ws = args.ws;
    F.tid = threadIdx.x; F.lane = F.tid & 63; F.wave = __builtin_amdgcn_readfirstlane(F.tid >> 6); F.G = gridDim.x; F.bid = blockIdx.x;
    volatile LAS unsigned* MISC = (volatile LAS unsigned*)(F.lds + MISC_OFF);
    if (F.tid < 32) MISC[F.tid] = 0u;
    __syncthreads();
    XcdBarrier bar; bar.bar = (unsigned*)(F.ws + WS_CTL) + CW_BAR; bar.x = 0; bar.st = nullptr;
    if (args.ph_hi - args.ph_lo > 1) bar = xcd_barrier_post((unsigned*)(F.ws + WS_CTL) + CW_BAR, MISC + 8, F.tid);
#if CLK_PROBE == 6
    if (F.bid == 0 && F.tid == 0) MISC[17] = (unsigned)__builtin_amdgcn_s_memrealtime();
#endif
#define IN(k) (launder(F), lo <= (k) && (k) < hi)
#if CLK_PROBE == 6
#define SEAM(k) do { if (IN(k) && IN((k) + 1)) xcd_barrier(bar, F.tid); if (F.bid == 0 && F.tid == 0) { const unsigned now_ = (unsigned)__builtin_amdgcn_s_memrealtime(); \
        if ((k) == PROBE_PH || (k) == PROBE_PH + 12) MISC[19] += now_ - MISC[17]; MISC[17] = now_; } } while (0)
#else
#define SEAM(k) do { if (IN(k) && IN((k) + 1)) xcd_barrier(bar, F.tid); } while (0)
#endif
#if CLK_PROBE >= 3 && CLK_PROBE <= 5
#define CLKP_BEGIN(l) do { if ((l) == 0 && F.bid == 0 && F.tid == 0) { MISC[20] = 1u; } } while (0)
#define CLKP_END(l) do { if ((l) == 0 && F.bid == 0 && F.tid == 0) { MISC[20] = 0u; } } while (0)
#elif CLK_PROBE && CLK_PROBE != 6
#define CLKP_BEGIN(l) do { if ((l) == 0 && F.bid == 0 && F.tid == 0) { MISC[16] = (unsigned)__builtin_readcyclecounter(); MISC[17] = (unsigned)__builtin_amdgcn_s_memrealtime(); } } while (0)
#define CLKP_END(l) do { if ((l) == 0 && F.bid == 0 && F.tid == 0) { MISC[18] = (unsigned)__builtin_readcyclecounter() - MISC[16]; MISC[19] = (unsigned)__builtin_amdgcn_s_memrealtime() - MISC[17]; } } while (0)
#else
#define CLKP_BEGIN(l) do { } while (0)
#define CLKP_END(l) do { } while (0)
#endif
#define LAYER(l) do { \
        const int pb = 1 + 12 * l; \
        if (IN(pb + 0)) { ph_prep1(F, l); } SEAM(pb + 0); \
        unsigned char* wl = F.ws + WS_W + (size_t)l * WL_STRIDE; \
        if (IN(pb + 1)) { \
            if (FAST_MASK & 1) { CLKP_BEGIN(l); for (int rep = 0; rep < REP_GEMM; ++rep) ph_fg1_fp8(F, l); CLKP_END(l); } \
            else ph_ngemm_bf16(F, (const bf16_t*)(F.ws + WS_H), DM, F.in(8) + (size_t)l * DM * DIN, DIN, DM, TT, DIN, (bf16_t*)(F.ws + WS_PROJ), PP); \
        } SEAM(pb + 1); \
        if (IN(pb + 2)) { if (FAST_MASK & 64) ph_prep2_fast(F, l); else ph_prep2(F, l); } SEAM(pb + 2); \
        if (IN(pb + 3)) { \
            if (FAST_MASK & 2) { \
                ph_fmla_up(F, l); \
            } else { \
                ph_ngemm_bf16(F, (const bf16_t*)(F.ws + WS_PROJ) + C_MCQ, PP, F.in(10) + (size_t)l * 384 * 768, 768, 384, TT, 768, (bf16_t*)(F.ws + WS_MQ), 768); \
                ph_ngemm_bf16(F, (const bf16_t*)(F.ws + WS_PROJ) + C_MCKV, PP, F.in(12) + (size_t)l * 256 * 1024, 1024, 256, TT, 1024, (bf16_t*)(F.ws + WS_MKV), 1024); \
            } \
        } SEAM(pb + 3); \
        if (IN(pb + 4)) { if (FAST_MASK & 64) ph_prep3_fast(F, l); else ph_prep3(F, l); } SEAM(pb + 4); \
        if (IN(pb + 5)) { if (FAST_MASK & 32) { for (int rep = 0; rep < REP_ATT; ++rep) ph_fattn8(F, l); } else ph_nattn(F, l); } SEAM(pb + 5); \
        if (IN(pb + 6)) { if (FAST_MASK & 8) { for (int rep = 0; rep < REP_GEMM; ++rep) ph_fbranch(F, l); } } SEAM(pb + 6); \
        if (IN(pb + 7)) { if (FAST_MASK & 8) { for (int rep = 0; rep < REP_GEMM; ++rep) ph_fgate(F, l); } else ph_nmerge(F, l); } SEAM(pb + 7); \
        if (IN(pb + 8)) { if (FAST_MASK & 4) ph_fout(F, l); else ph_nout(F, l); } SEAM(pb + 8); \
        if (IN(pb + 9)) { ph_prep4(F, l); } SEAM(pb + 9); \
        if (IN(pb + 10)) { if (FAST_MASK & 16) { for (int rep = 0; rep < REP_MOE; ++rep) ph_fmoe_up(F, l); } else ph_nmoe(F, l); } SEAM(pb + 10); \
        if (IN(pb + 11)) { if (FAST_MASK & 16) { for (int rep = 0; rep < REP_MOE; ++rep) ph_fmoe_down(F, l); } } SEAM(pb + 11); \
    } while (0)
#if PREFIX_K > 0
    {
        const int lo = 0, hi = PREFIX_K;
        if (IN(0)) { ph_mod(F); if (FAST_MASK) { rope_tables_build(F); ph_convert(F); } } SEAM(0);
        LAYER(0);
        xcd_barrier(bar, F.tid);
        if (F.bid == 0 && F.tid < 32) ((unsigned*)(F.ws + WS_CTL))[CW_ECNT + F.tid] = 0u;
        xcd_barrier(bar, F.tid);
    }
#endif
    const int lo = args.ph_lo, hi = args.ph_hi;
    if (IN(0)) { for (int rep = 0; rep < REP_PRO; ++rep) { ph_mod(F); if (FAST_MASK) { rope_tables_build(F); ph_convert(F); } } } SEAM(0);
    LAYER(0);
    LAYER(1);
#undef LAYER
    if (IN(N_PHASES - 1)) { ph_prep1(F, DEPTH); }
#if CLK_PROBE
    if (F.bid == 0 && F.tid == 0) {
        const unsigned dc = MISC[18], dw = MISC[19];
        const unsigned long long spin = CLK_PROBE == 1 ? (unsigned long long)dc * 3000ull / (dw ? dw : 1u) : ((CLK_PROBE == 2 || CLK_PROBE == 6) ? (unsigned long long)dw * 2ull : (unsigned long long)dc);
        const unsigned long long t0 = __builtin_amdgcn_s_memrealtime();
        while (__builtin_amdgcn_s_memrealtime() - t0 < spin) __builtin_amdgcn_s_sleep(8);
    }
#endif
#undef IN
#undef SEAM
}

extern "C" void kernel_launch(void* const* d_in, const int* in_sizes, int n_in, void* d_out, int out_size, void* d_ws, size_t ws_size, hipStream_t stream) {
    static int grid = 0;
    if (grid == 0) {
        if (n_in != 32 || in_sizes[0] != TL * DM || out_size != TL * DM || ws_size < WS_END) {
            fprintf(stderr, "kernel_launch: shape mismatch n_in %d in0 %d out %d ws %zu (need %zu)\n", n_in, n_in > 0 ? in_sizes[0] : -1, out_size, ws_size, (size_t)WS_END); grid = -1; return; }
        int dev = 0, cus = 0, per_cu = 0;
        if (hipGetDevice(&dev) != hipSuccess || hipDeviceGetAttribute(&cus, hipDeviceAttributeMultiprocessorCount, dev) != hipSuccess) { grid = -1; return; }
        if (hipFuncSetAttribute((const void*)mega, hipFuncAttributeMaxDynamicSharedMemorySize, LDS_BYTES) != hipSuccess) { fprintf(stderr, "kernel_launch: hipFuncSetAttribute failed\n"); grid = -1; return; }
        if (hipOccupancyMaxActiveBlocksPerMultiprocessor(&per_cu, (const void*)mega, NTHREADS, LDS_BYTES) != hipSuccess || per_cu < 1) { fprintf(stderr, "kernel_launch: occupancy query says %d\n", per_cu); }
        (void)hipGetLastError();
        grid = cus & ~7;
    }
    if (grid < 0) return;
    if (hipMemsetAsync((char*)d_ws + WS_CTL, 0, CTL_ZERO_BYTES, stream) != hipSuccess) return;
    Args a{};
    for (int i = 0; i < 32; ++i) a.in[i] = (const float*)d_in[i];
    a.out = (float*)d_out; a.ws = (unsigned char*)d_ws;
#if MK_N_LAUNCHES == 1
    a.ph_lo = 0; a.ph_hi = N_PHASES;
    hipLaunchKernelGGL(mega, dim3(grid), dim3(NTHREADS), LDS_BYTES, stream, a);
#else
    for (int p = 0; p < N_PHASES; ++p) { a.ph_lo = p; a.ph_hi = p + 1; hipLaunchKernelGGL(mega, dim3(grid), dim3(NTHREADS), LDS_BYTES, stream, a); }
#endif
    const hipError_t le = hipPeekAtLastError();
    if (le != hipSuccess) fprintf(stderr, "kernel_launch: launch failed: %s\n", hipGetErrorName(le));
}
```
